# Optimizing an MI355X kernel written in HIP

```python
import math
import jax, jax.numpy as jnp
from jax import lax
import numpy as np

D_MODEL = 1024
BATCH = 8
SEQ = 2048
DEPTH = 1
DEC_BATCH = 128
DEC_SEQ = 4
PAST_LEN = 16384
PAGE_SIZE = 128

D_A = D_MODEL
HEAD_A = 64
N_HEADS_A = D_A // HEAD_A
DECAY_LORA = 64
ICLR_LORA = 64
GATE_LORA = 128
RWKV_COLS = 3 * D_A + DECAY_LORA + ICLR_LORA + GATE_LORA
GN_EPS = HEAD_A * 1e-5
D_LRU = D_MODEL
LRU_BLOCKS = 16
LRU_BS = D_LRU // LRU_BLOCKS
CONV_W = 4
LRU_C = 8.0
N_IN = RWKV_COLS + 2 * D_LRU + 2 * D_MODEL
D_FF = ((8 * D_MODEL // 3 + 255) // 256) * 256
ALPHA = (2.0 * DEPTH) ** 0.25
BETA = (8.0 * DEPTH) ** -0.25
LN_EPS = 1e-5

kernel_name = "rwkv7_rglru_gated_hybrid_step"


def _layer_norm(x, g, b):
    xf = x.astype(jnp.float32)
    mu = xf.mean(-1, keepdims=True)
    var = jnp.square(xf - mu).mean(-1, keepdims=True)
    return ((xf - mu) * lax.rsqrt(var + LN_EPS) * g + b).astype(x.dtype)


def _wkv7_scan(r, decay, k, v, kk, a, S0):
    def step(S, inp):
        r_t, w_t, k_t, v_t, kk_t, a_t = inp
        sa = jnp.einsum('bhij,bhj->bhi', S, -kk_t)
        S = (S * w_t[:, :, None, :]
             + sa[..., None] * (kk_t * a_t)[:, :, None, :]
             + v_t[..., None] * k_t[:, :, None, :])
        return S, jnp.einsum('bhij,bhj->bhi', S, r_t)
    xs = tuple(jnp.swapaxes(t.astype(jnp.float32), 0, 1) for t in (r, decay, k, v, kk, a))
    S, y = lax.scan(step, S0.astype(jnp.float32), xs)
    return jnp.swapaxes(y, 0, 1), S


def _rwkv7_branch(z_rw, z_prev_first, S0, mu, w0, w2, a0, a2, g2, k_k, k_a, r_k, lnx_g, lnx_b):
    B, T, _ = z_rw.shape
    z_prev = jnp.concatenate([z_prev_first[:, None].astype(z_rw.dtype), z_rw[:, :-1]], axis=1)
    zm = z_rw + mu * (z_prev - z_rw)
    o = 0
    r = zm[..., o:o + D_A]; o += D_A
    k = zm[..., o:o + D_A]; o += D_A
    v = zm[..., o:o + D_A]; o += D_A
    w_lo = zm[..., o:o + DECAY_LORA]; o += DECAY_LORA
    a_lo = zm[..., o:o + ICLR_LORA]; o += ICLR_LORA
    g_lo = zm[..., o:o + GATE_LORA]
    w = -jax.nn.softplus(-(w0 + jnp.tanh(w_lo) @ w2).astype(jnp.float32)) - 0.5
    decay = jnp.exp(-jnp.exp(w))
    a = jax.nn.sigmoid(a0 + a_lo @ a2)
    g = jax.nn.sigmoid(g_lo) @ g2
    heads = lambda t: t.reshape(B, T, N_HEADS_A, HEAD_A)
    kk = heads(k * k_k).astype(jnp.float32)
    kk = kk / jnp.maximum(jnp.sqrt(jnp.sum(kk * kk, -1, keepdims=True)), 1e-12)
    k = k * (1.0 + (a - 1.0) * k_a)
    rh, kh, vh = heads(r), heads(k), heads(v)
    y, S = _wkv7_scan(rh, heads(decay), kh, vh, kk, heads(a), S0)
    mu_y = y.mean(-1, keepdims=True)
    var_y = jnp.square(y - mu_y).mean(-1, keepdims=True)
    y = ((y - mu_y) * lax.rsqrt(var_y + GN_EPS)).reshape(B, T, D_A) * lnx_g + lnx_b
    bonus = (jnp.sum((rh * kh * r_k).astype(jnp.float32), -1, keepdims=True) * vh).reshape(B, T, D_A)
    return (y + bonus) * g, S


def _combine(c1, c2):
    a1, b1 = c1
    a2, b2 = c2
    return a1 * a2, a2 * b1 + b2


def _rglru_branch(xb, gate_in, conv_buf, h0, conv_w, conv_b, wa, ba, wi, bi, lam, reset_first):
    B, T, _ = xb.shape
    xpad = jnp.concatenate([conv_buf.astype(xb.dtype), xb], axis=1)
    u = conv_b + sum(conv_w[j] * xpad[:, j:j + T] for j in range(CONV_W))
    new_conv = xpad[:, T:]
    ub = u.reshape(B, T, LRU_BLOCKS, LRU_BS)
    r = jax.nn.sigmoid(jnp.einsum('btnc,ncd->btnd', ub, wa) + ba).reshape(B, T, D_LRU)
    i = jax.nn.sigmoid(jnp.einsum('btnc,ncd->btnd', ub, wi) + bi).reshape(B, T, D_LRU)
    log_a = -LRU_C * r.astype(jnp.float32) * jax.nn.softplus(-lam.astype(jnp.float32))
    a = jnp.exp(log_a)
    mult = jnp.sqrt(-jnp.expm1(2.0 * log_a))
    if reset_first:
        mult = mult.at[:, 0].set(1.0)
    bx = mult * i.astype(jnp.float32) * u.astype(jnp.float32)
    bx = bx.at[:, 0].add(a[:, 0] * h0.astype(jnp.float32))
    _, h = lax.associative_scan(_combine, (a, bx), axis=1)
    out = h * jax.nn.gelu(gate_in.astype(jnp.float32))
    return out, new_conv, h[:, -1]


def _layer(x, shift_buf, wkv0, conv_buf, h0, reset_first,
           w_in, tmix_mu, w0, w2_decay, a0, a2_iclr, g2_gate, k_k, k_a, r_k, lnx_g, lnx_b,
           conv_w, conv_b, lru_wa, lru_ba, lru_wi, lru_bi, lru_lambda, w_o,
           ln1_g, ln1_b, w_ffn_gate, w_ffn_up, w_ffn_down, ln2_g, ln2_b):
    z = jnp.einsum('btd,de->bte', x, w_in)
    z_prev_first = shift_buf.astype(x.dtype) @ w_in[:, :RWKV_COLS]
    yA, S = _rwkv7_branch(z[..., :RWKV_COLS], z_prev_first, wkv0, tmix_mu, w0, w2_decay, a0,
                          a2_iclr, g2_gate, k_k, k_a, r_k, lnx_g, lnx_b)
    o = RWKV_COLS
    xb = z[..., o:o + D_LRU]
    gb = z[..., o + D_LRU:o + 2 * D_LRU]
    o2 = o + 2 * D_LRU
    gate_a = jax.nn.sigmoid(z[..., o2:o2 + D_MODEL].astype(jnp.float32))
    gate_b = jax.nn.sigmoid(z[..., o2 + D_MODEL:].astype(jnp.float32))
    yB, new_conv, h_last = _rglru_branch(xb, gb, conv_buf, h0, conv_w, conv_b, lru_wa, lru_ba,
                                         lru_wi, lru_bi, lru_lambda, reset_first)
    merged = (gate_a * yA + gate_b * yB).astype(x.dtype)
    mix = jnp.einsum('bte,ed->btd', merged, w_o)
    h1 = _layer_norm(ALPHA * x + mix, ln1_g, ln1_b)
    ffn = (jax.nn.silu(h1 @ w_ffn_gate) * (h1 @ w_ffn_up)) @ w_ffn_down
    y = _layer_norm(ALPHA * h1 + ffn, ln2_g, ln2_b)
    return y, x[:, -1], S, new_conv, h_last


def setup_inputs(seed: int = 0) -> dict:
    key = jax.random.key(seed)
    ks = jax.random.split(key, 40)
    nrm = lambda k, shape, s: jax.random.normal(k, shape, jnp.float32) * s
    L = DEPTH
    u_lam = jax.random.uniform(ks[20], (L, D_LRU), jnp.float32, 0.9, 0.999) ** (1.0 / LRU_C)
    return {
        "x_prompt": nrm(ks[0], (BATCH, SEQ, D_MODEL), 1.0),
        "x_sample": nrm(ks[1], (DEC_BATCH, DEC_SEQ, D_MODEL), 1.0),
        "state_shift": nrm(ks[2], (L, DEC_BATCH, D_MODEL), 1.0),
        "state_wkv": nrm(ks[3], (L, DEC_BATCH, N_HEADS_A, HEAD_A, HEAD_A), 0.5),
        "state_conv": nrm(ks[4], (L, DEC_BATCH, CONV_W - 1, D_LRU), 1.0),
        "state_lru": nrm(ks[5], (L, DEC_BATCH, D_LRU), 0.5),
        "w_in": nrm(ks[6], (L, D_MODEL, N_IN), D_MODEL ** -0.5),
        "tmix_mu": jax.random.uniform(ks[7], (L, RWKV_COLS), jnp.float32, 0.0, 1.0),
        "w0": jax.random.uniform(ks[8], (L, D_A), jnp.float32, -4.0, 1.0),
        "w2_decay": nrm(ks[9], (L, DECAY_LORA, D_A), 0.1 * DECAY_LORA ** -0.5),
        "a0": nrm(ks[10], (L, D_A), 0.1),
        "a2_iclr": nrm(ks[11], (L, ICLR_LORA, D_A), 0.5 * ICLR_LORA ** -0.5),
        "g2_gate": nrm(ks[12], (L, GATE_LORA, D_A), GATE_LORA ** -0.5),
        "k_k": 0.85 + nrm(ks[13], (L, D_A), 0.02),
        "k_a": 1.0 + nrm(ks[14], (L, D_A), 0.02),
        "r_k": nrm(ks[15], (L, N_HEADS_A, HEAD_A), 0.1),
        "lnx_g": 1.0 + nrm(ks[16], (L, D_A), 0.02),
        "lnx_b": nrm(ks[17], (L, D_A), 0.02),
        "conv_w": nrm(ks[18], (L, CONV_W, D_LRU), CONV_W ** -0.5),
        "conv_b": nrm(ks[19], (L, D_LRU), 0.02),
        "lru_wa": nrm(ks[21], (L, LRU_BLOCKS, LRU_BS, LRU_BS), LRU_BS ** -0.5),
        "lru_ba": nrm(ks[22], (L, LRU_BLOCKS, LRU_BS), 0.02),
        "lru_wi": nrm(ks[23], (L, LRU_BLOCKS, LRU_BS, LRU_BS), LRU_BS ** -0.5),
        "lru_bi": nrm(ks[24], (L, LRU_BLOCKS, LRU_BS), 0.02),
        "lru_lambda": jnp.log(u_lam / (1.0 - u_lam)),
        "w_o": nrm(ks[25], (L, D_MODEL, D_MODEL), BETA * D_MODEL ** -0.5),
        "ln1_g": 1.0 + nrm(ks[26], (L, D_MODEL), 0.02),
        "ln1_b": nrm(ks[27], (L, D_MODEL), 0.02),
        "w_ffn_gate": nrm(ks[28], (L, D_MODEL, D_FF), D_MODEL ** -0.5),
        "w_ffn_up": nrm(ks[29], (L, D_MODEL, D_FF), D_MODEL ** -0.5),
        "w_ffn_down": nrm(ks[30], (L, D_FF, D_MODEL), BETA * D_FF ** -0.5),
        "ln2_g": 1.0 + nrm(ks[31], (L, D_MODEL), 0.02),
        "ln2_b": nrm(ks[32], (L, D_MODEL), 0.02),
    }


def reference(x_prompt, x_sample, state_shift, state_wkv, state_conv, state_lru,
              w_in, tmix_mu, w0, w2_decay, a0, a2_iclr, g2_gate, k_k, k_a, r_k, lnx_g, lnx_b,
              conv_w, conv_b, lru_wa, lru_ba, lru_wi, lru_bi, lru_lambda, w_o,
              ln1_g, ln1_b, w_ffn_gate, w_ffn_up, w_ffn_down, ln2_g, ln2_b):
    params = (w_in, tmix_mu, w0, w2_decay, a0, a2_iclr, g2_gate, k_k, k_a, r_k, lnx_g, lnx_b,
              conv_w, conv_b, lru_wa, lru_ba, lru_wi, lru_bi, lru_lambda, w_o,
              ln1_g, ln1_b, w_ffn_gate, w_ffn_up, w_ffn_down, ln2_g, ln2_b)
    Bp = x_prompt.shape[0]
    yp, ys = x_prompt, x_sample
    sp_shift, sp_wkv, sp_conv, sp_lru = [], [], [], []
    ss_shift, ss_wkv, ss_conv, ss_lru = [], [], [], []
    for l in range(DEPTH):
        p = [w[l] for w in params]
        yp, s1, s2, s3, s4 = _layer(
            yp, jnp.zeros((Bp, D_MODEL), yp.dtype),
            jnp.zeros((Bp, N_HEADS_A, HEAD_A, HEAD_A), jnp.float32),
            jnp.zeros((Bp, CONV_W - 1, D_LRU), yp.dtype),
            jnp.zeros((Bp, D_LRU), jnp.float32), True, *p)
        sp_shift.append(s1); sp_wkv.append(s2); sp_conv.append(s3); sp_lru.append(s4)
        ys, t1, t2, t3, t4 = _layer(ys, state_shift[l], state_wkv[l], state_conv[l], state_lru[l],
                                    False, *p)
        ss_shift.append(t1); ss_wkv.append(t2); ss_conv.append(t3); ss_lru.append(t4)
    return (yp, ys,
            jnp.stack(sp_shift), jnp.stack(sp_wkv), jnp.stack(sp_conv), jnp.stack(sp_lru),
            jnp.stack(ss_shift), jnp.stack(ss_wkv), jnp.stack(ss_conv), jnp.stack(ss_lru))
```

```cpp
#include <hip/hip_runtime.h>
#include <hip/hip_cooperative_groups.h>
#include <cstdio>
#include <cstdint>
namespace pg8 {
#define PG8_LAS __attribute__((address_space(3)))
typedef unsigned short bf16_t;
typedef short bf16x8 __attribute__((ext_vector_type(8)));
typedef float f32x4 __attribute__((ext_vector_type(4)));
typedef unsigned u32x4 __attribute__((ext_vector_type(4)));
constexpr int BM = 256, BK = 64, HALF = 128, HTB = HALF * BK * 2  , STAGE_BYTES = 8 * HTB, NXCD = 8, WGM = 8;

__host__ __device__ __forceinline__ int lds_byte(int r, int c) { const int st = (r >> 4) * 2 + (c >> 5), rr = r & 15, cc = c & 31, ob = rr * 64 + cc * 2; return st * 1024 + (ob ^ (((ob >> 9) & 1) << 5)); }
__host__ __device__ __forceinline__ void stage_rc(int b, int& R, int& C) { const int st = b / 1024, sb = b % 1024, swz = sb ^ (((sb >> 9) & 1) << 5); R = (st >> 1) * 16 + swz / 64; C = (st & 1) * 32 + (swz % 64) / 2; }
__host__ __device__ __forceinline__ int perm32(int rho) { const int n = rho >> 4, i = rho & 15; return 8 * (i >> 2) + 4 * n + (i & 3); }

struct Unit { int pm, pn; };
struct Gemm { const bf16_t* A; const bf16_t* Bt; int M, N, K; };

struct StaticOrder {
    int nM, nN, nwg, G, c;
    __host__ __device__ void init(int M, int N, int G_, int c_) { nM = M / BM; nN = N / BM; nwg = nM * nN; G = G_; c = c_; }
    __host__ __device__ bool next(int i, Unit& u) const {
        const long L = (long)i * G + c; if (L >= nwg) return false;
        int wgid = (int)L; { const int q = nwg / NXCD, r = nwg % NXCD, xcd = wgid % NXCD, off = wgid / NXCD; wgid = (xcd < r ? xcd * (q + 1) : r * (q + 1) + (xcd - r) * q) + off; }
        const int nig = WGM * nN, gid = wgid / nig, fm = gid * WGM, gsz = (nM - fm) < WGM ? (nM - fm) : WGM;
        u.pm = fm + ((wgid % nig) % gsz); u.pn = (wgid % nig) / gsz; return true;
    }
    __device__ __forceinline__ void a_ready(const Unit&) const {}
    __device__ __forceinline__ void done(const Unit&) const {}
};

__device__ __forceinline__ unsigned cvt_pk_bf16(float lo, float hi) { unsigned r; asm volatile("v_cvt_pk_bf16_f32 %0, %1, %2" : "=v"(r) : "v"(lo), "v"(hi)); return r; }
typedef float f32x2 __attribute__((ext_vector_type(2)));
__device__ __forceinline__ f32x2 gelu_pk(f32x2 v) {
    const f32x2 av = __builtin_elementwise_abs(v), d = av * 0.2316418882f + 1.0f;
    f32x2 t; t.x = __builtin_amdgcn_rcpf(d.x); t.y = __builtin_amdgcn_rcpf(d.y);
    f32x2 q = t * 0.5307027145f + (-0.7265760135f); q = q * t + 0.7107068705f; q = q * t + (-0.142248368f); q = q * t + 0.127414796f; q = q * t;
    const f32x2 s = (v * v) * (-0.72134752044f);
    f32x2 e; e.x = __builtin_amdgcn_exp2f(s.x); e.y = __builtin_amdgcn_exp2f(s.y);
    const f32x2 m = v * (q * e), r = v - m;
    f32x2 o; o.x = v.x < 0.f ? m.x : r.x; o.y = v.y < 0.f ? m.y : r.y; return o;
}

template <int ACT  > struct EpiBf16 {
    static constexpr bool PERM = true, AFTER_DRAIN = false; static_assert(ACT == 0 || ACT == 1, "EpiBf16: ACT is 0 (none) or 1 (gelu_pk)");
    bf16_t* O; int ldc; const float* bias; int split_cols; size_t split_stride; float scale0;
    __device__ __forceinline__ void operator()(const f32x4 (&acc)[2][2][4][2], const Unit& u, int wr, int wc, int fr, int fq) const {
        const int row0 = u.pm * BM + wr * 64 + fr; int colt = u.pn * BM; bf16_t* base = O;
        float sc = 1.f; if (split_cols) { const int t = colt / split_cols; base += (size_t)t * split_stride; colt -= t * split_cols; if (t == 0) sc = scale0; }
        const int col0 = colt + wc * 32 + 8 * fq, bcol0 = u.pn * BM + wc * 32 + 8 * fq;
        f32x4 bv[2][2];
#pragma unroll
        for (int bj = 0; bj < 2; ++bj)
#pragma unroll
            for (int n = 0; n < 2; ++n) bv[bj][n] = bias ? *(const f32x4*)(bias + bcol0 + bj * HALF + 4 * n) : (f32x4){0.f, 0.f, 0.f, 0.f};
#pragma unroll
        for (int ai = 0; ai < 2; ++ai)
#pragma unroll
            for (int m = 0; m < 4; ++m) { bf16_t* rowp = base + (size_t)(row0 + ai * HALF + m * 16) * ldc + col0;
#pragma unroll
                for (int bj = 0; bj < 2; ++bj) { f32x4 v0 = acc[ai][bj][m][0] + bv[bj][0], v1 = acc[ai][bj][m][1] + bv[bj][1];
                    if (ACT == 1) { f32x2 a = gelu_pk((f32x2){v0[0], v0[1]}), b = gelu_pk((f32x2){v0[2], v0[3]}), c = gelu_pk((f32x2){v1[0], v1[1]}), d = gelu_pk((f32x2){v1[2], v1[3]});
                        v0 = (f32x4){a.x, a.y, b.x, b.y}; v1 = (f32x4){c.x, c.y, d.x, d.y}; }
                    v0 = v0 * sc; v1 = v1 * sc; u32x4 w; w.x = cvt_pk_bf16(v0[0], v0[1]); w.y = cvt_pk_bf16(v0[2], v0[3]); w.z = cvt_pk_bf16(v1[0], v1[1]); w.w = cvt_pk_bf16(v1[2], v1[3]);
                    *(u32x4*)(rowp + bj * HALF) = w; } }
    }
};
template <class Epi, class Sched, bool ALIGN_EPI = false, bool SP2 = false>
__device__ __forceinline__ void gemm_phase(PG8_LAS unsigned char* lds, const Gemm g, const Sched& S, const Epi& E) {
    const int tid = threadIdx.x, wid = __builtin_amdgcn_readfirstlane(tid >> 6), lane = tid & 63, wr = wid >> 2, wc = wid & 3, fr = lane & 15, fq = lane >> 4;
    const int K = g.K, nt = K / BK;
    unsigned voffA[2], voffB[2];
#pragma unroll
    for (int i = 0; i < 2; ++i) { int R, C; stage_rc(tid * 16 + i * 8192, R, C); const int Rb = Epi::PERM ? ((R & ~31) + perm32(R & 31)) : R;
        voffA[i] = (unsigned)(R * K + C) * 2u; voffB[i] = (unsigned)(Rb * K + C) * 2u; }
    const size_t kstep = (size_t)(BK * 2);
    const size_t hstep = (size_t)HALF * K * 2;
    const size_t tstep = 2 * hstep;
    const unsigned ldsw = (unsigned)wid * 1024u;
    const int aoff = lds_byte(wr * 64 + fr, fq * 8), boff = lds_byte(wc * 32 + fr, fq * 8);
#define PG8_SA(b, h) (((b) * 2 + (h)) * HTB)
#define PG8_SB(b, h) ((4 + (b) * 2 + (h)) * HTB)
#define PG8_STAGE(bufoff, gbase, voff) do { _Pragma("unroll") for (int _i = 0; _i < 2; ++_i) \
        __builtin_amdgcn_global_load_lds((const unsigned*)((const char*)(gbase) + (voff)[_i]), (PG8_LAS unsigned*)(lds + (bufoff) + ldsw + _i * 8192), 16, 0, 0); } while (0)
#define PG8_LDA(dst, b, h) do { _Pragma("unroll") for (int m = 0; m < 4; ++m) _Pragma("unroll") for (int k = 0; k < 2; ++k) dst[m][k] = *(const PG8_LAS bf16x8*)(lds + PG8_SA(b, h) + aoff + m * 2048 + k * 1024); } while (0)
#define PG8_LDB(dst, b, h) do { _Pragma("unroll") for (int n = 0; n < 2; ++n) _Pragma("unroll") for (int k = 0; k < 2; ++k) dst[n][k] = *(const PG8_LAS bf16x8*)(lds + PG8_SB(b, h) + boff + n * 2048 + k * 1024); } while (0)
#define PG8_MMA(ai, bj, At, Bt) do { __builtin_amdgcn_s_setprio(1); _Pragma("unroll") for (int m = 0; m < 4; ++m) _Pragma("unroll") for (int n = 0; n < 2; ++n) _Pragma("unroll") for (int k = 0; k < 2; ++k) \
        acc[ai][bj][m][n] = __builtin_amdgcn_mfma_f32_16x16x32_bf16(Bt[n][k], At[m][k], acc[ai][bj][m][n], 0, 0, 0); __builtin_amdgcn_s_setprio(0); } while (0)
#define PG8_WAIT_V(n) asm volatile("s_waitcnt vmcnt(" #n ")" ::: "memory")
#define PG8_WAIT_L(n) asm volatile("s_waitcnt lgkmcnt(" #n ")" ::: "memory")
#define PG8_BAR __builtin_amdgcn_s_barrier()
#define PG8_SCHED __builtin_amdgcn_sched_barrier(0)
    Unit cur, nxt; int ui = 0;
    if (!S.next(0, cur)) return;
    f32x4 acc[2][2][4][2];
#pragma unroll
    for (int a = 0; a < 2; ++a)
#pragma unroll
        for (int b = 0; b < 2; ++b)
#pragma unroll
            for (int m = 0; m < 4; ++m)
#pragma unroll
                for (int n = 0; n < 2; ++n) acc[a][b][m][n] = (f32x4){0.f, 0.f, 0.f, 0.f};
    bf16x8 At[4][2], B0[2][2], B1[2][2];
    const char* cA = (const char*)g.A + (size_t)cur.pm * tstep; const char* cB = (const char*)g.Bt + (size_t)cur.pn * tstep;
    S.a_ready(cur);
    if constexpr (SP2) {
        PG8_STAGE(PG8_SB(0, 0), cB, voffB); PG8_STAGE(PG8_SB(0, 1), cB + hstep, voffB); PG8_STAGE(PG8_SA(0, 0), cA, voffA); PG8_STAGE(PG8_SA(0, 1), cA + hstep, voffA);
        if (wr == 1) PG8_BAR;
        PG8_WAIT_V(2); PG8_BAR;
        PG8_STAGE(PG8_SB(1, 0), cB + kstep, voffB); PG8_STAGE(PG8_SA(1, 0), cA + kstep, voffA); PG8_STAGE(PG8_SB(1, 1), cB + hstep + kstep, voffB);
        PG8_WAIT_V(6); PG8_BAR;
    } else {
        PG8_STAGE(PG8_SB(0, 0), cB, voffB); PG8_STAGE(PG8_SA(0, 0), cA, voffA); PG8_STAGE(PG8_SB(0, 1), cB + hstep, voffB); PG8_STAGE(PG8_SA(0, 1), cA + hstep, voffA);
        if (wr == 1) PG8_BAR;
        PG8_WAIT_V(4); PG8_BAR;
        PG8_STAGE(PG8_SB(1, 0), cB + kstep, voffB); PG8_STAGE(PG8_SA(1, 0), cA + kstep, voffA); PG8_STAGE(PG8_SB(1, 1), cB + hstep + kstep, voffB);
        PG8_WAIT_V(6); PG8_BAR;
    }
    for (;;) {
        const bool has_next = S.next(ui + 1, nxt);
        const char* nA = has_next ? (const char*)g.A + (size_t)nxt.pm * tstep : cA; const char* nB = has_next ? (const char*)g.Bt + (size_t)nxt.pn * tstep : cB;
        for (int t = 0; t < nt; t += 2) {
            const bool last = (t == nt - 2);
            const char* a1 = cA + (size_t)(t + 1) * kstep;
            const char* a2 = last ? nA : cA + (size_t)(t + 2) * kstep; const char* b2 = last ? nB : cB + (size_t)(t + 2) * kstep;
            const char* a3 = a2 + kstep; const char* b3 = b2 + kstep;
            if (last && has_next) S.a_ready(nxt);
            if constexpr (SP2) {
            PG8_LDB(B0, 0, 0); PG8_LDB(B1, 0, 1); PG8_SCHED; PG8_LDA(At, 0, 0); PG8_STAGE(PG8_SA(1, 1), a1 + hstep, voffA);
            PG8_WAIT_V(8); PG8_WAIT_L(0); PG8_BAR; PG8_MMA(0, 0, At, B0); PG8_MMA(0, 1, At, B1); PG8_BAR; PG8_SCHED;
            PG8_LDA(At, 0, 1); PG8_STAGE(PG8_SB(0, 0), b2, voffB); PG8_STAGE(PG8_SB(0, 1), b2 + hstep, voffB); PG8_STAGE(PG8_SA(0, 0), a2, voffA);
            PG8_WAIT_V(8); PG8_WAIT_L(0); PG8_BAR; PG8_MMA(1, 0, At, B0); PG8_MMA(1, 1, At, B1); PG8_BAR; PG8_SCHED;
            PG8_LDB(B0, 1, 0); PG8_LDB(B1, 1, 1); PG8_SCHED; PG8_LDA(At, 1, 0); PG8_STAGE(PG8_SA(0, 1), a2 + hstep, voffA);
            PG8_WAIT_V(8); PG8_WAIT_L(0); PG8_BAR; PG8_MMA(0, 0, At, B0); PG8_MMA(0, 1, At, B1); PG8_BAR; PG8_SCHED;
            PG8_LDA(At, 1, 1); PG8_STAGE(PG8_SB(1, 0), b3, voffB); PG8_STAGE(PG8_SB(1, 1), b3 + hstep, voffB); PG8_STAGE(PG8_SA(1, 0), a3, voffA);
            PG8_WAIT_V(8); PG8_WAIT_L(0); PG8_BAR; PG8_MMA(1, 0, At, B0); PG8_MMA(1, 1, At, B1); PG8_BAR; PG8_SCHED;
            } else {
            PG8_LDB(B0, 0, 0); PG8_SCHED; PG8_LDA(At, 0, 0); PG8_STAGE(PG8_SA(1, 1), a1 + hstep, voffA);
            PG8_WAIT_L(8); PG8_BAR; PG8_WAIT_L(0); PG8_MMA(0, 0, At, B0); PG8_BAR; PG8_SCHED;
            PG8_LDB(B1, 0, 1); PG8_STAGE(PG8_SB(0, 0), b2, voffB);
            PG8_BAR; PG8_WAIT_L(0); PG8_MMA(0, 1, At, B1); PG8_BAR;
            PG8_LDA(At, 0, 1); PG8_STAGE(PG8_SA(0, 0), a2, voffA);
            PG8_BAR; PG8_WAIT_L(0); PG8_MMA(1, 0, At, B0); PG8_BAR; PG8_SCHED;
            PG8_STAGE(PG8_SB(0, 1), b2 + hstep, voffB);
            PG8_WAIT_V(6); PG8_BAR; PG8_MMA(1, 1, At, B1); PG8_BAR;
            PG8_LDB(B0, 1, 0); PG8_SCHED; PG8_LDA(At, 1, 0); PG8_STAGE(PG8_SA(0, 1), a2 + hstep, voffA);
            PG8_WAIT_L(8); PG8_BAR; PG8_WAIT_L(0); PG8_MMA(0, 0, At, B0); PG8_BAR; PG8_SCHED;
            PG8_LDB(B1, 1, 1); PG8_STAGE(PG8_SB(1, 0), b3, voffB);
            PG8_BAR; PG8_WAIT_L(0); PG8_MMA(0, 1, At, B1); PG8_BAR;
            PG8_LDA(At, 1, 1); PG8_STAGE(PG8_SA(1, 0), a3, voffA);
            PG8_BAR; PG8_WAIT_L(0); PG8_MMA(1, 0, At, B0); PG8_BAR; PG8_SCHED;
            PG8_STAGE(PG8_SB(1, 1), b3 + hstep, voffB);
            PG8_WAIT_V(6); PG8_BAR; PG8_MMA(1, 1, At, B1); PG8_BAR;
            }
        }
        if constexpr (ALIGN_EPI) { if (wr == 0) PG8_BAR; }
        if constexpr (!Epi::AFTER_DRAIN) { E(acc, cur, wr, wc, fr, fq); S.done(cur); }
        if (!has_next) break;
#pragma unroll
        for (int a = 0; a < 2; ++a)
#pragma unroll
            for (int b = 0; b < 2; ++b)
#pragma unroll
                for (int m = 0; m < 4; ++m)
#pragma unroll
                    for (int n = 0; n < 2; ++n) acc[a][b][m][n] = (f32x4){0.f, 0.f, 0.f, 0.f};
        cur = nxt; cA = nA; cB = nB; ++ui;
        if constexpr (ALIGN_EPI) { if (wr == 1) PG8_BAR; }
    }
    PG8_WAIT_V(0);
    if constexpr (!ALIGN_EPI) { if (wr == 0) PG8_BAR; }
    PG8_BAR;
    if constexpr (Epi::AFTER_DRAIN) { E.fused(acc, cur, wr, wc, fr, fq, lds, wid, lane); S.done(cur); }
#undef PG8_SA
#undef PG8_SB
#undef PG8_STAGE
#undef PG8_LDA
#undef PG8_LDB
#undef PG8_MMA
#undef PG8_WAIT_V
#undef PG8_WAIT_L
#undef PG8_BAR
#undef PG8_SCHED
}
}
#define GAS __attribute__((address_space(1)))
#define LAS __attribute__((address_space(3)))
#define XB_TMO      128
#define XB_XCNT(j)  (256  + 64 * (j))
#define XB_XSUB(j)  (1280 + 64 * (j))
#define XB_XGEN(j)  (2304 + 64 * (j))
#define XB_TOP      3328
#define XB_TOPGEN   3392
#define XCD_BAR_WORDS 3456
#define XB_SPIN_CAP (1u << 18)

__device__ __forceinline__ unsigned xb_ld(unsigned* p)              { return __hip_atomic_load(p, __ATOMIC_RELAXED, __HIP_MEMORY_SCOPE_AGENT); }
__device__ __forceinline__ unsigned xb_add(unsigned* p, unsigned v) { return __hip_atomic_fetch_add(p, v, __ATOMIC_RELAXED, __HIP_MEMORY_SCOPE_AGENT); }
__device__ __forceinline__ unsigned xb_xcc_id() { return (unsigned)__builtin_amdgcn_s_getreg((3 << 11) | 20) & 0xFu; }
#define XB_SPIN(cond, bar) do { unsigned _sp = 0; while (cond) { __builtin_amdgcn_s_sleep(1); \
    if ((++_sp & 255u) == 0u) { if (xb_ld(&(bar)[XB_TMO])) break; if (_sp > XB_SPIN_CAP) { atomicAdd(&(bar)[XB_TMO], 1u); break; } } } } while (0)

struct XcdBarrier {
    unsigned* bar; unsigned x;
    volatile LAS unsigned* st;
};

__device__ __forceinline__ XcdBarrier xcd_barrier_post(unsigned* bar, volatile LAS unsigned* st) {
    XcdBarrier b; b.bar = bar; b.x = xb_xcc_id(); b.st = st;
    if (threadIdx.x == 0) (void)xb_add(&bar[XB_XCNT(b.x)], 1u);
    return b;
}
__device__ __forceinline__ void xcd_barrier_complete(unsigned* bar, unsigned x, unsigned& nloc, unsigned& nx) {
    const unsigned G = gridDim.x * gridDim.y * gridDim.z;
    unsigned sum, cnt, mine, sp = 0u;
    for (;;) {
        sum = 0u; cnt = 0u; mine = 0u;
#pragma unroll
        for (unsigned j = 0; j < 16; ++j) { const unsigned c = xb_ld(&bar[XB_XCNT(j)]); sum += c; cnt += (c > 0u) ? 1u : 0u; mine = (j == x) ? c : mine; }
        if (sum == G) break;
        __builtin_amdgcn_s_sleep(1);
        if ((++sp & 255u) == 0u) { if (xb_ld(&bar[XB_TMO])) break; if (sp > XB_SPIN_CAP) { atomicAdd(&bar[XB_TMO], 1u); break; } }
    }
    nloc = mine > 0u ? mine : 1u; nx = cnt > 0u ? cnt : 1u;
}

__device__ __forceinline__ void xcd_barrier(const XcdBarrier& b) {
    asm volatile("s_waitcnt vmcnt(0)" ::: "memory");
    __syncthreads();
    if (threadIdx.x == 0) {
        unsigned* bar = b.bar;
        __builtin_amdgcn_s_waitcnt(0);
        unsigned nloc = b.st[0], nx = b.st[1];
        if (nloc == 0u) { xcd_barrier_complete(bar, b.x, nloc, nx); b.st[0] = nloc; b.st[1] = nx; }
        const unsigned old = xb_add(&bar[XB_XSUB(b.x)], 1u);
        const unsigned gen = old / nloc;
        if (old + 1u == (gen + 1u) * nloc) {
            __builtin_amdgcn_fence(__ATOMIC_RELEASE, "agent");
            asm volatile("s_waitcnt vmcnt(0)" ::: "memory");
            const unsigned og = xb_add(&bar[XB_TOP], 1u);
            const unsigned tg = og / nx;
            if (og + 1u == (tg + 1u) * nx) xb_add(&bar[XB_TOPGEN], 1u);
            else XB_SPIN(xb_ld(&bar[XB_TOPGEN]) == tg, bar);
            __builtin_amdgcn_fence(__ATOMIC_ACQUIRE, "agent");
            xb_add(&bar[XB_XGEN(b.x)], 1u);
            asm volatile("s_waitcnt vmcnt(0)" ::: "memory");
        } else {
            XB_SPIN(xb_ld(&bar[XB_XGEN(b.x)]) == gen, bar);
            __builtin_amdgcn_fence(__ATOMIC_ACQUIRE, "agent");
            asm volatile("s_waitcnt vmcnt(0)" ::: "memory");
        }
    }
    __syncthreads();
}

namespace cg = cooperative_groups;
typedef unsigned short bf16;
typedef unsigned v4u __attribute__((ext_vector_type(4)));
typedef unsigned v2u __attribute__((ext_vector_type(2)));
typedef float f32x4 __attribute__((ext_vector_type(4)));
typedef float f32x2 __attribute__((ext_vector_type(2)));
typedef short bf16x8 __attribute__((ext_vector_type(8)));
#define LDS_WAIT() asm volatile("s_waitcnt lgkmcnt(0)" ::: "memory")

constexpr int DM = 1024, NB = 8, SEQ = 2048, DECB = 128, DECS = 4;
constexpr int MP = NB * SEQ, MS = DECB * DECS, MT = MP + MS, MPAD = 17152;
constexpr int NZ1 = 5376, NIN = 7424, DFF = 2816;
constexpr int ZR = 0, ZK = 1024, ZV = 2048, ZWL = 3072, ZAL = 3136, ZGL = 3200, ZXB = 3328, ZGB = 4352;
constexpr float ALPHA = 1.189207115002721f;
constexpr float LN_EPS = 1e-5f, GN_EPS = 64e-5f;

constexpr size_t MiB = 1u << 20;
constexpr size_t WS_CTL = 0, CTL_ZERO_BYTES = 65536;
constexpr int CW_BAR = 1024;
constexpr size_t WS_WOT = 1 * MiB;
constexpr size_t WS_SMALL = 3 * MiB;
constexpr size_t WS_XB = 4 * MiB;
constexpr size_t WS_Z1 = 38 * MiB;
constexpr size_t WS_WINT = 214 * MiB;
constexpr size_t WS_BONUS = 214 * MiB;
constexpr size_t WS_H1 = 38 * MiB;
constexpr size_t WS_H1B = 104 * MiB;
constexpr size_t WS_WGUT = 137 * MiB;
constexpr size_t WS_WDT = 148 * MiB;
constexpr size_t WS_ACT = 154 * MiB;
constexpr size_t O_Y = 0, O_SHP = 17301504, O_WKVP = 17309696, O_CONVP = 17833984, O_LRUP = 17858560,
                 O_SHS = 17866752, O_WKVS = 17997824, O_CONVS = 26386432, O_LRUS = 26779648;

constexpr int LDS_BYTES = 163840, MISC_OFF = LDS_BYTES - 64;

struct Params { const float* in[33]; float* out; unsigned char* ws; int never; int pad; };
typedef const __attribute__((address_space(4))) Params CP;
__device__ __forceinline__ CP* launder(CP* q) { asm volatile("" : "+s"(q)); return q; }
enum { I_XP = 0, I_XS, I_SHIFT, I_WKV, I_CONV, I_LRU, I_WIN, I_MU, I_W0, I_W2, I_A0, I_A2, I_G2, I_KK, I_KA, I_RK, I_LNXG, I_LNXB,
       I_CW, I_CB, I_WA, I_BA, I_WI, I_BI, I_LAM, I_WO, I_LN1G, I_LN1B, I_WG, I_WU, I_WD, I_LN2G, I_LN2B };

__device__ __forceinline__ float bf2f(unsigned b) { return __uint_as_float(b << 16); }
__device__ __forceinline__ unsigned f2bf(float f) { unsigned u = __float_as_uint(f); return (u + 0x7fffu + ((u >> 16) & 1u)) >> 16; }
__device__ __forceinline__ unsigned pk2(float lo, float hi) { return f2bf(lo) | (f2bf(hi) << 16); }
__device__ __forceinline__ float lo16(unsigned u) { return __uint_as_float(u << 16); }
__device__ __forceinline__ float hi16(unsigned u) { return __uint_as_float(u & 0xffff0000u); }
__device__ __forceinline__ float sigm(float x) { return __builtin_amdgcn_rcpf(1.f + __expf(-x)); }
__device__ __forceinline__ float tanh_(float x) { return 1.f - 2.f * __builtin_amdgcn_rcpf(__expf(2.f * x) + 1.f); }
__device__ __forceinline__ float gelu_tanh(float x) { return 0.5f * x * (1.f + tanh_(0.7978845608028654f * (x + 0.044715f * x * x * x))); }
template <int CTRL> __device__ __forceinline__ float dpp_add(float v) {
    return v + __int_as_float(__builtin_amdgcn_update_dpp(0, __float_as_int(v), CTRL, 0xF, 0xF, true)); }
__device__ __forceinline__ float allred8(float v) { v = dpp_add<0xB1>(v); v = dpp_add<0x4E>(v); v = dpp_add<0x141>(v); return v; }
__device__ __forceinline__ float allred16(float v) { v = allred8(v); v = dpp_add<0x140>(v); return v; }
__device__ __forceinline__ float wave_sum(float v) {
#pragma unroll
    for (int o = 1; o < 64; o <<= 1) v += __shfl_xor(v, o);
    return v; }
#define UNPACK8(q, f) do { f[0] = lo16(q.x); f[1] = hi16(q.x); f[2] = lo16(q.y); f[3] = hi16(q.y); f[4] = lo16(q.z); f[5] = hi16(q.z); f[6] = lo16(q.w); f[7] = hi16(q.w); } while (0)

__device__ __forceinline__ void transpose_item(const float* W, int N, bf16* WT, int ldT, int k0, int n0, int drow0, LAS float* scr, int lane) {
#pragma unroll 8
    for (int i = 0; i < 32; ++i) { const int kk = 2 * i + (lane >> 5); scr[kk * 33 + (lane & 31)] = W[(size_t)(k0 + kk) * N + n0 + (lane & 31)]; }
    LDS_WAIT();
    const int c = lane & 7;
#pragma unroll
    for (int j = 0; j < 4; ++j) { const int n = (lane >> 3) + 8 * j; const LAS float* s = scr + (8 * c) * 33 + n;
        v4u o; o.x = pk2(s[0 * 33], s[1 * 33]); o.y = pk2(s[2 * 33], s[3 * 33]); o.z = pk2(s[4 * 33], s[5 * 33]); o.w = pk2(s[6 * 33], s[7 * 33]);
        *(v4u*)(WT + (size_t)(drow0 + n) * ldT + k0 + 8 * c) = o; }
    LDS_WAIT();
}

__device__ __forceinline__ void phase0(CP& p, LAS unsigned char* lds) {
    int tid_l = threadIdx.x; asm volatile("" : "+v"(tid_l)); const int tid = tid_l, wave = tid >> 6, lane = tid & 63;
    const int gw = blockIdx.x * 8 + wave, NGW = gridDim.x * 8;
    bf16* Xb = (bf16*)(p.ws + WS_XB);
    for (int m = gw; m < MPAD; m += NGW) {
        const float* src = m < MP ? p.in[I_XP] + (size_t)m * DM : (m < MT ? p.in[I_XS] + (size_t)(m - MP) * DM : (m < MT + DECB ? p.in[I_SHIFT] + (size_t)(m - MT) * DM : nullptr));
        f32x4 v[4];
#pragma unroll
        for (int j = 0; j < 4; ++j) v[j] = src ? *(const f32x4*)(src + 4 * lane + 256 * j) : (f32x4){0.f, 0.f, 0.f, 0.f};
        unsigned long long* o8 = (unsigned long long*)(Xb + (size_t)m * DM) + lane;
#pragma unroll
        for (int j = 0; j < 4; ++j) o8[64 * j] = (unsigned long long)pk2(v[j].x, v[j].y) | ((unsigned long long)pk2(v[j].z, v[j].w) << 32);
        float* so = nullptr;
        if (m < MP) { if ((m & (SEQ - 1)) == SEQ - 1) so = p.out + O_SHP + (size_t)(m >> 11) * DM; }
        else if (m < MT) { if (((m - MP) & 3) == 3) so = p.out + O_SHS + (size_t)((m - MP) >> 2) * DM; }
        if (so) {
#pragma unroll
            for (int j = 0; j < 4; ++j) *(f32x4*)(so + 4 * lane + 256 * j) = v[j]; }
    }
    LAS float* scr = (LAS float*)(lds + wave * 16384);
    bf16* WinT = (bf16*)(p.ws + WS_WINT); bf16* WoT = (bf16*)(p.ws + WS_WOT);
    bf16* w2T = (bf16*)(p.ws + WS_SMALL); bf16* a2T = w2T + 65536; bf16* g2T = w2T + 131072; bf16* waT = w2T + 262144; bf16* wiT = w2T + 327680;
    constexpr int N_WIN = 16 * 232, N_WO = 16 * 32, N_L = 32, N_G = 64, N_B = 32;
    constexpr int NITEMS = N_WIN + N_WO + 2 * N_L + N_G + 2 * N_B;
    for (int it = gw; it < NITEMS; it += NGW) {
        int r = it;
        if (r < N_WIN) { transpose_item(p.in[I_WIN], NIN, WinT, 1024, 64 * (r / 232), 32 * (r % 232), 32 * (r % 232), scr, lane); continue; } r -= N_WIN;
        if (r < N_WO) { transpose_item(p.in[I_WO], 1024, WoT, 1024, 64 * (r / 32), 32 * (r % 32), 32 * (r % 32), scr, lane); continue; } r -= N_WO;
        if (r < N_L) { transpose_item(p.in[I_W2], 1024, w2T, 64, 0, 32 * r, 32 * r, scr, lane); continue; } r -= N_L;
        if (r < N_L) { transpose_item(p.in[I_A2], 1024, a2T, 64, 0, 32 * r, 32 * r, scr, lane); continue; } r -= N_L;
        if (r < N_G) { transpose_item(p.in[I_G2], 1024, g2T, 128, 64 * (r / 32), 32 * (r % 32), 32 * (r % 32), scr, lane); continue; } r -= N_G;
        if (r < N_B) { transpose_item(p.in[I_WA] + (r >> 1) * 4096, 64, waT + (r >> 1) * 4096, 64, 0, 32 * (r & 1), 32 * (r & 1), scr, lane); continue; } r -= N_B;
        transpose_item(p.in[I_WI] + (r >> 1) * 4096, 64, wiT + (r >> 1) * 4096, 64, 0, 32 * (r & 1), 32 * (r & 1), scr, lane);
    }
}
__device__ __forceinline__ void phase_convert_ffn(CP& p, LAS unsigned char* lds) {
    int tid_l = threadIdx.x; asm volatile("" : "+v"(tid_l)); const int tid = tid_l, wave = tid >> 6, lane = tid & 63;
    const int gw = blockIdx.x * 8 + wave, NGW = gridDim.x * 8;
    LAS float* scr = (LAS float*)(lds + wave * 16384);
    bf16* WguT = (bf16*)(p.ws + WS_WGUT); bf16* WdT = (bf16*)(p.ws + WS_WDT);
    constexpr int N_G = 16 * 88, N_D = 44 * 32;
    for (int it = gw; it < 2 * N_G + N_D; it += NGW) {
        int r = it;
        if (r < N_G) { const int n0 = 32 * (r % 88); transpose_item(p.in[I_WG], DFF, WguT, 1024, 64 * (r / 88), n0, 256 * (n0 >> 7) + (n0 & 127), scr, lane); continue; } r -= N_G;
        if (r < N_G) { const int n0 = 32 * (r % 88); transpose_item(p.in[I_WU], DFF, WguT, 1024, 64 * (r / 88), n0, 256 * (n0 >> 7) + 128 + (n0 & 127), scr, lane); continue; } r -= N_G;
        transpose_item(p.in[I_WD], 1024, WdT, DFF, 64 * (r / 32), 32 * (r % 32), 32 * (r % 32), scr, lane);
    }
}

struct EpiZ {
    static constexpr bool PERM = true, AFTER_DRAIN = false;
    bf16* Z1; bf16* Zg;
    __device__ __forceinline__ void operator()(const pg8::f32x4 (&acc)[2][2][4][2], const pg8::Unit& u, int wr, int wc, int fr, int fq) const {
        bf16* base; int ldc, colt;
        if (u.pn < 21) { base = Z1; ldc = NZ1; colt = u.pn * 256; } else { if (u.pm >= 66) return; base = Zg; ldc = 2048; colt = (u.pn - 21) * 256; }
        const int row0 = u.pm * 256 + wr * 64 + fr, col0 = colt + wc * 32 + 8 * fq;
#pragma unroll
        for (int ai = 0; ai < 2; ++ai)
#pragma unroll
            for (int m = 0; m < 4; ++m) { bf16* rowp = base + (size_t)(row0 + ai * 128 + m * 16) * ldc + col0;
#pragma unroll
                for (int bj = 0; bj < 2; ++bj) { const pg8::f32x4 v0 = acc[ai][bj][m][0], v1 = acc[ai][bj][m][1];
                    v4u w; w.x = pg8::cvt_pk_bf16(v0[0], v0[1]); w.y = pg8::cvt_pk_bf16(v0[2], v0[3]); w.z = pg8::cvt_pk_bf16(v1[0], v1[1]); w.w = pg8::cvt_pk_bf16(v1[2], v1[3]);
                    *(v4u*)(rowp + bj * 128) = w; } }
    }
};
struct EpiRes {
    static constexpr bool PERM = false, AFTER_DRAIN = false;
    const float* resA; const float* resB; float* out;
    __device__ __forceinline__ void operator()(const pg8::f32x4 (&acc)[2][2][4][2], const pg8::Unit& u, int wr, int wc, int fr, int fq) const {
        const int row0 = u.pm * 256 + wr * 64 + fr, col0 = u.pn * 256 + wc * 32 + 4 * fq;
#pragma unroll
        for (int ai = 0; ai < 2; ++ai)
#pragma unroll
            for (int m = 0; m < 4; ++m) { const int row = row0 + ai * 128 + m * 16;
                const float* rp = (row < MP ? resA + (size_t)row * DM : resB + (size_t)(row - MP) * DM) + col0; float* op = out + (size_t)row * DM + col0;
#pragma unroll
                for (int bj = 0; bj < 2; ++bj)
#pragma unroll
                    for (int n = 0; n < 2; ++n) { const pg8::f32x4 x = *(const pg8::f32x4*)(rp + bj * 128 + n * 16); *(pg8::f32x4*)(op + bj * 128 + n * 16) = acc[ai][bj][m][n] + x * ALPHA; } }
    }
};
struct EpiSwi {
    static constexpr bool PERM = true, AFTER_DRAIN = false;
    bf16* O;
    __device__ __forceinline__ void operator()(const pg8::f32x4 (&acc)[2][2][4][2], const pg8::Unit& u, int wr, int wc, int fr, int fq) const {
        const int row0 = u.pm * 256 + wr * 64 + fr, col0 = u.pn * 128 + wc * 32 + 8 * fq;
#pragma unroll
        for (int ai = 0; ai < 2; ++ai)
#pragma unroll
            for (int m = 0; m < 4; ++m) { bf16* rowp = O + (size_t)(row0 + ai * 128 + m * 16) * DFF + col0;
                float o[8];
#pragma unroll
                for (int n = 0; n < 2; ++n)
#pragma unroll
                    for (int j = 0; j < 4; ++j) { const float g = acc[ai][0][m][n][j], uu = acc[ai][1][m][n][j]; o[4 * n + j] = g * sigm(g) * uu; }
                v4u w; w.x = pg8::cvt_pk_bf16(o[0], o[1]); w.y = pg8::cvt_pk_bf16(o[2], o[3]); w.z = pg8::cvt_pk_bf16(o[4], o[5]); w.w = pg8::cvt_pk_bf16(o[6], o[7]);
                *(v4u*)rowp = w; }
    }
};

constexpr int OPS = 68;
constexpr int L_NKK = 0, L_WR = 17408, L_W = 34816, L_B = 52224, L_KP = 69632, L_VL = 87040, L_SC = 95232, L_YB = 95744, L_RAW = 103936, L_RAWL = 128896;
__device__ __forceinline__ void wkv_prompt(CP& p, LAS unsigned char* lds, int unit) {
    int tid_l = threadIdx.x; asm volatile("" : "+v"(tid_l)); const int tid = tid_l, wave = tid >> 6, lane = tid & 63;
    const int bh = unit >> 1, half = unit & 1, b = bh >> 4, h = bh & 15;
    const int rl = wave * 4 + (lane >> 4), s = lane & 15;
    const int ptok = tid >> 3, pcg = tid & 7;
    bf16* Z1 = (bf16*)(p.ws + WS_Z1); bf16* BON = (bf16*)(p.ws + WS_BONUS);
    const bf16* w2T = (const bf16*)(p.ws + WS_SMALL); const bf16* a2T = w2T + 65536;
    const size_t rowbase = (size_t)b * SEQ;
    LAS bf16* RAW = (LAS bf16*)(lds + L_RAW); LAS bf16* RAWL = (LAS bf16*)(lds + L_RAWL);
    LAS float* ONKK = (LAS float*)(lds + L_NKK); LAS float* OWR = (LAS float*)(lds + L_WR); LAS float* OW = (LAS float*)(lds + L_W);
    LAS float* OB = (LAS float*)(lds + L_B); LAS float* OKP = (LAS float*)(lds + L_KP); LAS float* VL = (LAS float*)(lds + L_VL);
    LAS float* SC = (LAS float*)(lds + L_SC); LAS float* YB = (LAS float*)(lds + L_YB);
    if (tid < 96) ((LAS unsigned*)RAW)[tid] = 0u;
    if (tid < 64) ((LAS unsigned*)RAWL)[tid] = 0u;
    float S0 = 0.f, S1 = 0.f, S2 = 0.f, S3 = 0.f;
    const int C0 = h * 64 + 8 * pcg;
    const bool vmine = (pcg >> 2) == half;
    v4u pr, pk, pv, pl0, pl1;
    { const bf16* z = Z1 + (rowbase + ptok) * NZ1;
      pr = *(const v4u*)(z + ZR + C0); pk = *(const v4u*)(z + ZK + C0); pv = vmine ? *(const v4u*)(z + ZV + C0) : (v4u){0u, 0u, 0u, 0u};
      pl0 = *(const v4u*)(z + ZWL + 16 * pcg); pl1 = *(const v4u*)(z + ZWL + 16 * pcg + 8); }
    for (int c = 0; c < SEQ / 64; ++c) {
        if (ptok == 63 && c > 0) {
            *(LAS v4u*)(RAW + 0 + 8 * pcg) = *(LAS v4u*)(RAW + 64 * 192 + 8 * pcg); *(LAS v4u*)(RAW + 64 + 8 * pcg) = *(LAS v4u*)(RAW + 64 * 192 + 64 + 8 * pcg);
            *(LAS v4u*)(RAW + 128 + 8 * pcg) = *(LAS v4u*)(RAW + 64 * 192 + 128 + 8 * pcg);
            *(LAS v4u*)(RAWL + 16 * pcg) = *(LAS v4u*)(RAWL + 64 * 128 + 16 * pcg); *(LAS v4u*)(RAWL + 16 * pcg + 8) = *(LAS v4u*)(RAWL + 64 * 128 + 16 * pcg + 8); }
        { LAS bf16* rr = RAW + (ptok + 1) * 192; *(LAS v4u*)(rr + 8 * pcg) = pr; *(LAS v4u*)(rr + 64 + 8 * pcg) = pk; *(LAS v4u*)(rr + 128 + 8 * pcg) = pv;
          LAS bf16* rl2 = RAWL + (ptok + 1) * 128; *(LAS v4u*)(rl2 + 16 * pcg) = pl0; *(LAS v4u*)(rl2 + 16 * pcg + 8) = pl1; }
        __syncthreads();
        if (c + 1 < SEQ / 64) { const bf16* z = Z1 + (rowbase + (size_t)(c + 1) * 64 + ptok) * NZ1;
            pr = *(const v4u*)(z + ZR + C0); pk = *(const v4u*)(z + ZK + C0); if (vmine) pv = *(const v4u*)(z + ZV + C0);
            pl0 = *(const v4u*)(z + ZWL + 16 * pcg); pl1 = *(const v4u*)(z + ZWL + 16 * pcg + 8); }
        { const int tb = wave & 3, nh = wave >> 2, fr = lane & 15, q = lane >> 4, ti = 16 * tb + fr;
          bf16x8 aw[2], aa[2];
#pragma unroll
          for (int ks = 0; ks < 2; ++ks) {
              const int ko = 32 * ks + 8 * q;
              { const v4u cu = *(LAS v4u*)(RAWL + (ti + 1) * 128 + ko), pu = *(LAS v4u*)(RAWL + ti * 128 + ko); float cf[8], pf[8]; UNPACK8(cu, cf); UNPACK8(pu, pf);
                const f32x4 m0 = *(const f32x4*)(p.in[I_MU] + ZWL + ko), m1 = *(const f32x4*)(p.in[I_MU] + ZWL + ko + 4); float o[8];
#pragma unroll
                for (int e = 0; e < 8; ++e) { const float mu = e < 4 ? m0[e & 3] : m1[e & 3]; o[e] = tanh_(cf[e] + mu * (pf[e] - cf[e])); }
                v4u w; w.x = pk2(o[0], o[1]); w.y = pk2(o[2], o[3]); w.z = pk2(o[4], o[5]); w.w = pk2(o[6], o[7]); aw[ks] = __builtin_bit_cast(bf16x8, w); }
              { const v4u cu = *(LAS v4u*)(RAWL + (ti + 1) * 128 + 64 + ko), pu = *(LAS v4u*)(RAWL + ti * 128 + 64 + ko); float cf[8], pf[8]; UNPACK8(cu, cf); UNPACK8(pu, pf);
                const f32x4 m0 = *(const f32x4*)(p.in[I_MU] + ZAL + ko), m1 = *(const f32x4*)(p.in[I_MU] + ZAL + ko + 4); float o[8];
#pragma unroll
                for (int e = 0; e < 8; ++e) { const float mu = e < 4 ? m0[e & 3] : m1[e & 3]; o[e] = cf[e] + mu * (pf[e] - cf[e]); }
                v4u w; w.x = pk2(o[0], o[1]); w.y = pk2(o[2], o[3]); w.z = pk2(o[4], o[5]); w.w = pk2(o[6], o[7]); aa[ks] = __builtin_bit_cast(bf16x8, w); }
          }
#pragma unroll
          for (int nbi = 0; nbi < 2; ++nbi) {
              const int nb = 2 * nh + nbi, n = h * 64 + 16 * nb + fr;
              f32x4 cw = {0.f, 0.f, 0.f, 0.f}, ca = {0.f, 0.f, 0.f, 0.f};
#pragma unroll
              for (int ks = 0; ks < 2; ++ks) {
                  const bf16x8 bw = *(const bf16x8*)(w2T + (size_t)n * 64 + 32 * ks + 8 * q), ba = *(const bf16x8*)(a2T + (size_t)n * 64 + 32 * ks + 8 * q);
                  cw = __builtin_amdgcn_mfma_f32_16x16x32_bf16(aw[ks], bw, cw, 0, 0, 0); ca = __builtin_amdgcn_mfma_f32_16x16x32_bf16(aa[ks], ba, ca, 0, 0, 0); }
#pragma unroll
              for (int r = 0; r < 4; ++r) { const int tok = 16 * tb + 4 * q + r; OW[tok * OPS + 16 * nb + fr] = cw[r]; OB[tok * OPS + 16 * nb + fr] = ca[r]; }
          }
        }
        __syncthreads();
        { float rc[8], kc[8], vc[8], t8[8];
          { const v4u cu = *(LAS v4u*)(RAW + (ptok + 1) * 192 + 8 * pcg), pu = *(LAS v4u*)(RAW + ptok * 192 + 8 * pcg); UNPACK8(cu, rc); UNPACK8(pu, t8);
            const f32x4 m0 = *(const f32x4*)(p.in[I_MU] + ZR + C0), m1 = *(const f32x4*)(p.in[I_MU] + ZR + C0 + 4);
#pragma unroll
            for (int e = 0; e < 8; ++e) rc[e] += (e < 4 ? m0[e & 3] : m1[e & 3]) * (t8[e] - rc[e]); }
          { const v4u cu = *(LAS v4u*)(RAW + (ptok + 1) * 192 + 64 + 8 * pcg), pu = *(LAS v4u*)(RAW + ptok * 192 + 64 + 8 * pcg); UNPACK8(cu, kc); UNPACK8(pu, t8);
            const f32x4 m0 = *(const f32x4*)(p.in[I_MU] + ZK + C0), m1 = *(const f32x4*)(p.in[I_MU] + ZK + C0 + 4);
#pragma unroll
            for (int e = 0; e < 8; ++e) kc[e] += (e < 4 ? m0[e & 3] : m1[e & 3]) * (t8[e] - kc[e]); }
          { const v4u cu = *(LAS v4u*)(RAW + (ptok + 1) * 192 + 128 + 8 * pcg), pu = *(LAS v4u*)(RAW + ptok * 192 + 128 + 8 * pcg); UNPACK8(cu, vc); UNPACK8(pu, t8);
            const f32x4 m0 = *(const f32x4*)(p.in[I_MU] + ZV + C0), m1 = *(const f32x4*)(p.in[I_MU] + ZV + C0 + 4);
#pragma unroll
            for (int e = 0; e < 8; ++e) vc[e] += (e < 4 ? m0[e & 3] : m1[e & 3]) * (t8[e] - vc[e]); }
          float dec[8], av[8], kku[8], kp[8];
          { const f32x4 wa0 = *(LAS f32x4*)(OW + ptok * OPS + 8 * pcg), wa1 = *(LAS f32x4*)(OW + ptok * OPS + 8 * pcg + 4);
            const f32x4 aa0 = *(LAS f32x4*)(OB + ptok * OPS + 8 * pcg), aa1 = *(LAS f32x4*)(OB + ptok * OPS + 8 * pcg + 4);
            const f32x4 w00 = *(const f32x4*)(p.in[I_W0] + C0), w01 = *(const f32x4*)(p.in[I_W0] + C0 + 4);
            const f32x4 a00 = *(const f32x4*)(p.in[I_A0] + C0), a01 = *(const f32x4*)(p.in[I_A0] + C0 + 4);
            const f32x4 kk0 = *(const f32x4*)(p.in[I_KK] + C0), kk1 = *(const f32x4*)(p.in[I_KK] + C0 + 4);
            const f32x4 ka0 = *(const f32x4*)(p.in[I_KA] + C0), ka1 = *(const f32x4*)(p.in[I_KA] + C0 + 4);
#pragma unroll
            for (int e = 0; e < 8; ++e) {
                const float wl = (e < 4 ? w00[e & 3] : w01[e & 3]) + (e < 4 ? wa0[e & 3] : wa1[e & 3]);
                dec[e] = __expf(-0.6065306597126334f * sigm(wl));
                av[e] = sigm((e < 4 ? a00[e & 3] : a01[e & 3]) + (e < 4 ? aa0[e & 3] : aa1[e & 3]));
                kku[e] = kc[e] * (e < 4 ? kk0[e & 3] : kk1[e & 3]);
                kp[e] = kc[e] * (1.f + (av[e] - 1.f) * (e < 4 ? ka0[e & 3] : ka1[e & 3])); } }
          float ss = 0.f;
#pragma unroll
          for (int e = 0; e < 8; ++e) ss += kku[e] * kku[e];
          ss = allred8(ss);
          const float inv = 1.f / fmaxf(sqrtf(ss), 1e-12f);
          const f32x4 rk0 = *(const f32x4*)(p.in[I_RK] + C0), rk1 = *(const f32x4*)(p.in[I_RK] + C0 + 4);
          float nk[8], bb[8], wr8[8], br = 0.f, kr = 0.f, bon = 0.f;
#pragma unroll
          for (int e = 0; e < 8; ++e) { const float kk = kku[e] * inv; nk[e] = -kk; bb[e] = kk * av[e]; wr8[e] = dec[e] * rc[e];
              br += bb[e] * rc[e]; kr += kp[e] * rc[e]; bon += rc[e] * kp[e] * (e < 4 ? rk0[e & 3] : rk1[e & 3]); }
          br = allred8(br); kr = allred8(kr); bon = allred8(bon);
          const int o = ptok * OPS + 8 * pcg;
          *(LAS f32x4*)(ONKK + o) = (f32x4){nk[0], nk[1], nk[2], nk[3]}; *(LAS f32x4*)(ONKK + o + 4) = (f32x4){nk[4], nk[5], nk[6], nk[7]};
          *(LAS f32x4*)(OWR + o) = (f32x4){wr8[0], wr8[1], wr8[2], wr8[3]}; *(LAS f32x4*)(OWR + o + 4) = (f32x4){wr8[4], wr8[5], wr8[6], wr8[7]};
          *(LAS f32x4*)(OW + o) = (f32x4){dec[0], dec[1], dec[2], dec[3]}; *(LAS f32x4*)(OW + o + 4) = (f32x4){dec[4], dec[5], dec[6], dec[7]};
          *(LAS f32x4*)(OB + o) = (f32x4){bb[0], bb[1], bb[2], bb[3]}; *(LAS f32x4*)(OB + o + 4) = (f32x4){bb[4], bb[5], bb[6], bb[7]};
          *(LAS f32x4*)(OKP + o) = (f32x4){kp[0], kp[1], kp[2], kp[3]}; *(LAS f32x4*)(OKP + o + 4) = (f32x4){kp[4], kp[5], kp[6], kp[7]};
          if (pcg == 0) *(LAS f32x2*)(SC + 2 * ptok) = (f32x2){br, kr};
          if (vmine) { const int vo = ptok * 32 + 8 * (pcg & 3);
              *(LAS f32x4*)(VL + vo) = (f32x4){vc[0], vc[1], vc[2], vc[3]}; *(LAS f32x4*)(VL + vo + 4) = (f32x4){vc[4], vc[5], vc[6], vc[7]};
              v4u w; w.x = pk2(bon * vc[0], bon * vc[1]); w.y = pk2(bon * vc[2], bon * vc[3]); w.z = pk2(bon * vc[4], bon * vc[5]); w.w = pk2(bon * vc[6], bon * vc[7]);
              *(v4u*)(BON + (rowbase + (size_t)c * 64 + ptok) * DM + C0) = w; }
        }
        __syncthreads();
        { const LAS float* a0 = ONKK + 4 * s; const LAS float* a1 = OWR + 4 * s; const LAS float* a2 = OW + 4 * s; const LAS float* a3 = OB + 4 * s; const LAS float* a4 = OKP + 4 * s;
#pragma unroll 4
          for (int t = 0; t < 64; ++t) {
              const f32x4 nk = *(const LAS f32x4*)(a0 + t * OPS), wrv = *(const LAS f32x4*)(a1 + t * OPS), wv = *(const LAS f32x4*)(a2 + t * OPS),
                          bv = *(const LAS f32x4*)(a3 + t * OPS), kv = *(const LAS f32x4*)(a4 + t * OPS);
              const f32x2 sc = *(const LAS f32x2*)(SC + 2 * t); const float vi = VL[t * 32 + rl];
              float psa = S0 * nk[0] + S1 * nk[1] + S2 * nk[2] + S3 * nk[3];
              float py = S0 * wrv[0] + S1 * wrv[1] + S2 * wrv[2] + S3 * wrv[3];
              const float sa = allred16(psa), y0 = allred16(py);
              S0 = S0 * wv[0] + sa * bv[0] + vi * kv[0]; S1 = S1 * wv[1] + sa * bv[1] + vi * kv[1];
              S2 = S2 * wv[2] + sa * bv[2] + vi * kv[2]; S3 = S3 * wv[3] + sa * bv[3] + vi * kv[3];
              const float y = y0 + sa * sc[0] + vi * sc[1];
              if (s == 0) YB[t * 32 + rl] = y;
          } }
        __syncthreads();
        { const f32x4 yv = *(LAS f32x4*)(YB + ptok * 32 + 4 * pcg); v2u w; w.x = pk2(yv[0], yv[1]); w.y = pk2(yv[2], yv[3]);
          *(v2u*)(Z1 + (rowbase + (size_t)c * 64 + ptok) * NZ1 + ZV + h * 64 + 32 * half + 4 * pcg) = w; }
    }
    *(f32x4*)(p.out + O_WKVP + ((size_t)(b * 16 + h) * 64 + 32 * half + rl) * 64 + 4 * s) = (f32x4){S0, S1, S2, S3};
    __syncthreads();
}

__device__ __forceinline__ void wkv_sample(CP& p, LAS unsigned char* lds) {
    int tid_l = threadIdx.x; asm volatile("" : "+v"(tid_l)); const int tid = tid_l, lane = tid & 63;
    const int i = tid >> 3, s8 = tid & 7;
    bf16* Z1 = (bf16*)(p.ws + WS_Z1); bf16* BON = (bf16*)(p.ws + WS_BONUS);
    LAS float* TW = (LAS float*)lds; LAS float* TA = TW + 256; LAS float* ONKK = TW + 512; LAS float* OWR = TW + 768; LAS float* OW = TW + 1024;
    LAS float* OB = TW + 1280; LAS float* OKP = TW + 1536; LAS float* VV = TW + 1792; LAS float* SC = TW + 2048; LAS float* YS = TW + 2064;
    const float* Sin = p.in[I_WKV];
    int u = blockIdx.x;
    f32x4 sa0, sa1;
    if (u < DECB * 16) { const float* sp = Sin + ((size_t)u * 64 + i) * 64 + 8 * s8; sa0 = *(const f32x4*)sp; sa1 = *(const f32x4*)(sp + 4); }
    for (; u < DECB * 16; u += gridDim.x) {
        const int b = u >> 4, h = u & 15;
        float S[8] = {sa0[0], sa0[1], sa0[2], sa0[3], sa1[0], sa1[1], sa1[2], sa1[3]};
        { const int un = u + gridDim.x; if (un < DECB * 16) { const float* sp = Sin + ((size_t)un * 64 + i) * 64 + 8 * s8; sa0 = *(const f32x4*)sp; sa1 = *(const f32x4*)(sp + 4); } }
        const int tok = tid >> 6, c = lane, C = h * 64 + c;
        const size_t rowc = (size_t)MP + 4 * b + (tok & 3), rowp = (tok & 3) == 0 ? (size_t)MT + b : rowc - 1;
        float r = 0.f, k = 0.f, v = 0.f;
        if (tid < 256) {
            const bf16* zc = Z1 + rowc * NZ1; const bf16* zp = Z1 + rowp * NZ1; const float* mu = p.in[I_MU];
            r = bf2f(zc[ZR + C]); r += mu[ZR + C] * (bf2f(zp[ZR + C]) - r);
            k = bf2f(zc[ZK + C]); k += mu[ZK + C] * (bf2f(zp[ZK + C]) - k);
            v = bf2f(zc[ZV + C]); v += mu[ZV + C] * (bf2f(zp[ZV + C]) - v);
            float wl = bf2f(zc[ZWL + c]); wl += mu[ZWL + c] * (bf2f(zp[ZWL + c]) - wl);
            float al = bf2f(zc[ZAL + c]); al += mu[ZAL + c] * (bf2f(zp[ZAL + c]) - al);
            TW[tok * 64 + c] = tanh_(wl); TA[tok * 64 + c] = al;
        }
        __syncthreads();
        if (tid < 256) {
            float wp = 0.f, ap = 0.f; const float* w2 = p.in[I_W2] + C; const float* a2 = p.in[I_A2] + C;
#pragma unroll 8
            for (int kk = 0; kk < 64; ++kk) { wp += TW[tok * 64 + kk] * w2[(size_t)kk * DM]; ap += TA[tok * 64 + kk] * a2[(size_t)kk * DM]; }
            const float dec = __expf(-0.6065306597126334f * sigm(p.in[I_W0][C] + wp));
            const float a = sigm(p.in[I_A0][C] + ap);
            const float kku = k * p.in[I_KK][C];
            const float kp = k * (1.f + (a - 1.f) * p.in[I_KA][C]);
            const float ss = wave_sum(kku * kku);
            const float kk = kku / fmaxf(sqrtf(ss), 1e-12f);
            const float bb = kk * a;
            const float br = wave_sum(bb * r), kr = wave_sum(kp * r), bon = wave_sum(r * kp * p.in[I_RK][C]);
            ONKK[tok * 64 + c] = -kk; OWR[tok * 64 + c] = dec * r; OW[tok * 64 + c] = dec; OB[tok * 64 + c] = bb; OKP[tok * 64 + c] = kp; VV[tok * 64 + c] = v;
            if (c == 0) { SC[2 * tok] = br; SC[2 * tok + 1] = kr; }
            BON[rowc * DM + C] = (bf16)f2bf(bon * v);
        }
        __syncthreads();
#pragma unroll
        for (int t = 0; t < 4; ++t) {
            const f32x4 n0 = *(LAS f32x4*)(ONKK + t * 64 + 8 * s8), n1 = *(LAS f32x4*)(ONKK + t * 64 + 8 * s8 + 4);
            const f32x4 q0 = *(LAS f32x4*)(OWR + t * 64 + 8 * s8), q1 = *(LAS f32x4*)(OWR + t * 64 + 8 * s8 + 4);
            const f32x4 w0 = *(LAS f32x4*)(OW + t * 64 + 8 * s8), w1 = *(LAS f32x4*)(OW + t * 64 + 8 * s8 + 4);
            const f32x4 b0 = *(LAS f32x4*)(OB + t * 64 + 8 * s8), b1 = *(LAS f32x4*)(OB + t * 64 + 8 * s8 + 4);
            const f32x4 k0 = *(LAS f32x4*)(OKP + t * 64 + 8 * s8), k1 = *(LAS f32x4*)(OKP + t * 64 + 8 * s8 + 4);
            const float vi = VV[t * 64 + i], br = SC[2 * t], kr = SC[2 * t + 1];
            float psa = 0.f, py = 0.f;
#pragma unroll
            for (int e = 0; e < 8; ++e) { psa += S[e] * (e < 4 ? n0[e & 3] : n1[e & 3]); py += S[e] * (e < 4 ? q0[e & 3] : q1[e & 3]); }
            const float sa = allred8(psa), y0 = allred8(py);
#pragma unroll
            for (int e = 0; e < 8; ++e) S[e] = S[e] * (e < 4 ? w0[e & 3] : w1[e & 3]) + sa * (e < 4 ? b0[e & 3] : b1[e & 3]) + vi * (e < 4 ? k0[e & 3] : k1[e & 3]);
            if (s8 == 0) YS[t * 64 + i] = y0 + sa * br + vi * kr;
        }
        { float* so = p.out + O_WKVS + ((size_t)u * 64 + i) * 64 + 8 * s8; *(f32x4*)so = (f32x4){S[0], S[1], S[2], S[3]}; *(f32x4*)(so + 4) = (f32x4){S[4], S[5], S[6], S[7]}; }
        __syncthreads();
        if (tid < 256) Z1[rowc * NZ1 + ZV + C] = (bf16)f2bf(YS[tok * 64 + c]);
        __syncthreads();
    }
}

constexpr int LL_XR = 0, LL_UB = 8704, LL_UF = 17920, LL_PR = 26112, LL_PI = 34560, LL_CA = 43008, LL_CB = 45056, LL_HC = 47104;
__device__ __forceinline__ void lru_prompt(CP& p, LAS unsigned char* lds, int unit) {
    int tid_l = threadIdx.x; asm volatile("" : "+v"(tid_l)); const int tid = tid_l, wave = tid >> 6, lane = tid & 63;
    const int b = unit >> 5, n = (unit >> 1) & 15, hf = unit & 1;
    const int ptok = tid >> 3, pcg = tid & 7;
    bf16* Z1 = (bf16*)(p.ws + WS_Z1);
    const bf16* waT = (const bf16*)(p.ws + WS_SMALL) + 262144; const bf16* wiT = waT + 65536;
    const size_t rowbase = (size_t)b * SEQ;
    LAS bf16* XR = (LAS bf16*)(lds + LL_XR); LAS bf16* UB = (LAS bf16*)(lds + LL_UB); LAS float* UF = (LAS float*)(lds + LL_UF);
    LAS float* PR = (LAS float*)(lds + LL_PR); LAS float* PI = (LAS float*)(lds + LL_PI); LAS float* CA = (LAS float*)(lds + LL_CA);
    LAS float* CB = (LAS float*)(lds + LL_CB); LAS float* HC = (LAS float*)(lds + LL_HC);
    if (tid < 96) ((LAS unsigned*)XR)[tid] = 0u;
    if (tid < 32) HC[tid] = 0.f;
    const int mb = wave & 3, gate = wave >> 2, fr = lane & 15, q = lane >> 4;
    bf16x8 Bf[2][2];
#pragma unroll
    for (int nb = 0; nb < 2; ++nb)
#pragma unroll
        for (int ks = 0; ks < 2; ++ks) Bf[nb][ks] = *(const bf16x8*)((gate ? wiT : waT) + (size_t)n * 4096 + (32 * hf + 16 * nb + fr) * 64 + 32 * ks + 8 * q);
    const int dl = tid & 31, sub = tid >> 5, Cs = 64 * n + 32 * hf + dl;
    const int etok = tid >> 3, dg = tid & 7, Ce = 64 * n + 32 * hf + 4 * dg;
    const f32x4 ba4 = *(const f32x4*)(p.in[I_BA] + Ce), bi4 = *(const f32x4*)(p.in[I_BI] + Ce), lam4 = *(const f32x4*)(p.in[I_LAM] + Ce);
    f32x4 sp4;
#pragma unroll
    for (int e = 0; e < 4; ++e) sp4[e] = -8.f * __logf(1.f + __expf(-lam4[e]));
    const int Cc = 64 * n + 8 * pcg;
    v4u px = *(const v4u*)(Z1 + (rowbase + ptok) * NZ1 + ZXB + Cc);
    float hlast = 0.f;
    for (int c = 0; c < SEQ / 64; ++c) {
        if (ptok >= 61 && c > 0) *(LAS v4u*)(XR + (ptok - 61) * 64 + 8 * pcg) = *(LAS v4u*)(XR + (3 + ptok) * 64 + 8 * pcg);
        *(LAS v4u*)(XR + (3 + ptok) * 64 + 8 * pcg) = px;
        __syncthreads();
        if (c + 1 < SEQ / 64) px = *(const v4u*)(Z1 + (rowbase + (size_t)(c + 1) * 64 + ptok) * NZ1 + ZXB + Cc);
        unsigned short gbr[4];
#pragma unroll
        for (int i2 = 0; i2 < 4; ++i2) gbr[i2] = Z1[(rowbase + (size_t)c * 64 + 4 * sub + i2) * NZ1 + ZGB + Cs];
        { float u8[8];
          { const f32x4 c0 = *(const f32x4*)(p.in[I_CB] + Cc), c1 = *(const f32x4*)(p.in[I_CB] + Cc + 4);
#pragma unroll
            for (int e = 0; e < 8; ++e) u8[e] = e < 4 ? c0[e & 3] : c1[e & 3]; }
#pragma unroll
          for (int j = 0; j < 4; ++j) { const v4u xu = *(LAS v4u*)(XR + (ptok + j) * 64 + 8 * pcg); float xf[8]; UNPACK8(xu, xf);
              const f32x4 w0 = *(const f32x4*)(p.in[I_CW] + j * DM + Cc), w1 = *(const f32x4*)(p.in[I_CW] + j * DM + Cc + 4);
#pragma unroll
              for (int e = 0; e < 8; ++e) u8[e] += (e < 4 ? w0[e & 3] : w1[e & 3]) * xf[e]; }
          v4u w; w.x = pk2(u8[0], u8[1]); w.y = pk2(u8[2], u8[3]); w.z = pk2(u8[4], u8[5]); w.w = pk2(u8[6], u8[7]);
          *(LAS v4u*)(UB + ptok * 72 + 8 * pcg) = w;
          if ((pcg >> 2) == hf) { *(LAS f32x4*)(UF + ptok * 32 + 8 * (pcg & 3)) = (f32x4){u8[0], u8[1], u8[2], u8[3]}; *(LAS f32x4*)(UF + ptok * 32 + 8 * (pcg & 3) + 4) = (f32x4){u8[4], u8[5], u8[6], u8[7]}; }
        }
        __syncthreads();
        { const bf16x8 A0 = *(LAS bf16x8*)(UB + (16 * mb + fr) * 72 + 8 * q), A1 = *(LAS bf16x8*)(UB + (16 * mb + fr) * 72 + 32 + 8 * q);
          LAS float* P = gate ? PI : PR;
#pragma unroll
          for (int nb = 0; nb < 2; ++nb) { f32x4 acc = {0.f, 0.f, 0.f, 0.f};
              acc = __builtin_amdgcn_mfma_f32_16x16x32_bf16(A0, Bf[nb][0], acc, 0, 0, 0); acc = __builtin_amdgcn_mfma_f32_16x16x32_bf16(A1, Bf[nb][1], acc, 0, 0, 0);
#pragma unroll
              for (int r = 0; r < 4; ++r) P[(16 * mb + 4 * q + r) * 33 + 16 * nb + fr] = acc[r]; } }
        __syncthreads();
        {
#pragma unroll
          for (int e = 0; e < 4; ++e) { const int o = etok * 33 + 4 * dg + e;
              const float rg = sigm(PR[o] + ba4[e]), ig = sigm(PI[o] + bi4[e]);
              const float a = __expf(sp4[e] * rg);
              float mult = sqrtf(fmaxf(1.f - a * a, 0.f)); if (c == 0 && etok == 0) mult = 1.f;
              PR[o] = a; PI[o] = mult * ig * UF[etok * 32 + 4 * dg + e]; } }
        __syncthreads();
        { float av[4], bx[4];
#pragma unroll
          for (int i2 = 0; i2 < 4; ++i2) { av[i2] = PR[(4 * sub + i2) * 33 + dl]; bx[i2] = PI[(4 * sub + i2) * 33 + dl]; }
          float hl = 0.f, ap = 1.f;
#pragma unroll
          for (int i2 = 0; i2 < 4; ++i2) { hl = av[i2] * hl + bx[i2]; ap *= av[i2]; }
          CA[sub * 32 + dl] = ap; CB[sub * 32 + dl] = hl;
          float h = HC[dl];
          __syncthreads();
          for (int s2 = 0; s2 < sub; ++s2) h = CA[s2 * 32 + dl] * h + CB[s2 * 32 + dl];
#pragma unroll
          for (int i2 = 0; i2 < 4; ++i2) { h = av[i2] * h + bx[i2];
              Z1[(rowbase + (size_t)c * 64 + 4 * sub + i2) * NZ1 + ZGB + Cs] = (bf16)f2bf(h * gelu_tanh(bf2f(gbr[i2]))); }
          if (sub == 15) { HC[dl] = h; hlast = h; }
        }
        __syncthreads();
    }
    if (sub == 15) p.out[O_LRUP + (size_t)b * DM + Cs] = hlast;
    if (hf == 0 && tid < 192) { const int j = tid >> 6, cc = tid & 63; p.out[O_CONVP + ((size_t)b * 3 + j) * DM + 64 * n + cc] = bf2f(XR[(64 + j) * 64 + cc]); }
    __syncthreads();
}

__device__ __forceinline__ void lru_sample(CP& p, LAS unsigned char* lds) {
    int tid_l = threadIdx.x; asm volatile("" : "+v"(tid_l)); const int tid = tid_l;
    bf16* Z1 = (bf16*)(p.ws + WS_Z1);
    LAS float* U = (LAS float*)lds;
    for (int b = blockIdx.x; b < DECB; b += gridDim.x) {
        const int C = 2 * tid, n = C >> 6, d = C & 63;
        float xp0[7], xp1[7];
#pragma unroll
        for (int j = 0; j < 3; ++j) { const f32x2 v = *(const f32x2*)(p.in[I_CONV] + ((size_t)b * 3 + j) * DM + C); xp0[j] = v[0]; xp1[j] = v[1]; }
#pragma unroll
        for (int j = 0; j < 4; ++j) { const unsigned v = *(const unsigned*)(Z1 + ((size_t)MP + 4 * b + j) * NZ1 + ZXB + C); xp0[3 + j] = lo16(v); xp1[3 + j] = hi16(v); }
        { const f32x2 cb = *(const f32x2*)(p.in[I_CB] + C); f32x2 cw[4];
#pragma unroll
          for (int j = 0; j < 4; ++j) cw[j] = *(const f32x2*)(p.in[I_CW] + j * DM + C);
#pragma unroll
          for (int t = 0; t < 4; ++t) { float u0 = cb[0], u1 = cb[1];
#pragma unroll
              for (int j = 0; j < 4; ++j) { u0 += cw[j][0] * xp0[t + j]; u1 += cw[j][1] * xp1[t + j]; }
              *(LAS f32x2*)(U + t * DM + C) = (f32x2){u0, u1}; } }
        __syncthreads();
        float pr[4][2], pi[4][2];
#pragma unroll
        for (int t = 0; t < 4; ++t) { pr[t][0] = pr[t][1] = pi[t][0] = pi[t][1] = 0.f; }
        const float* wa = p.in[I_WA] + (size_t)n * 4096 + d; const float* wi = p.in[I_WI] + (size_t)n * 4096 + d;
#pragma unroll 4
        for (int cc = 0; cc < 64; ++cc) { const f32x2 a = *(const f32x2*)(wa + cc * 64), i2 = *(const f32x2*)(wi + cc * 64);
#pragma unroll
            for (int t = 0; t < 4; ++t) { const float uu = U[t * DM + 64 * n + cc]; pr[t][0] += uu * a[0]; pr[t][1] += uu * a[1]; pi[t][0] += uu * i2[0]; pi[t][1] += uu * i2[1]; } }
        const f32x2 ba = *(const f32x2*)(p.in[I_BA] + C), bi = *(const f32x2*)(p.in[I_BI] + C), lam = *(const f32x2*)(p.in[I_LAM] + C), h0 = *(const f32x2*)(p.in[I_LRU] + (size_t)b * DM + C);
        float h[2] = {h0[0], h0[1]};
        const float sp[2] = {-8.f * __logf(1.f + __expf(-lam[0])), -8.f * __logf(1.f + __expf(-lam[1]))};
#pragma unroll
        for (int t = 0; t < 4; ++t) { const f32x2 uu = *(LAS f32x2*)(U + t * DM + C);
            bf16* zp = Z1 + ((size_t)MP + 4 * b + t) * NZ1 + ZGB + C; const unsigned g = *(const unsigned*)zp; float yb[2];
#pragma unroll
            for (int e = 0; e < 2; ++e) { const float rg = sigm(pr[t][e] + ba[e]), ig = sigm(pi[t][e] + bi[e]); const float a = __expf(sp[e] * rg);
                const float mult = sqrtf(fmaxf(1.f - a * a, 0.f)); h[e] = a * h[e] + mult * ig * uu[e]; yb[e] = h[e] * gelu_tanh(e ? hi16(g) : lo16(g)); }
            *(unsigned*)zp = pk2(yb[0], yb[1]); }
        *(f32x2*)(p.out + O_LRUS + (size_t)b * DM + C) = (f32x2){h[0], h[1]};
#pragma unroll
        for (int j = 0; j < 3; ++j) *(f32x2*)(p.out + O_CONVS + ((size_t)b * 3 + j) * DM + C) = (f32x2){xp0[4 + j], xp1[4 + j]};
        __syncthreads();
    }
}

__device__ __forceinline__ void phase_merge(CP& p, LAS unsigned char* lds) {
    int tid_l = threadIdx.x; asm volatile("" : "+v"(tid_l)); const int tid = tid_l, wave = tid >> 6, lane = tid & 63, fr = lane & 15, q = lane >> 4;
    const bf16* Z1 = (const bf16*)(p.ws + WS_Z1); const bf16* BON = (const bf16*)(p.ws + WS_BONUS); const bf16* Zg = (const bf16*)p.out;
    const bf16* g2T = (const bf16*)(p.ws + WS_SMALL) + 131072; bf16* MG = (bf16*)(p.ws + WS_XB);
    LAS float* GL = (LAS float*)lds;
    const int tk = tid >> 7, cg8 = tid & 127, Cm = 8 * cg8;
    const f32x4 lg0 = *(const f32x4*)(p.in[I_LNXG] + Cm), lg1 = *(const f32x4*)(p.in[I_LNXG] + Cm + 4), lb0 = *(const f32x4*)(p.in[I_LNXB] + Cm), lb1 = *(const f32x4*)(p.in[I_LNXB] + Cm + 4);
    for (int unit = blockIdx.x; unit < MT / 16; unit += gridDim.x) {
        const int m0 = unit * 16;
        {
          const int m = m0 + fr; size_t prow; bool pz = false;
          if (m < MP) { if ((m & (SEQ - 1)) == 0) { pz = true; prow = m; } else prow = m - 1; } else { const int ms = m - MP; prow = (ms & 3) == 0 ? (size_t)MT + (ms >> 2) : (size_t)m - 1; }
          bf16x8 Tf[4];
#pragma unroll
          for (int ks = 0; ks < 4; ++ks) { const int ko = 32 * ks + 8 * q;
              const v4u cu = *(const v4u*)(Z1 + (size_t)m * NZ1 + ZGL + ko); v4u pu = *(const v4u*)(Z1 + prow * NZ1 + ZGL + ko); if (pz) pu = (v4u){0u, 0u, 0u, 0u};
              float cf[8], pf[8]; UNPACK8(cu, cf); UNPACK8(pu, pf);
              const f32x4 mu0 = *(const f32x4*)(p.in[I_MU] + ZGL + ko), mu1 = *(const f32x4*)(p.in[I_MU] + ZGL + ko + 4); float o[8];
#pragma unroll
              for (int e = 0; e < 8; ++e) o[e] = sigm(cf[e] + (e < 4 ? mu0[e & 3] : mu1[e & 3]) * (pf[e] - cf[e]));
              v4u w; w.x = pk2(o[0], o[1]); w.y = pk2(o[2], o[3]); w.z = pk2(o[4], o[5]); w.w = pk2(o[6], o[7]); Tf[ks] = __builtin_bit_cast(bf16x8, w); }
#pragma unroll 2
          for (int nbi = 0; nbi < 8; ++nbi) { const int nb = wave * 8 + nbi; f32x4 acc = {0.f, 0.f, 0.f, 0.f};
#pragma unroll
              for (int ks = 0; ks < 4; ++ks) { const bf16x8 gf = *(const bf16x8*)(g2T + (size_t)(16 * nb + fr) * 128 + 32 * ks + 8 * q); acc = __builtin_amdgcn_mfma_f32_16x16x32_bf16(gf, Tf[ks], acc, 0, 0, 0); }
              *(LAS f32x4*)(GL + fr * 1028 + 16 * nb + 4 * q) = acc; }
        }
        __syncthreads();
#pragma unroll 1
        for (int ps = 0; ps < 4; ++ps) {
            const int tok = 4 * ps + tk; const size_t m = (size_t)m0 + tok;
            const v4u yu = *(const v4u*)(Z1 + m * NZ1 + ZV + Cm), bu = *(const v4u*)(BON + m * DM + Cm), ybu = *(const v4u*)(Z1 + m * NZ1 + ZGB + Cm);
            const v4u gau = *(const v4u*)(Zg + m * 2048 + Cm), gbu = *(const v4u*)(Zg + m * 2048 + 1024 + Cm);
            const f32x4 g0 = *(LAS f32x4*)(GL + tok * 1028 + Cm), g1 = *(LAS f32x4*)(GL + tok * 1028 + Cm + 4);
            float y[8], bo[8], yb[8], ga[8], gb[8]; UNPACK8(yu, y); UNPACK8(bu, bo); UNPACK8(ybu, yb); UNPACK8(gau, ga); UNPACK8(gbu, gb);
            float sm = 0.f;
#pragma unroll
            for (int e = 0; e < 8; ++e) sm += y[e];
            const float mean = allred8(sm) * (1.f / 64.f); float sq = 0.f;
#pragma unroll
            for (int e = 0; e < 8; ++e) { y[e] -= mean; sq += y[e] * y[e]; }
            const float rstd = __builtin_amdgcn_rsqf(allred8(sq) * (1.f / 64.f) + GN_EPS);
            float o[8];
#pragma unroll
            for (int e = 0; e < 8; ++e) { const float yn = y[e] * rstd * (e < 4 ? lg0[e & 3] : lg1[e & 3]) + (e < 4 ? lb0[e & 3] : lb1[e & 3]);
                const float yA = (yn + bo[e]) * (e < 4 ? g0[e & 3] : g1[e & 3]); o[e] = sigm(ga[e]) * yA + sigm(gb[e]) * yb[e]; }
            v4u w; w.x = pk2(o[0], o[1]); w.y = pk2(o[2], o[3]); w.z = pk2(o[4], o[5]); w.w = pk2(o[6], o[7]);
            *(v4u*)(MG + m * DM + Cm) = w;
        }
        __syncthreads();
    }
}

template <bool FINAL> __device__ __forceinline__ void phase_ln(CP& p, const float* g, const float* bb) {
    int tid_l = threadIdx.x; asm volatile("" : "+v"(tid_l)); const int tid = tid_l, wave = tid >> 6, lane = tid & 63;
    float* H1 = (float*)(p.ws + WS_H1); bf16* H1B = (bf16*)(p.ws + WS_H1B);
    f32x4 gv[4], bv[4];
#pragma unroll
    for (int j = 0; j < 4; ++j) { gv[j] = *(const f32x4*)(g + 4 * lane + 256 * j); bv[j] = *(const f32x4*)(bb + 4 * lane + 256 * j); }
    for (int m = blockIdx.x * 8 + wave; m < MT; m += gridDim.x * 8) {
        float* xr = H1 + (size_t)m * DM + 4 * lane; f32x4 v[4]; float s = 0.f;
#pragma unroll
        for (int j = 0; j < 4; ++j) { v[j] = *(const f32x4*)(xr + 256 * j); s += (v[j][0] + v[j][1]) + (v[j][2] + v[j][3]); }
        const float mean = wave_sum(s) * (1.f / DM); float s2 = 0.f;
#pragma unroll
        for (int j = 0; j < 4; ++j) { v[j] = v[j] - mean; s2 += (v[j][0] * v[j][0] + v[j][1] * v[j][1]) + (v[j][2] * v[j][2] + v[j][3] * v[j][3]); }
        const float rstd = 1.f / sqrtf(wave_sum(s2) * (1.f / DM) + LN_EPS);
#pragma unroll
        for (int j = 0; j < 4; ++j) { v[j] = v[j] * rstd * gv[j] + bv[j];
            if (FINAL) *(f32x4*)(p.out + O_Y + (size_t)m * DM + 4 * lane + 256 * j) = v[j];
            else { *(f32x4*)(xr + 256 * j) = v[j]; *(v2u*)(H1B + (size_t)m * DM + 4 * lane + 256 * j) = (v2u){pk2(v[j][0], v[j][1]), pk2(v[j][2], v[j][3])}; } }
    }
}

__global__ void __launch_bounds__(512, 2) hybrid_step_kernel(Params p_unused) {
    CP* pp = (CP*)__builtin_amdgcn_kernarg_segment_ptr();
#define p (*launder(pp))
    extern __shared__ __attribute__((aligned(16))) unsigned char lds_raw[];
    LAS unsigned char* lds = (LAS unsigned char*)lds_raw;
    volatile LAS unsigned* MISC = (volatile LAS unsigned*)(lds + MISC_OFF);
    if (threadIdx.x < 16) MISC[threadIdx.x] = 0u;
    __syncthreads();
    XcdBarrier bar = xcd_barrier_post((unsigned*)(p.ws + WS_CTL) + CW_BAR, MISC + 8);
    if (p.never) cg::this_grid().sync();
    const int G = gridDim.x, bx = blockIdx.x;

    phase0(p, lds);
    xcd_barrier(bar);
    { pg8::Gemm g{(const pg8::bf16_t*)(p.ws + WS_XB), (const pg8::bf16_t*)(p.ws + WS_WINT), MPAD, NIN, 1024}; pg8::StaticOrder S; S.init(MPAD, NIN, G, bx);
      EpiZ E{(bf16*)(p.ws + WS_Z1), (bf16*)p.out};
      pg8::gemm_phase<EpiZ, pg8::StaticOrder, true, true>(lds, g, S, E); }
    xcd_barrier(bar);
    for (int u = bx; u < 256; u += G) wkv_prompt(p, lds, u);
    wkv_sample(p, lds);
    for (int u = bx; u < 256; u += G) lru_prompt(p, lds, u);
    lru_sample(p, lds);
    xcd_barrier(bar);
    phase_merge(p, lds);
    xcd_barrier(bar);
    phase_convert_ffn(p, lds);
    __syncthreads();
    { pg8::Gemm g{(const pg8::bf16_t*)(p.ws + WS_XB), (const pg8::bf16_t*)(p.ws + WS_WOT), MT, 1024, 1024}; pg8::StaticOrder S; S.init(MT, 1024, G, bx);
      EpiRes E{p.in[I_XP], p.in[I_XS], (float*)(p.ws + WS_H1)};
      pg8::gemm_phase<EpiRes, pg8::StaticOrder, true, true>(lds, g, S, E); }
    xcd_barrier(bar);
    phase_ln<false>(p, p.in[I_LN1G], p.in[I_LN1B]);
    xcd_barrier(bar);
    { pg8::Gemm g{(const pg8::bf16_t*)(p.ws + WS_H1B), (const pg8::bf16_t*)(p.ws + WS_WGUT), MT, 2 * DFF, 1024}; pg8::StaticOrder S; S.init(MT, 2 * DFF, G, bx);
      EpiSwi E{(bf16*)(p.ws + WS_ACT)};
      pg8::gemm_phase<EpiSwi, pg8::StaticOrder, true, true>(lds, g, S, E); }
    xcd_barrier(bar);
    { pg8::Gemm g{(const pg8::bf16_t*)(p.ws + WS_ACT), (const pg8::bf16_t*)(p.ws + WS_WDT), MT, 1024, DFF}; pg8::StaticOrder S; S.init(MT, 1024, G, bx);
      const float* h1 = (const float*)(p.ws + WS_H1);
      EpiRes E{h1, h1 + (size_t)MP * DM, (float*)(p.ws + WS_H1)};
      pg8::gemm_phase<EpiRes, pg8::StaticOrder, true, true>(lds, g, S, E); }
    xcd_barrier(bar);
    phase_ln<true>(p, p.in[I_LN2G], p.in[I_LN2B]);
#undef p
}

extern "C" void kernel_launch(void* const* d_in, const int* in_sizes, int n_in, void* d_out, int out_size, void* d_ws, size_t ws_size, hipStream_t stream) {
    static int grid = 0;
    if (grid == 0) {
        int dev = 0, cus = 0, per_cu = 0;
        if (n_in != 33 || ws_size < 256 * MiB) { fprintf(stderr, "kernel_launch: unexpected n_in %d / ws %zu\n", n_in, ws_size); grid = -1; return; }
        hipGetDevice(&dev); hipDeviceGetAttribute(&cus, hipDeviceAttributeMultiprocessorCount, dev);
        if (hipFuncSetAttribute((const void*)hybrid_step_kernel, hipFuncAttributeMaxDynamicSharedMemorySize, LDS_BYTES) != hipSuccess) { fprintf(stderr, "kernel_launch: hipFuncSetAttribute failed\n"); grid = -1; return; }
        if (hipOccupancyMaxActiveBlocksPerMultiprocessor(&per_cu, (const void*)hybrid_step_kernel, 512, LDS_BYTES) != hipSuccess || per_cu < 1) { fprintf(stderr, "kernel_launch: occupancy query says %d blocks per CU\n", per_cu); }
        (void)hipGetLastError();
        grid = cus;
    }
    if (grid < 0) return;
    (void)hipMemsetAsync((char*)d_ws + WS_CTL, 0, CTL_ZERO_BYTES, stream);
    Params p{};
    for (int i = 0; i < 33; ++i) p.in[i] = (const float*)d_in[i];
    p.out = (float*)d_out; p.ws = (unsigned char*)d_ws; p.never = 0; p.pad = 0;
    void* args[] = {&p};
    hipError_t e = hipLaunchCooperativeKernel((const void*)hybrid_step_kernel, dim3(grid), dim3(512), args, LDS_BYTES, stream);
    if (e != hipSuccess) fprintf(stderr, "kernel_launch: cooperative launch failed: %s (grid %d)\n", hipGetErrorString(e), grid);
}
```

```cpp
#include <hip/hip_runtime.h>
#include <hip/hip_cooperative_groups.h>
#include <cstdio>
#include <cstdint>
namespace pg8 {
#define PG8_LAS __attribute__((address_space(3)))
typedef unsigned short bf16_t;
typedef short bf16x8 __attribute__((ext_vector_type(8)));
typedef float f32x4 __attribute__((ext_vector_type(4)));
typedef unsigned u32x4 __attribute__((ext_vector_type(4)));
constexpr int BM = 256, BK = 64, HALF = 128, HTB = HALF * BK * 2  , STAGE_BYTES = 8 * HTB, NXCD = 8, WGM = 8;

__host__ __device__ __forceinline__ int lds_byte(int r, int c) { const int st = (r >> 4) * 2 + (c >> 5), rr = r & 15, cc = c & 31, ob = rr * 64 + cc * 2; return st * 1024 + (ob ^ (((ob >> 9) & 1) << 5)); }
__host__ __device__ __forceinline__ void stage_rc(int b, int& R, int& C) { const int st = b / 1024, sb = b % 1024, swz = sb ^ (((sb >> 9) & 1) << 5); R = (st >> 1) * 16 + swz / 64; C = (st & 1) * 32 + (swz % 64) / 2; }
__host__ __device__ __forceinline__ int perm32(int rho) { const int n = rho >> 4, i = rho & 15; return 8 * (i >> 2) + 4 * n + (i & 3); }

struct Unit { int pm, pn; };
struct Gemm { const bf16_t* A; const bf16_t* Bt; int M, N, K; };

struct StaticOrder {
    int nM, nN, nwg, G, c;
    __host__ __device__ void init(int M, int N, int G_, int c_) { nM = M / BM; nN = N / BM; nwg = nM * nN; G = G_; c = c_; }
    __host__ __device__ bool next(int i, Unit& u) const {
        const long L = (long)i * G + c; if (L >= nwg) return false;
        int wgid = (int)L; { const int q = nwg / NXCD, r = nwg % NXCD, xcd = wgid % NXCD, off = wgid / NXCD; wgid = (xcd < r ? xcd * (q + 1) : r * (q + 1) + (xcd - r) * q) + off; }
        const int nig = WGM * nN, gid = wgid / nig, fm = gid * WGM, gsz = (nM - fm) < WGM ? (nM - fm) : WGM;
        u.pm = fm + ((wgid % nig) % gsz); u.pn = (wgid % nig) / gsz; return true;
    }
    __device__ __forceinline__ void a_ready(const Unit&) const {}
    __device__ __forceinline__ void done(const Unit&) const {}
};

__device__ __forceinline__ unsigned cvt_pk_bf16(float lo, float hi) { unsigned r; asm volatile("v_cvt_pk_bf16_f32 %0, %1, %2" : "=v"(r) : "v"(lo), "v"(hi)); return r; }
typedef float f32x2 __attribute__((ext_vector_type(2)));
__device__ __forceinline__ f32x2 gelu_pk(f32x2 v) {
    const f32x2 av = __builtin_elementwise_abs(v), d = av * 0.2316418882f + 1.0f;
    f32x2 t; t.x = __builtin_amdgcn_rcpf(d.x); t.y = __builtin_amdgcn_rcpf(d.y);
    f32x2 q = t * 0.5307027145f + (-0.7265760135f); q = q * t + 0.7107068705f; q = q * t + (-0.142248368f); q = q * t + 0.127414796f; q = q * t;
    const f32x2 s = (v * v) * (-0.72134752044f);
    f32x2 e; e.x = __builtin_amdgcn_exp2f(s.x); e.y = __builtin_amdgcn_exp2f(s.y);
    const f32x2 m = v * (q * e), r = v - m;
    f32x2 o; o.x = v.x < 0.f ? m.x : r.x; o.y = v.y < 0.f ? m.y : r.y; return o;
}

template <int ACT  > struct EpiBf16 {
    static constexpr bool PERM = true, AFTER_DRAIN = false; static_assert(ACT == 0 || ACT == 1, "EpiBf16: ACT is 0 (none) or 1 (gelu_pk)");
    bf16_t* O; int ldc; const float* bias; int split_cols; size_t split_stride; float scale0;
    __device__ __forceinline__ void operator()(const f32x4 (&acc)[2][2][4][2], const Unit& u, int wr, int wc, int fr, int fq) const {
        const int row0 = u.pm * BM + wr * 64 + fr; int colt = u.pn * BM; bf16_t* base = O;
        float sc = 1.f; if (split_cols) { const int t = colt / split_cols; base += (size_t)t * split_stride; colt -= t * split_cols; if (t == 0) sc = scale0; }
        const int col0 = colt + wc * 32 + 8 * fq, bcol0 = u.pn * BM + wc * 32 + 8 * fq;
        f32x4 bv[2][2];
#pragma unroll
        for (int bj = 0; bj < 2; ++bj)
#pragma unroll
            for (int n = 0; n < 2; ++n) bv[bj][n] = bias ? *(const f32x4*)(bias + bcol0 + bj * HALF + 4 * n) : (f32x4){0.f, 0.f, 0.f, 0.f};
#pragma unroll
        for (int ai = 0; ai < 2; ++ai)
#pragma unroll
            for (int m = 0; m < 4; ++m) { bf16_t* rowp = base + (size_t)(row0 + ai * HALF + m * 16) * ldc + col0;
#pragma unroll
                for (int bj = 0; bj < 2; ++bj) { f32x4 v0 = acc[ai][bj][m][0] + bv[bj][0], v1 = acc[ai][bj][m][1] + bv[bj][1];
                    if (ACT == 1) { f32x2 a = gelu_pk((f32x2){v0[0], v0[1]}), b = gelu_pk((f32x2){v0[2], v0[3]}), c = gelu_pk((f32x2){v1[0], v1[1]}), d = gelu_pk((f32x2){v1[2], v1[3]});
                        v0 = (f32x4){a.x, a.y, b.x, b.y}; v1 = (f32x4){c.x, c.y, d.x, d.y}; }
                    v0 = v0 * sc; v1 = v1 * sc; u32x4 w; w.x = cvt_pk_bf16(v0[0], v0[1]); w.y = cvt_pk_bf16(v0[2], v0[3]); w.z = cvt_pk_bf16(v1[0], v1[1]); w.w = cvt_pk_bf16(v1[2], v1[3]);
                    *(u32x4*)(rowp + bj * HALF) = w; } }
    }
};
template <class Epi, class Sched, bool ALIGN_EPI = false, bool SP2 = false>
__device__ __forceinline__ void gemm_phase(PG8_LAS unsigned char* lds, const Gemm g, const Sched& S, const Epi& E) {
    const int tid = threadIdx.x, wid = __builtin_amdgcn_readfirstlane(tid >> 6), lane = tid & 63, wr = wid >> 2, wc = wid & 3, fr = lane & 15, fq = lane >> 4;
    const int K = g.K, nt = K / BK;
    unsigned voffA[2], voffB[2];
#pragma unroll
    for (int i = 0; i < 2; ++i) { int R, C; stage_rc(tid * 16 + i * 8192, R, C); const int Rb = Epi::PERM ? ((R & ~31) + perm32(R & 31)) : R;
        voffA[i] = (unsigned)(R * K + C) * 2u; voffB[i] = (unsigned)(Rb * K + C) * 2u; }
    const size_t kstep = (size_t)(BK * 2);
    const size_t hstep = (size_t)HALF * K * 2;
    const size_t tstep = 2 * hstep;
    const unsigned ldsw = (unsigned)wid * 1024u;
    const int aoff = lds_byte(wr * 64 + fr, fq * 8), boff = lds_byte(wc * 32 + fr, fq * 8);
#define PG8_SA(b, h) (((b) * 2 + (h)) * HTB)
#define PG8_SB(b, h) ((4 + (b) * 2 + (h)) * HTB)
#define PG8_STAGE(bufoff, gbase, voff) do { _Pragma("unroll") for (int _i = 0; _i < 2; ++_i) \
        __builtin_amdgcn_global_load_lds((const unsigned*)((const char*)(gbase) + (voff)[_i]), (PG8_LAS unsigned*)(lds + (bufoff) + ldsw + _i * 8192), 16, 0, 0); } while (0)
#define PG8_LDA(dst, b, h) do { _Pragma("unroll") for (int m = 0; m < 4; ++m) _Pragma("unroll") for (int k = 0; k < 2; ++k) dst[m][k] = *(const PG8_LAS bf16x8*)(lds + PG8_SA(b, h) + aoff + m * 2048 + k * 1024); } while (0)
#define PG8_LDB(dst, b, h) do { _Pragma("unroll") for (int n = 0; n < 2; ++n) _Pragma("unroll") for (int k = 0; k < 2; ++k) dst[n][k] = *(const PG8_LAS bf16x8*)(lds + PG8_SB(b, h) + boff + n * 2048 + k * 1024); } while (0)
#define PG8_MMA(ai, bj, At, Bt) do { __builtin_amdgcn_s_setprio(1); _Pragma("unroll") for (int m = 0; m < 4; ++m) _Pragma("unroll") for (int n = 0; n < 2; ++n) _Pragma("unroll") for (int k = 0; k < 2; ++k) \
        acc[ai][bj][m][n] = __builtin_amdgcn_mfma_f32_16x16x32_bf16(Bt[n][k], At[m][k], acc[ai][bj][m][n], 0, 0, 0); __builtin_amdgcn_s_setprio(0); } while (0)
#define PG8_WAIT_V(n) asm volatile("s_waitcnt vmcnt(" #n ")" ::: "memory")
#define PG8_WAIT_L(n) asm volatile("s_waitcnt lgkmcnt(" #n ")" ::: "memory")
#define PG8_BAR __builtin_amdgcn_s_barrier()
#define PG8_SCHED __builtin_amdgcn_sched_barrier(0)
    Unit cur, nxt; int ui = 0;
    if (!S.next(0, cur)) return;
    f32x4 acc[2][2][4][2];
#pragma unroll
    for (int a = 0; a < 2; ++a)
#pragma unroll
        for (int b = 0; b < 2; ++b)
#pragma unroll
            for (int m = 0; m < 4; ++m)
#pragma unroll
                for (int n = 0; n < 2; ++n) acc[a][b][m][n] = (f32x4){0.f, 0.f, 0.f, 0.f};
    bf16x8 At[4][2], B0[2][2], B1[2][2];
    const char* cA = (const char*)g.A + (size_t)cur.pm * tstep; const char* cB = (const char*)g.Bt + (size_t)cur.pn * tstep;
    S.a_ready(cur);
    if constexpr (SP2) {
        PG8_STAGE(PG8_SB(0, 0), cB, voffB); PG8_STAGE(PG8_SB(0, 1), cB + hstep, voffB); PG8_STAGE(PG8_SA(0, 0), cA, voffA); PG8_STAGE(PG8_SA(0, 1), cA + hstep, voffA);
        if (wr == 1) PG8_BAR;
        PG8_WAIT_V(2); PG8_BAR;
        PG8_STAGE(PG8_SB(1, 0), cB + kstep, voffB); PG8_STAGE(PG8_SA(1, 0), cA + kstep, voffA); PG8_STAGE(PG8_SB(1, 1), cB + hstep + kstep, voffB);
        PG8_WAIT_V(6); PG8_BAR;
    } else {
        PG8_STAGE(PG8_SB(0, 0), cB, voffB); PG8_STAGE(PG8_SA(0, 0), cA, voffA); PG8_STAGE(PG8_SB(0, 1), cB + hstep, voffB); PG8_STAGE(PG8_SA(0, 1), cA + hstep, voffA);
        if (wr == 1) PG8_BAR;
        PG8_WAIT_V(4); PG8_BAR;
        PG8_STAGE(PG8_SB(1, 0), cB + kstep, voffB); PG8_STAGE(PG8_SA(1, 0), cA + kstep, voffA); PG8_STAGE(PG8_SB(1, 1), cB + hstep + kstep, voffB);
        PG8_WAIT_V(6); PG8_BAR;
    }
    for (;;) {
        const bool has_next = S.next(ui + 1, nxt);
        const char* nA = has_next ? (const char*)g.A + (size_t)nxt.pm * tstep : cA; const char* nB = has_next ? (const char*)g.Bt + (size_t)nxt.pn * tstep : cB;
        for (int t = 0; t < nt; t += 2) {
            const bool last = (t == nt - 2);
            const char* a1 = cA + (size_t)(t + 1) * kstep;
            const char* a2 = last ? nA : cA + (size_t)(t + 2) * kstep; const char* b2 = last ? nB : cB + (size_t)(t + 2) * kstep;
            const char* a3 = a2 + kstep; const char* b3 = b2 + kstep;
            if (last && has_next) S.a_ready(nxt);
            if constexpr (SP2) {
            PG8_LDB(B0, 0, 0); PG8_LDB(B1, 0, 1); PG8_SCHED; PG8_LDA(At, 0, 0); PG8_STAGE(PG8_SA(1, 1), a1 + hstep, voffA);
            PG8_WAIT_V(8); PG8_WAIT_L(0); PG8_BAR; PG8_MMA(0, 0, At, B0); PG8_MMA(0, 1, At, B1); PG8_BAR; PG8_SCHED;
            PG8_LDA(At, 0, 1); PG8_STAGE(PG8_SB(0, 0), b2, voffB); PG8_STAGE(PG8_SB(0, 1), b2 + hstep, voffB); PG8_STAGE(PG8_SA(0, 0), a2, voffA);
            PG8_WAIT_V(8); PG8_WAIT_L(0); PG8_BAR; PG8_MMA(1, 0, At, B0); PG8_MMA(1, 1, At, B1); PG8_BAR; PG8_SCHED;
            PG8_LDB(B0, 1, 0); PG8_LDB(B1, 1, 1); PG8_SCHED; PG8_LDA(At, 1, 0); PG8_STAGE(PG8_SA(0, 1), a2 + hstep, voffA);
            PG8_WAIT_V(8); PG8_WAIT_L(0); PG8_BAR; PG8_MMA(0, 0, At, B0); PG8_MMA(0, 1, At, B1); PG8_BAR; PG8_SCHED;
            PG8_LDA(At, 1, 1); PG8_STAGE(PG8_SB(1, 0), b3, voffB); PG8_STAGE(PG8_SB(1, 1), b3 + hstep, voffB); PG8_STAGE(PG8_SA(1, 0), a3, voffA);
            PG8_WAIT_V(8); PG8_WAIT_L(0); PG8_BAR; PG8_MMA(1, 0, At, B0); PG8_MMA(1, 1, At, B1); PG8_BAR; PG8_SCHED;
            } else {
            PG8_LDB(B0, 0, 0); PG8_SCHED; PG8_LDA(At, 0, 0); PG8_STAGE(PG8_SA(1, 1), a1 + hstep, voffA);
            PG8_WAIT_L(8); PG8_BAR; PG8_WAIT_L(0); PG8_MMA(0, 0, At, B0); PG8_BAR; PG8_SCHED;
            PG8_LDB(B1, 0, 1); PG8_STAGE(PG8_SB(0, 0), b2, voffB);
            PG8_BAR; PG8_WAIT_L(0); PG8_MMA(0, 1, At, B1); PG8_BAR;
            PG8_LDA(At, 0, 1); PG8_STAGE(PG8_SA(0, 0), a2, voffA);
            PG8_BAR; PG8_WAIT_L(0); PG8_MMA(1, 0, At, B0); PG8_BAR; PG8_SCHED;
            PG8_STAGE(PG8_SB(0, 1), b2 + hstep, voffB);
            PG8_WAIT_V(6); PG8_BAR; PG8_MMA(1, 1, At, B1); PG8_BAR;
            PG8_LDB(B0, 1, 0); PG8_SCHED; PG8_LDA(At, 1, 0); PG8_STAGE(PG8_SA(0, 1), a2 + hstep, voffA);
            PG8_WAIT_L(8); PG8_BAR; PG8_WAIT_L(0); PG8_MMA(0, 0, At, B0); PG8_BAR; PG8_SCHED;
            PG8_LDB(B1, 1, 1); PG8_STAGE(PG8_SB(1, 0), b3, voffB);
            PG8_BAR; PG8_WAIT_L(0); PG8_MMA(0, 1, At, B1); PG8_BAR;
            PG8_LDA(At, 1, 1); PG8_STAGE(PG8_SA(1, 0), a3, voffA);
            PG8_BAR; PG8_WAIT_L(0); PG8_MMA(1, 0, At, B0); PG8_BAR; PG8_SCHED;
            PG8_STAGE(PG8_SB(1, 1), b3 + hstep, voffB);
            PG8_WAIT_V(6); PG8_BAR; PG8_MMA(1, 1, At, B1); PG8_BAR;
            }
        }
        if constexpr (ALIGN_EPI) { if (wr == 0) PG8_BAR; }
        if constexpr (!Epi::AFTER_DRAIN) { E(acc, cur, wr, wc, fr, fq); S.done(cur); }
        if (!has_next) break;
#pragma unroll
        for (int a = 0; a < 2; ++a)
#pragma unroll
            for (int b = 0; b < 2; ++b)
#pragma unroll
                for (int m = 0; m < 4; ++m)
#pragma unroll
                    for (int n = 0; n < 2; ++n) acc[a][b][m][n] = (f32x4){0.f, 0.f, 0.f, 0.f};
        cur = nxt; cA = nA; cB = nB; ++ui;
        if constexpr (ALIGN_EPI) { if (wr == 1) PG8_BAR; }
    }
    PG8_WAIT_V(0);
    if constexpr (!ALIGN_EPI) { if (wr == 0) PG8_BAR; }
    PG8_BAR;
    if constexpr (Epi::AFTER_DRAIN) { E.fused(acc, cur, wr, wc, fr, fq, lds, wid, lane); S.done(cur); }
#undef PG8_SA
#undef PG8_SB
#undef PG8_STAGE
#undef PG8_LDA
#undef PG8_LDB
#undef PG8_MMA
#undef PG8_WAIT_V
#undef PG8_WAIT_L
#undef PG8_BAR
#undef PG8_SCHED
}
}
#define GAS __attribute__((address_space(1)))
#define LAS __attribute__((address_space(3)))
#define XB_TMO      128
#define XB_XCNT(j)  (256  + 64 * (j))
#define XB_XSUB(j)  (1280 + 64 * (j))
#define XB_XGEN(j)  (2304 + 64 * (j))
#define XB_TOP      3328
#define XB_TOPGEN   3392
#define XCD_BAR_WORDS 3456
#define XB_SPIN_CAP (1u << 18)

__device__ __forceinline__ unsigned xb_ld(unsigned* p)              { return __hip_atomic_load(p, __ATOMIC_RELAXED, __HIP_MEMORY_SCOPE_AGENT); }
__device__ __forceinline__ unsigned xb_add(unsigned* p, unsigned v) { return __hip_atomic_fetch_add(p, v, __ATOMIC_RELAXED, __HIP_MEMORY_SCOPE_AGENT); }
__device__ __forceinline__ unsigned xb_xcc_id() { return (unsigned)__builtin_amdgcn_s_getreg((3 << 11) | 20) & 0xFu; }
#define XB_SPIN(cond, bar) do { unsigned _sp = 0; while (cond) { __builtin_amdgcn_s_sleep(1); \
    if ((++_sp & 255u) == 0u) { if (xb_ld(&(bar)[XB_TMO])) break; if (_sp > XB_SPIN_CAP) { atomicAdd(&(bar)[XB_TMO], 1u); break; } } } } while (0)

struct XcdBarrier {
    unsigned* bar; unsigned x;
    volatile LAS unsigned* st;
};

__device__ __forceinline__ XcdBarrier xcd_barrier_post(unsigned* bar, volatile LAS unsigned* st) {
    XcdBarrier b; b.bar = bar; b.x = xb_xcc_id(); b.st = st;
    if (threadIdx.x == 0) (void)xb_add(&bar[XB_XCNT(b.x)], 1u);
    return b;
}
__device__ __forceinline__ void xcd_barrier_complete(unsigned* bar, unsigned x, unsigned& nloc, unsigned& nx) {
    const unsigned G = gridDim.x * gridDim.y * gridDim.z;
    unsigned sum, cnt, mine, sp = 0u;
    for (;;) {
        sum = 0u; cnt = 0u; mine = 0u;
#pragma unroll
        for (unsigned j = 0; j < 16; ++j) { const unsigned c = xb_ld(&bar[XB_XCNT(j)]); sum += c; cnt += (c > 0u) ? 1u : 0u; mine = (j == x) ? c : mine; }
        if (sum == G) break;
        __builtin_amdgcn_s_sleep(1);
        if ((++sp & 255u) == 0u) { if (xb_ld(&bar[XB_TMO])) break; if (sp > XB_SPIN_CAP) { atomicAdd(&bar[XB_TMO], 1u); break; } }
    }
    nloc = mine > 0u ? mine : 1u; nx = cnt > 0u ? cnt : 1u;
}

__device__ __forceinline__ void xcd_barrier(const XcdBarrier& b) {
    asm volatile("s_waitcnt vmcnt(0)" ::: "memory");
    __syncthreads();
    if (threadIdx.x == 0) {
        unsigned* bar = b.bar;
        __builtin_amdgcn_s_waitcnt(0);
        unsigned nloc = b.st[0], nx = b.st[1];
        if (nloc == 0u) { xcd_barrier_complete(bar, b.x, nloc, nx); b.st[0] = nloc; b.st[1] = nx; }
        const unsigned old = xb_add(&bar[XB_XSUB(b.x)], 1u);
        const unsigned gen = old / nloc;
        if (old + 1u == (gen + 1u) * nloc) {
            __builtin_amdgcn_fence(__ATOMIC_RELEASE, "agent");
            asm volatile("s_waitcnt vmcnt(0)" ::: "memory");
            const unsigned og = xb_add(&bar[XB_TOP], 1u);
            const unsigned tg = og / nx;
            if (og + 1u == (tg + 1u) * nx) xb_add(&bar[XB_TOPGEN], 1u);
            else XB_SPIN(xb_ld(&bar[XB_TOPGEN]) == tg, bar);
            __builtin_amdgcn_fence(__ATOMIC_ACQUIRE, "agent");
            xb_add(&bar[XB_XGEN(b.x)], 1u);
            asm volatile("s_waitcnt vmcnt(0)" ::: "memory");
        } else {
            XB_SPIN(xb_ld(&bar[XB_XGEN(b.x)]) == gen, bar);
            __builtin_amdgcn_fence(__ATOMIC_ACQUIRE, "agent");
            asm volatile("s_waitcnt vmcnt(0)" ::: "memory");
        }
    }
    __syncthreads();
}

namespace cg = cooperative_groups;
typedef unsigned short bf16;
typedef unsigned v4u __attribute__((ext_vector_type(4)));
typedef unsigned v2u __attribute__((ext_vector_type(2)));
typedef float f32x4 __attribute__((ext_vector_type(4)));
typedef float f32x2 __attribute__((ext_vector_type(2)));
typedef short bf16x8 __attribute__((ext_vector_type(8)));
#define LDS_WAIT() asm volatile("s_waitcnt lgkmcnt(0)" ::: "memory")

constexpr int DM = 1024, NB = 8, SEQ = 2048, DECB = 128, DECS = 4;
constexpr int MP = NB * SEQ, MS = DECB * DECS, MT = MP + MS, MPAD = 17152;
constexpr int NZ1 = 5376, NIN = 7424, DFF = 2816;
constexpr int ZR = 0, ZK = 1024, ZV = 2048, ZWL = 3072, ZAL = 3136, ZGL = 3200, ZXB = 3328, ZGB = 4352;
constexpr float ALPHA = 1.189207115002721f;
constexpr float LN_EPS = 1e-5f, GN_EPS = 64e-5f;

constexpr size_t MiB = 1u << 20;
constexpr size_t WS_CTL = 0, CTL_ZERO_BYTES = 65536;
constexpr int CW_BAR = 1024;
constexpr size_t WS_WOT = 1 * MiB;
constexpr size_t WS_SMALL = 3 * MiB;
constexpr size_t WS_XB = 4 * MiB;
constexpr size_t WS_Z1 = 38 * MiB;
constexpr size_t WS_WINT = 214 * MiB;
constexpr size_t WS_BONUS = 214 * MiB;
constexpr size_t WS_H1 = 38 * MiB;
constexpr size_t WS_H1B = 104 * MiB;
constexpr size_t WS_WGUT = 137 * MiB;
constexpr size_t WS_WDT = 148 * MiB;
constexpr size_t WS_ACT = 154 * MiB;
constexpr size_t O_Y = 0, O_SHP = 17301504, O_WKVP = 17309696, O_CONVP = 17833984, O_LRUP = 17858560,
                 O_SHS = 17866752, O_WKVS = 17997824, O_CONVS = 26386432, O_LRUS = 26779648;

constexpr int LDS_BYTES = 163840, MISC_OFF = LDS_BYTES - 64;

struct Params { const float* in[33]; float* out; unsigned char* ws; int never; int pad; };
typedef const __attribute__((address_space(4))) Params CP;
__device__ __forceinline__ CP* launder(CP* q) { asm volatile("" : "+s"(q)); return q; }
enum { I_XP = 0, I_XS, I_SHIFT, I_WKV, I_CONV, I_LRU, I_WIN, I_MU, I_W0, I_W2, I_A0, I_A2, I_G2, I_KK, I_KA, I_RK, I_LNXG, I_LNXB,
       I_CW, I_CB, I_WA, I_BA, I_WI, I_BI, I_LAM, I_WO, I_LN1G, I_LN1B, I_WG, I_WU, I_WD, I_LN2G, I_LN2B };

__device__ __forceinline__ float bf2f(unsigned b) { return __uint_as_float(b << 16); }
__device__ __forceinline__ unsigned f2bf(float f) { unsigned u = __float_as_uint(f); return (u + 0x7fffu + ((u >> 16) & 1u)) >> 16; }
__device__ __forceinline__ unsigned pk2(float lo, float hi) { return f2bf(lo) | (f2bf(hi) << 16); }
__device__ __forceinline__ float lo16(unsigned u) { return __uint_as_float(u << 16); }
__device__ __forceinline__ float hi16(unsigned u) { return __uint_as_float(u & 0xffff0000u); }
__device__ __forceinline__ float sigm(float x) { return __builtin_amdgcn_rcpf(1.f + __expf(-x)); }
__device__ __forceinline__ float tanh_(float x) { return 1.f - 2.f * __builtin_amdgcn_rcpf(__expf(2.f * x) + 1.f); }
__device__ __forceinline__ float gelu_tanh(float x) { return 0.5f * x * (1.f + tanh_(0.7978845608028654f * (x + 0.044715f * x * x * x))); }
template <int CTRL> __device__ __forceinline__ float dpp_add(float v) {
    return v + __int_as_float(__builtin_amdgcn_update_dpp(0, __float_as_int(v), CTRL, 0xF, 0xF, true)); }
__device__ __forceinline__ float allred8(float v) { v = dpp_add<0xB1>(v); v = dpp_add<0x4E>(v); v = dpp_add<0x141>(v); return v; }
__device__ __forceinline__ float allred16(float v) { v = allred8(v); v = dpp_add<0x140>(v); return v; }
__device__ __forceinline__ float wave_sum(float v) {
#pragma unroll
    for (int o = 1; o < 64; o <<= 1) v += __shfl_xor(v, o);
    return v; }
#define UNPACK8(q, f) do { f[0] = lo16(q.x); f[1] = hi16(q.x); f[2] = lo16(q.y); f[3] = hi16(q.y); f[4] = lo16(q.z); f[5] = hi16(q.z); f[6] = lo16(q.w); f[7] = hi16(q.w); } while (0)

__device__ __forceinline__ void transpose_item(const float* W, int N, bf16* WT, int ldT, int k0, int n0, int drow0, LAS float* scr, int lane) {
#pragma unroll 8
    for (int i = 0; i < 32; ++i) { const int kk = 2 * i + (lane >> 5); scr[kk * 33 + (lane & 31)] = W[(size_t)(k0 + kk) * N + n0 + (lane & 31)]; }
    LDS_WAIT();
    const int c = lane & 7;
#pragma unroll
    for (int j = 0; j < 4; ++j) { const int n = (lane >> 3) + 8 * j; const LAS float* s = scr + (8 * c) * 33 + n;
        v4u o; o.x = pk2(s[0 * 33], s[1 * 33]); o.y = pk2(s[2 * 33], s[3 * 33]); o.z = pk2(s[4 * 33], s[5 * 33]); o.w = pk2(s[6 * 33], s[7 * 33]);
        *(v4u*)(WT + (size_t)(drow0 + n) * ldT + k0 + 8 * c) = o; }
    LDS_WAIT();
}

__device__ __forceinline__ void phase0(CP& p, LAS unsigned char* lds) {
    int tid_l = threadIdx.x; asm volatile("" : "+v"(tid_l)); const int tid = tid_l, wave = tid >> 6, lane = tid & 63;
    const int gw = blockIdx.x * 8 + wave, NGW = gridDim.x * 8;
    bf16* Xb = (bf16*)(p.ws + WS_XB);
    for (int m = gw; m < MPAD; m += NGW) {
        const float* src = m < MP ? p.in[I_XP] + (size_t)m * DM : (m < MT ? p.in[I_XS] + (size_t)(m - MP) * DM : (m < MT + DECB ? p.in[I_SHIFT] + (size_t)(m - MT) * DM : nullptr));
        f32x4 v[4];
#pragma unroll
        for (int j = 0; j < 4; ++j) v[j] = src ? *(const f32x4*)(src + 4 * lane + 256 * j) : (f32x4){0.f, 0.f, 0.f, 0.f};
        unsigned long long* o8 = (unsigned long long*)(Xb + (size_t)m * DM) + lane;
#pragma unroll
        for (int j = 0; j < 4; ++j) o8[64 * j] = (unsigned long long)pk2(v[j].x, v[j].y) | ((unsigned long long)pk2(v[j].z, v[j].w) << 32);
        float* so = nullptr;
        if (m < MP) { if ((m & (SEQ - 1)) == SEQ - 1) so = p.out + O_SHP + (size_t)(m >> 11) * DM; }
        else if (m < MT) { if (((m - MP) & 3) == 3) so = p.out + O_SHS + (size_t)((m - MP) >> 2) * DM; }
        if (so) {
#pragma unroll
            for (int j = 0; j < 4; ++j) *(f32x4*)(so + 4 * lane + 256 * j) = v[j]; }
    }
    LAS float* scr = (LAS float*)(lds + wave * 16384);
    bf16* WinT = (bf16*)(p.ws + WS_WINT); bf16* WoT = (bf16*)(p.ws + WS_WOT);
    bf16* w2T = (bf16*)(p.ws + WS_SMALL); bf16* a2T = w2T + 65536; bf16* g2T = w2T + 131072; bf16* waT = w2T + 262144; bf16* wiT = w2T + 327680;
    constexpr int N_WIN = 16 * 232, N_WO = 16 * 32, N_L = 32, N_G = 64, N_B = 32;
    constexpr int NITEMS = N_WIN + N_WO + 2 * N_L + N_G + 2 * N_B;
    for (int it = gw; it < NITEMS; it += NGW) {
        int r = it;
        if (r < N_WIN) { transpose_item(p.in[I_WIN], NIN, WinT, 1024, 64 * (r / 232), 32 * (r % 232), 32 * (r % 232), scr, lane); continue; } r -= N_WIN;
        if (r < N_WO) { transpose_item(p.in[I_WO], 1024, WoT, 1024, 64 * (r / 32), 32 * (r % 32), 32 * (r % 32), scr, lane); continue; } r -= N_WO;
        if (r < N_L) { transpose_item(p.in[I_W2], 1024, w2T, 64, 0, 32 * r, 32 * r, scr, lane); continue; } r -= N_L;
        if (r < N_L) { transpose_item(p.in[I_A2], 1024, a2T, 64, 0, 32 * r, 32 * r, scr, lane); continue; } r -= N_L;
        if (r < N_G) { transpose_item(p.in[I_G2], 1024, g2T, 128, 64 * (r / 32), 32 * (r % 32), 32 * (r % 32), scr, lane); continue; } r -= N_G;
        if (r < N_B) { transpose_item(p.in[I_WA] + (r >> 1) * 4096, 64, waT + (r >> 1) * 4096, 64, 0, 32 * (r & 1), 32 * (r & 1), scr, lane); continue; } r -= N_B;
        transpose_item(p.in[I_WI] + (r >> 1) * 4096, 64, wiT + (r >> 1) * 4096, 64, 0, 32 * (r & 1), 32 * (r & 1), scr, lane);
    }
}
__device__ __forceinline__ void phase_convert_ffn(CP& p, LAS unsigned char* lds) {
    int tid_l = threadIdx.x; asm volatile("" : "+v"(tid_l)); const int tid = tid_l, wave = tid >> 6, lane = tid & 63;
    const int gw = blockIdx.x * 8 + wave, NGW = gridDim.x * 8;
    LAS float* scr = (LAS float*)(lds + wave * 16384);
    bf16* WguT = (bf16*)(p.ws + WS_WGUT); bf16* WdT = (bf16*)(p.ws + WS_WDT);
    constexpr int N_G = 16 * 88, N_D = 44 * 32;
    for (int it = gw; it < 2 * N_G + N_D; it += NGW) {
        int r = it;
        if (r < N_G) { const int n0 = 32 * (r % 88); transpose_item(p.in[I_WG], DFF, WguT, 1024, 64 * (r / 88), n0, 256 * (n0 >> 7) + (n0 & 127), scr, lane); continue; } r -= N_G;
        if (r < N_G) { const int n0 = 32 * (r % 88); transpose_item(p.in[I_WU], DFF, WguT, 1024, 64 * (r / 88), n0, 256 * (n0 >> 7) + 128 + (n0 & 127), scr, lane); continue; } r -= N_G;
        transpose_item(p.in[I_WD], 1024, WdT, DFF, 64 * (r / 32), 32 * (r % 32), 32 * (r % 32), scr, lane);
    }
}

struct EpiZ {
    static constexpr bool PERM = true, AFTER_DRAIN = false;
    bf16* Z1; bf16* Zg;
    __device__ __forceinline__ void operator()(const pg8::f32x4 (&acc)[2][2][4][2], const pg8::Unit& u, int wr, int wc, int fr, int fq) const {
        bf16* base; int ldc, colt;
        if (u.pn < 21) { base = Z1; ldc = NZ1; colt = u.pn * 256; } else { if (u.pm >= 66) return; base = Zg; ldc = 2048; colt = (u.pn - 21) * 256; }
        const int row0 = u.pm * 256 + wr * 64 + fr, col0 = colt + wc * 32 + 8 * fq;
#pragma unroll
        for (int ai = 0; ai < 2; ++ai)
#pragma unroll
            for (int m = 0; m < 4; ++m) { bf16* rowp = base + (size_t)(row0 + ai * 128 + m * 16) * ldc + col0;
#pragma unroll
                for (int bj = 0; bj < 2; ++bj) { const pg8::f32x4 v0 = acc[ai][bj][m][0], v1 = acc[ai][bj][m][1];
                    v4u w; w.x = pg8::cvt_pk_bf16(v0[0], v0[1]); w.y = pg8::cvt_pk_bf16(v0[2], v0[3]); w.z = pg8::cvt_pk_bf16(v1[0], v1[1]); w.w = pg8::cvt_pk_bf16(v1[2], v1[3]);
                    *(v4u*)(rowp + bj * 128) = w; } }
    }
};
struct EpiRes {
    static constexpr bool PERM = false, AFTER_DRAIN = false;
    const float* resA; const float* resB; float* out;
    __device__ __forceinline__ void operator()(const pg8::f32x4 (&acc)[2][2][4][2], const pg8::Unit& u, int wr, int wc, int fr, int fq) const {
        const int row0 = u.pm * 256 + wr * 64 + fr, col0 = u.pn * 256 + wc * 32 + 4 * fq;
#pragma unroll
        for (int ai = 0; ai < 2; ++ai)
#pragma unroll
            for (int m = 0; m < 4; ++m) { const int row = row0 + ai * 128 + m * 16;
                const float* rp = (row < MP ? resA + (size_t)row * DM : resB + (size_t)(row - MP) * DM) + col0; float* op = out + (size_t)row * DM + col0;
#pragma unroll
                for (int bj = 0; bj < 2; ++bj)
#pragma unroll
                    for (int n = 0; n < 2; ++n) { const pg8::f32x4 x = *(const pg8::f32x4*)(rp + bj * 128 + n * 16); *(pg8::f32x4*)(op + bj * 128 + n * 16) = acc[ai][bj][m][n] + x * ALPHA; } }
    }
};
struct EpiSwi {
    static constexpr bool PERM = true, AFTER_DRAIN = false;
    bf16* O;
    __device__ __forceinline__ void operator()(const pg8::f32x4 (&acc)[2][2][4][2], const pg8::Unit& u, int wr, int wc, int fr, int fq) const {
        const int row0 = u.pm * 256 + wr * 64 + fr, col0 = u.pn * 128 + wc * 32 + 8 * fq;
#pragma unroll
        for (int ai = 0; ai < 2; ++ai)
#pragma unroll
            for (int m = 0; m < 4; ++m) { bf16* rowp = O + (size_t)(row0 + ai * 128 + m * 16) * DFF + col0;
                float o[8];
#pragma unroll
                for (int n = 0; n < 2; ++n)
#pragma unroll
                    for (int j = 0; j < 4; ++j) { const float g = acc[ai][0][m][n][j], uu = acc[ai][1][m][n][j]; o[4 * n + j] = g * sigm(g) * uu; }
                v4u w; w.x = pg8::cvt_pk_bf16(o[0], o[1]); w.y = pg8::cvt_pk_bf16(o[2], o[3]); w.z = pg8::cvt_pk_bf16(o[4], o[5]); w.w = pg8::cvt_pk_bf16(o[6], o[7]);
                *(v4u*)rowp = w; }
    }
};

typedef _Float16 h8 __attribute__((ext_vector_type(8)));
typedef _Float16 h4 __attribute__((ext_vector_type(4)));
constexpr int L_NKK = 0, L_WR = 17408, L_W = 34816, L_B = 52224, L_KP = 69632, L_VL = 87040, L_SC = 95232, L_RAW = 95744, L_YB = L_RAW  , L_RAWL = 120704,
              L_CST = 138384, L_MUL = 140432, L_WB = 140944, L_PW = L_W, L_PA = L_B;
constexpr int OPS = 68, RLS = 136, WBS = 72;

__device__ __forceinline__ float mixmul_lo(unsigned h, float x) { float d; asm("v_fma_mix_f32 %0, %1, %2, 0 op_sel_hi:[1,0,0]" : "=v"(d) : "v"(h), "v"(x)); return d; }
__device__ __forceinline__ float mix_lo(unsigned h, float x, float acc) { float d; asm("v_fma_mix_f32 %0, %1, %2, %3 op_sel_hi:[1,0,0]" : "=v"(d) : "v"(h), "v"(x), "v"(acc)); return d; }
__device__ __forceinline__ float mix_hi(unsigned h, float x, float acc) { float d; asm("v_fma_mix_f32 %0, %1, %2, %3 op_sel:[1,0,0] op_sel_hi:[1,0,0]" : "=v"(d) : "v"(h), "v"(x), "v"(acc)); return d; }
__device__ __forceinline__ float nmix_lo(unsigned h, float x, float acc) { float d; asm("v_fma_mix_f32 %0, -%1, %2, %3 op_sel_hi:[1,0,0]" : "=v"(d) : "v"(h), "v"(x), "v"(acc)); return d; }
__device__ __forceinline__ float nmix_hi(unsigned h, float x, float acc) { float d; asm("v_fma_mix_f32 %0, -%1, %2, %3 op_sel:[1,0,0] op_sel_hi:[1,0,0]" : "=v"(d) : "v"(h), "v"(x), "v"(acc)); return d; }
__device__ __forceinline__ void allred16x2(float& a, float& b) {
    asm("s_nop 0\n\t"
        "v_add_f32_dpp %0, %0, %0 quad_perm:[1,0,3,2] row_mask:0xf bank_mask:0xf bound_ctrl:1\n\t"
        "v_add_f32_dpp %1, %1, %1 quad_perm:[1,0,3,2] row_mask:0xf bank_mask:0xf bound_ctrl:1\n\t"
        "s_nop 0\n\t"
        "v_add_f32_dpp %0, %0, %0 quad_perm:[2,3,0,1] row_mask:0xf bank_mask:0xf bound_ctrl:1\n\t"
        "v_add_f32_dpp %1, %1, %1 quad_perm:[2,3,0,1] row_mask:0xf bank_mask:0xf bound_ctrl:1\n\t"
        "s_nop 0\n\t"
        "v_add_f32_dpp %0, %0, %0 row_half_mirror row_mask:0xf bank_mask:0xf bound_ctrl:1\n\t"
        "v_add_f32_dpp %1, %1, %1 row_half_mirror row_mask:0xf bank_mask:0xf bound_ctrl:1\n\t"
        "s_nop 0\n\t"
        "v_add_f32_dpp %0, %0, %0 row_mirror row_mask:0xf bank_mask:0xf bound_ctrl:1\n\t"
        "v_add_f32_dpp %1, %1, %1 row_mirror row_mask:0xf bank_mask:0xf bound_ctrl:1"
        : "+v"(a), "+v"(b));
}

__device__ __forceinline__ f32x2 pk_mul(f32x2 a, f32x2 b) { f32x2 d; asm("v_pk_mul_f32 %0, %1, %2" : "=v"(d) : "v"(a), "v"(b)); return d; }
__device__ __forceinline__ f32x2 pk_fma(f32x2 a, f32x2 b, f32x2 c) { f32x2 d; asm("v_pk_fma_f32 %0, %1, %2, %3" : "=v"(d) : "v"(a), "v"(b), "v"(c)); return d; }
__device__ __forceinline__ f32x2 pk_fma_b(f32x2 a, f32x2 blo, f32x2 c) { f32x2 d; asm("v_pk_fma_f32 %0, %1, %2, %3 op_sel_hi:[1,0,1]" : "=v"(d) : "v"(a), "v"(blo), "v"(c)); return d; }
__device__ __forceinline__ float add_asm(float a, float b) { float d; asm("v_add_f32 %0, %1, %2" : "=v"(d) : "v"(a), "v"(b)); return d; }
struct StepOps { f32x4 nk, wr, w, b, k; f32x2 vi; };
__device__ __forceinline__ void wkv_prompt(CP& p, LAS unsigned char* lds, int unit, bool dry) {
    int tid_l = threadIdx.x; asm volatile("" : "+v"(tid_l)); const int tid = tid_l, wave = tid >> 6, lane = tid & 63;
    const int bh = unit >> 1, half = unit & 1, b = bh >> 4, h = bh & 15;
    const int rl = wave * 4 + (lane >> 4), s = lane & 15;
    const int ptok = tid >> 3, pcg = tid & 7;
    bf16* Z1 = (bf16*)(p.ws + WS_Z1); bf16* BON = (bf16*)(p.ws + WS_BONUS);
    const size_t rowbase = (size_t)b * SEQ;
    LAS bf16* RAW = (LAS bf16*)(lds + L_RAW); LAS bf16* RAWL = (LAS bf16*)(lds + L_RAWL);
    LAS float* ONKK = (LAS float*)(lds + L_NKK); LAS float* OWR = (LAS float*)(lds + L_WR); LAS float* OW = (LAS float*)(lds + L_W); LAS float* OB = (LAS float*)(lds + L_B); LAS float* OKP = (LAS float*)(lds + L_KP);
    LAS float* VL = (LAS float*)(lds + L_VL); LAS float* SC = (LAS float*)(lds + L_SC); LAS float* YB = (LAS float*)(lds + L_YB);
    LAS float* PW = (LAS float*)(lds + L_PW); LAS float* PA = (LAS float*)(lds + L_PA);
    LAS float* CST = (LAS float*)(lds + L_CST); LAS float* MUL = (LAS float*)(lds + L_MUL); LAS bf16* WB = (LAS bf16*)(lds + L_WB);
    if (tid < 96) ((LAS unsigned*)RAW)[tid] = 0u;
    if (tid < 68) ((LAS unsigned*)RAWL)[tid] = 0u;
    {
      const int a = tid >> 6, cc = tid & 63, C = h * 64 + cc;
      const float* src = a == 0 ? p.in[I_MU] + ZR : a == 1 ? p.in[I_MU] + ZK : a == 2 ? p.in[I_MU] + ZV : a == 3 ? p.in[I_W0] : a == 4 ? p.in[I_A0] : a == 5 ? p.in[I_KK] : a == 6 ? p.in[I_KA] : p.in[I_RK];
      CST[a * 64 + cc] = src[C];
      if (tid < 128) MUL[tid] = p.in[I_MU][ZWL + tid];
      const bf16* w2T = (const bf16*)(p.ws + WS_SMALL); const bf16* a2T = w2T + 65536;
      const int n = tid >> 3, k8 = tid & 7;
      *(LAS v4u*)(WB + n * WBS + 8 * k8) = *(const v4u*)(w2T + (size_t)(h * 64 + n) * 64 + 8 * k8);
      *(LAS v4u*)(WB + 64 * WBS + n * WBS + 8 * k8) = *(const v4u*)(a2T + (size_t)(h * 64 + n) * 64 + 8 * k8); }
    f32x2 S01 = {0.f, 0.f}, S23 = {0.f, 0.f};
    const int C0 = h * 64 + 8 * pcg;
    const bool vmine = (pcg >> 2) == half;
    v4u pr, pk, pv, pl0, pl1;
    { const bf16* z = Z1 + (rowbase + ptok) * NZ1;
      pr = *(const v4u*)(z + ZR + C0); pk = *(const v4u*)(z + ZK + C0); pv = vmine ? *(const v4u*)(z + ZV + C0) : (v4u){0u, 0u, 0u, 0u};
      pl0 = *(const v4u*)(z + ZWL + 16 * pcg); pl1 = *(const v4u*)(z + ZWL + 16 * pcg + 8); }
    for (int c = 0; c < SEQ / 64; ++c) {
        if (ptok == 63 && c > 0) {
            *(LAS v4u*)(RAW + 0 + 8 * pcg) = *(LAS v4u*)(RAW + 64 * 192 + 8 * pcg); *(LAS v4u*)(RAW + 64 + 8 * pcg) = *(LAS v4u*)(RAW + 64 * 192 + 64 + 8 * pcg);
            *(LAS v4u*)(RAW + 128 + 8 * pcg) = *(LAS v4u*)(RAW + 64 * 192 + 128 + 8 * pcg);
            *(LAS v4u*)(RAWL + 16 * pcg) = *(LAS v4u*)(RAWL + 64 * RLS + 16 * pcg); *(LAS v4u*)(RAWL + 16 * pcg + 8) = *(LAS v4u*)(RAWL + 64 * RLS + 16 * pcg + 8); }
        { LAS bf16* rr = RAW + (ptok + 1) * 192; *(LAS v4u*)(rr + 8 * pcg) = pr; *(LAS v4u*)(rr + 64 + 8 * pcg) = pk; *(LAS v4u*)(rr + 128 + 8 * pcg) = pv;
          LAS bf16* rl2 = RAWL + (ptok + 1) * RLS; *(LAS v4u*)(rl2 + 16 * pcg) = pl0; *(LAS v4u*)(rl2 + 16 * pcg + 8) = pl1; }
        __syncthreads();
        if (c + 1 < SEQ / 64) { const bf16* z = Z1 + (rowbase + (size_t)(c + 1) * 64 + ptok) * NZ1;
            pr = *(const v4u*)(z + ZR + C0); pk = *(const v4u*)(z + ZK + C0); if (vmine) pv = *(const v4u*)(z + ZV + C0);
            pl0 = *(const v4u*)(z + ZWL + 16 * pcg); pl1 = *(const v4u*)(z + ZWL + 16 * pcg + 8); }
#ifdef PROBE_PREP2
        for (int rep = 0; rep < (p.never == 0 ? 2 : 1); ++rep) {
#else
        {
#endif
        { const int tb = wave & 3, nh = wave >> 2, fr = lane & 15, q = lane >> 4, ti = 16 * tb + fr;
          bf16x8 aw[2], aa[2];
#pragma unroll
          for (int ks = 0; ks < 2; ++ks) {
              const int ko = 32 * ks + 8 * q;
              { const v4u cu = *(LAS v4u*)(RAWL + (ti + 1) * RLS + ko), pu = *(LAS v4u*)(RAWL + ti * RLS + ko); float cf[8], pf[8]; UNPACK8(cu, cf); UNPACK8(pu, pf);
                const f32x4 m0 = *(LAS f32x4*)(MUL + ko), m1 = *(LAS f32x4*)(MUL + ko + 4); float o[8];
#pragma unroll
                for (int e = 0; e < 8; ++e) { const float mu = e < 4 ? m0[e & 3] : m1[e & 3]; o[e] = tanh_(cf[e] + mu * (pf[e] - cf[e])); }
                v4u w; w.x = pk2(o[0], o[1]); w.y = pk2(o[2], o[3]); w.z = pk2(o[4], o[5]); w.w = pk2(o[6], o[7]); aw[ks] = __builtin_bit_cast(bf16x8, w); }
              { const v4u cu = *(LAS v4u*)(RAWL + (ti + 1) * RLS + 64 + ko), pu = *(LAS v4u*)(RAWL + ti * RLS + 64 + ko); float cf[8], pf[8]; UNPACK8(cu, cf); UNPACK8(pu, pf);
                const f32x4 m0 = *(LAS f32x4*)(MUL + 64 + ko), m1 = *(LAS f32x4*)(MUL + 64 + ko + 4); float o[8];
#pragma unroll
                for (int e = 0; e < 8; ++e) { const float mu = e < 4 ? m0[e & 3] : m1[e & 3]; o[e] = cf[e] + mu * (pf[e] - cf[e]); }
                v4u w; w.x = pk2(o[0], o[1]); w.y = pk2(o[2], o[3]); w.z = pk2(o[4], o[5]); w.w = pk2(o[6], o[7]); aa[ks] = __builtin_bit_cast(bf16x8, w); }
          }
#pragma unroll
          for (int nbi = 0; nbi < 2; ++nbi) {
              const int nb = 2 * nh + nbi, n = 16 * nb + fr;
              f32x4 cw = {0.f, 0.f, 0.f, 0.f}, ca = {0.f, 0.f, 0.f, 0.f};
#pragma unroll
              for (int ks = 0; ks < 2; ++ks) {
                  const bf16x8 bw = *(LAS bf16x8*)(WB + n * WBS + 32 * ks + 8 * q), ba = *(LAS bf16x8*)(WB + 64 * WBS + n * WBS + 32 * ks + 8 * q);
                  cw = __builtin_amdgcn_mfma_f32_16x16x32_bf16(aw[ks], bw, cw, 0, 0, 0); ca = __builtin_amdgcn_mfma_f32_16x16x32_bf16(aa[ks], ba, ca, 0, 0, 0); }
#pragma unroll
              for (int r = 0; r < 4; ++r) { const int tok = 16 * tb + 4 * q + r; PW[tok * OPS + 16 * nb + fr] = cw[r]; PA[tok * OPS + 16 * nb + fr] = ca[r]; }
          }
        }
        __syncthreads();
        { float rc[8], kc[8], vc[8], t8[8];
          const int cc0 = 8 * pcg;
          { const v4u cu = *(LAS v4u*)(RAW + (ptok + 1) * 192 + cc0), pu = *(LAS v4u*)(RAW + ptok * 192 + cc0); UNPACK8(cu, rc); UNPACK8(pu, t8);
            const f32x4 m0 = *(LAS f32x4*)(CST + cc0), m1 = *(LAS f32x4*)(CST + cc0 + 4);
#pragma unroll
            for (int e = 0; e < 8; ++e) rc[e] += (e < 4 ? m0[e & 3] : m1[e & 3]) * (t8[e] - rc[e]); }
          { const v4u cu = *(LAS v4u*)(RAW + (ptok + 1) * 192 + 64 + cc0), pu = *(LAS v4u*)(RAW + ptok * 192 + 64 + cc0); UNPACK8(cu, kc); UNPACK8(pu, t8);
            const f32x4 m0 = *(LAS f32x4*)(CST + 64 + cc0), m1 = *(LAS f32x4*)(CST + 64 + cc0 + 4);
#pragma unroll
            for (int e = 0; e < 8; ++e) kc[e] += (e < 4 ? m0[e & 3] : m1[e & 3]) * (t8[e] - kc[e]); }
          { const v4u cu = *(LAS v4u*)(RAW + (ptok + 1) * 192 + 128 + cc0), pu = *(LAS v4u*)(RAW + ptok * 192 + 128 + cc0); UNPACK8(cu, vc); UNPACK8(pu, t8);
            const f32x4 m0 = *(LAS f32x4*)(CST + 128 + cc0), m1 = *(LAS f32x4*)(CST + 128 + cc0 + 4);
#pragma unroll
            for (int e = 0; e < 8; ++e) vc[e] += (e < 4 ? m0[e & 3] : m1[e & 3]) * (t8[e] - vc[e]); }
          float dec[8], av[8], kku[8], kp[8];
          { const f32x4 wa0 = *(LAS f32x4*)(PW + ptok * OPS + cc0), wa1 = *(LAS f32x4*)(PW + ptok * OPS + cc0 + 4);
            const f32x4 aa0 = *(LAS f32x4*)(PA + ptok * OPS + cc0), aa1 = *(LAS f32x4*)(PA + ptok * OPS + cc0 + 4);
            const f32x4 w00 = *(LAS f32x4*)(CST + 192 + cc0), w01 = *(LAS f32x4*)(CST + 192 + cc0 + 4);
            const f32x4 a00 = *(LAS f32x4*)(CST + 256 + cc0), a01 = *(LAS f32x4*)(CST + 256 + cc0 + 4);
            const f32x4 kk0 = *(LAS f32x4*)(CST + 320 + cc0), kk1 = *(LAS f32x4*)(CST + 320 + cc0 + 4);
            const f32x4 ka0 = *(LAS f32x4*)(CST + 384 + cc0), ka1 = *(LAS f32x4*)(CST + 384 + cc0 + 4);
#pragma unroll
            for (int e = 0; e < 8; ++e) {
                const float wl = (e < 4 ? w00[e & 3] : w01[e & 3]) + (e < 4 ? wa0[e & 3] : wa1[e & 3]);
                dec[e] = __expf(-0.6065306597126334f * sigm(wl));
                av[e] = sigm((e < 4 ? a00[e & 3] : a01[e & 3]) + (e < 4 ? aa0[e & 3] : aa1[e & 3]));
                kku[e] = kc[e] * (e < 4 ? kk0[e & 3] : kk1[e & 3]);
                kp[e] = kc[e] * (1.f + (av[e] - 1.f) * (e < 4 ? ka0[e & 3] : ka1[e & 3])); } }
          float ss = 0.f;
#pragma unroll
          for (int e = 0; e < 8; ++e) ss += kku[e] * kku[e];
          ss = allred8(ss);
          const float inv = 1.f / fmaxf(sqrtf(ss), 1e-12f);
          const f32x4 rk0 = *(LAS f32x4*)(CST + 448 + cc0), rk1 = *(LAS f32x4*)(CST + 448 + cc0 + 4);
          float nk[8], bb[8], wr8[8], br = 0.f, kr = 0.f, bon = 0.f;
#pragma unroll
          for (int e = 0; e < 8; ++e) { const float kk = kku[e] * inv; nk[e] = -kk; bb[e] = kk * av[e]; wr8[e] = dec[e] * rc[e];
              br += bb[e] * rc[e]; kr += kp[e] * rc[e]; bon += rc[e] * kp[e] * (e < 4 ? rk0[e & 3] : rk1[e & 3]); }
          br = allred8(br); kr = allred8(kr); bon = allred8(bon);
          const int o = ptok * OPS + 8 * pcg;
          *(LAS f32x4*)(ONKK + o) = (f32x4){nk[0], nk[1], nk[2], nk[3]}; *(LAS f32x4*)(ONKK + o + 4) = (f32x4){nk[4], nk[5], nk[6], nk[7]};
          *(LAS f32x4*)(OWR + o) = (f32x4){wr8[0], wr8[1], wr8[2], wr8[3]}; *(LAS f32x4*)(OWR + o + 4) = (f32x4){wr8[4], wr8[5], wr8[6], wr8[7]};
          *(LAS f32x4*)(OW + o) = (f32x4){dec[0], dec[1], dec[2], dec[3]}; *(LAS f32x4*)(OW + o + 4) = (f32x4){dec[4], dec[5], dec[6], dec[7]};
          *(LAS f32x4*)(OB + o) = (f32x4){bb[0], bb[1], bb[2], bb[3]}; *(LAS f32x4*)(OB + o + 4) = (f32x4){bb[4], bb[5], bb[6], bb[7]};
          *(LAS f32x4*)(OKP + o) = (f32x4){kp[0], kp[1], kp[2], kp[3]}; *(LAS f32x4*)(OKP + o + 4) = (f32x4){kp[4], kp[5], kp[6], kp[7]};
          if (pcg == 0) *(LAS f32x2*)(SC + 2 * ptok) = (f32x2){br, kr};
          if (vmine) { const int vo = ptok * 32 + 8 * (pcg & 3);
              *(LAS f32x4*)(VL + vo) = (f32x4){vc[0], vc[1], vc[2], vc[3]}; *(LAS f32x4*)(VL + vo + 4) = (f32x4){vc[4], vc[5], vc[6], vc[7]};
              v4u w; w.x = pk2(bon * vc[0], bon * vc[1]); w.y = pk2(bon * vc[2], bon * vc[3]); w.z = pk2(bon * vc[4], bon * vc[5]); w.w = pk2(bon * vc[6], bon * vc[7]);
              if (!dry) *(v4u*)(BON + (rowbase + (size_t)c * 64 + ptok) * DM + C0) = w; }
        }
        __syncthreads();
        }
        { float sak = 0.f, y0k = 0.f;
#define WK_LOAD(o, t) do { o.nk = *(const LAS f32x4*)(ONKK + (t) * OPS + 4 * s); o.wr = *(const LAS f32x4*)(OWR + (t) * OPS + 4 * s); o.w = *(const LAS f32x4*)(OW + (t) * OPS + 4 * s); \
              o.b = *(const LAS f32x4*)(OB + (t) * OPS + 4 * s); o.k = *(const LAS f32x4*)(OKP + (t) * OPS + 4 * s); o.vi[0] = VL[(t) * 32 + rl]; } while (0)
#define WK_STEP(o, tl) do { \
              f32x2 ac = pk_mul(S01, (f32x2){o.nk[0], o.nk[1]}); ac = pk_fma(S23, (f32x2){o.nk[2], o.nk[3]}, ac); \
              f32x2 ay = pk_mul(S01, (f32x2){o.wr[0], o.wr[1]}); ay = pk_fma(S23, (f32x2){o.wr[2], o.wr[3]}, ay); \
              float psa = add_asm(ac[0], ac[1]), py = add_asm(ay[0], ay[1]); \
              allred16x2(psa, py); f32x2 sap; sap[0] = psa; sap[1] = 0.f; \
              S01 = pk_mul(S01, (f32x2){o.w[0], o.w[1]}); S23 = pk_mul(S23, (f32x2){o.w[2], o.w[3]}); \
              S01 = pk_fma_b((f32x2){o.b[0], o.b[1]}, sap, S01); S23 = pk_fma_b((f32x2){o.b[2], o.b[3]}, sap, S23); \
              S01 = pk_fma_b((f32x2){o.k[0], o.k[1]}, o.vi, S01); S23 = pk_fma_b((f32x2){o.k[2], o.k[3]}, o.vi, S23); \
              const bool mine = (s == (tl)); sak = mine ? psa : sak; y0k = mine ? py : y0k; } while (0)
          StepOps A0, A1, B0, B1; A0.vi[1] = A1.vi[1] = B0.vi[1] = B1.vi[1] = 0.f;
          WK_LOAD(A0, 0); WK_LOAD(A1, 1);
#pragma unroll 1
          for (int tb = 0; tb < 64; tb += 16) {
              WK_LOAD(B0, tb + 2); WK_LOAD(B1, tb + 3);   WK_STEP(A0, 0); WK_STEP(A1, 1);
              WK_LOAD(A0, tb + 4); WK_LOAD(A1, tb + 5);   WK_STEP(B0, 2); WK_STEP(B1, 3);
              WK_LOAD(B0, tb + 6); WK_LOAD(B1, tb + 7);   WK_STEP(A0, 4); WK_STEP(A1, 5);
              WK_LOAD(A0, tb + 8); WK_LOAD(A1, tb + 9);   WK_STEP(B0, 6); WK_STEP(B1, 7);
              WK_LOAD(B0, tb + 10); WK_LOAD(B1, tb + 11); WK_STEP(A0, 8); WK_STEP(A1, 9);
              WK_LOAD(A0, tb + 12); WK_LOAD(A1, tb + 13); WK_STEP(B0, 10); WK_STEP(B1, 11);
              WK_LOAD(B0, tb + 14); WK_LOAD(B1, tb + 15); WK_STEP(A0, 12); WK_STEP(A1, 13);
              const int tn = (tb + 16) & 63;
              WK_LOAD(A0, tn); WK_LOAD(A1, tn + 1);       WK_STEP(B0, 14); WK_STEP(B1, 15);
              { const int t = tb + s; const f32x2 sc = *(const LAS f32x2*)(SC + 2 * t); YB[t * 32 + rl] = y0k + sak * sc[0] + VL[t * 32 + rl] * sc[1]; }
          }
#undef WK_LOAD
#undef WK_STEP
        }
        __syncthreads();
        { const f32x4 yv = *(LAS f32x4*)(YB + ptok * 32 + 4 * pcg); v2u w; w.x = pk2(yv[0], yv[1]); w.y = pk2(yv[2], yv[3]);
          if (!dry) *(v2u*)(Z1 + (rowbase + (size_t)c * 64 + ptok) * NZ1 + ZV + h * 64 + 32 * half + 4 * pcg) = w; }
    }
    if (!dry) *(f32x4*)(p.out + O_WKVP + ((size_t)(b * 16 + h) * 64 + 32 * half + rl) * 64 + 4 * s) = (f32x4){S01[0], S01[1], S23[0], S23[1]};
    __syncthreads();
}

__device__ __forceinline__ void wkv_sample(CP& p, LAS unsigned char* lds) {
    int tid_l = threadIdx.x; asm volatile("" : "+v"(tid_l)); const int tid = tid_l, lane = tid & 63;
    const int i = tid >> 3, s8 = tid & 7;
    bf16* Z1 = (bf16*)(p.ws + WS_Z1); bf16* BON = (bf16*)(p.ws + WS_BONUS);
    LAS float* TW = (LAS float*)lds; LAS float* TA = TW + 256; LAS float* ONKK = TW + 512; LAS float* OWR = TW + 768; LAS float* OW = TW + 1024;
    LAS float* OB = TW + 1280; LAS float* OKP = TW + 1536; LAS float* VV = TW + 1792; LAS float* SC = TW + 2048; LAS float* YS = TW + 2064;
    const float* Sin = p.in[I_WKV];
    int u = blockIdx.x;
    f32x4 sa0, sa1;
    if (u < DECB * 16) { const float* sp = Sin + ((size_t)u * 64 + i) * 64 + 8 * s8; sa0 = *(const f32x4*)sp; sa1 = *(const f32x4*)(sp + 4); }
    for (; u < DECB * 16; u += gridDim.x) {
        const int b = u >> 4, h = u & 15;
        float S[8] = {sa0[0], sa0[1], sa0[2], sa0[3], sa1[0], sa1[1], sa1[2], sa1[3]};
        { const int un = u + gridDim.x; if (un < DECB * 16) { const float* sp = Sin + ((size_t)un * 64 + i) * 64 + 8 * s8; sa0 = *(const f32x4*)sp; sa1 = *(const f32x4*)(sp + 4); } }
        const int tok = tid >> 6, c = lane, C = h * 64 + c;
        const size_t rowc = (size_t)MP + 4 * b + (tok & 3), rowp = (tok & 3) == 0 ? (size_t)MT + b : rowc - 1;
        float r = 0.f, k = 0.f, v = 0.f;
        if (tid < 256) {
            const bf16* zc = Z1 + rowc * NZ1; const bf16* zp = Z1 + rowp * NZ1; const float* mu = p.in[I_MU];
            r = bf2f(zc[ZR + C]); r += mu[ZR + C] * (bf2f(zp[ZR + C]) - r);
            k = bf2f(zc[ZK + C]); k += mu[ZK + C] * (bf2f(zp[ZK + C]) - k);
            v = bf2f(zc[ZV + C]); v += mu[ZV + C] * (bf2f(zp[ZV + C]) - v);
            float wl = bf2f(zc[ZWL + c]); wl += mu[ZWL + c] * (bf2f(zp[ZWL + c]) - wl);
            float al = bf2f(zc[ZAL + c]); al += mu[ZAL + c] * (bf2f(zp[ZAL + c]) - al);
            TW[tok * 64 + c] = tanh_(wl); TA[tok * 64 + c] = al;
        }
        __syncthreads();
        if (tid < 256) {
            float wp = 0.f, ap = 0.f; const float* w2 = p.in[I_W2] + C; const float* a2 = p.in[I_A2] + C;
#pragma unroll 8
            for (int kk = 0; kk < 64; ++kk) { wp += TW[tok * 64 + kk] * w2[(size_t)kk * DM]; ap += TA[tok * 64 + kk] * a2[(size_t)kk * DM]; }
            const float dec = __expf(-0.6065306597126334f * sigm(p.in[I_W0][C] + wp));
            const float a = sigm(p.in[I_A0][C] + ap);
            const float kku = k * p.in[I_KK][C];
            const float kp = k * (1.f + (a - 1.f) * p.in[I_KA][C]);
            const float ss = wave_sum(kku * kku);
            const float kk = kku / fmaxf(sqrtf(ss), 1e-12f);
            const float bb = kk * a;
            const float br = wave_sum(bb * r), kr = wave_sum(kp * r), bon = wave_sum(r * kp * p.in[I_RK][C]);
            ONKK[tok * 64 + c] = -kk; OWR[tok * 64 + c] = dec * r; OW[tok * 64 + c] = dec; OB[tok * 64 + c] = bb; OKP[tok * 64 + c] = kp; VV[tok * 64 + c] = v;
            if (c == 0) { SC[2 * tok] = br; SC[2 * tok + 1] = kr; }
            BON[rowc * DM + C] = (bf16)f2bf(bon * v);
        }
        __syncthreads();
#pragma unroll
        for (int t = 0; t < 4; ++t) {
            const f32x4 n0 = *(LAS f32x4*)(ONKK + t * 64 + 8 * s8), n1 = *(LAS f32x4*)(ONKK + t * 64 + 8 * s8 + 4);
            const f32x4 q0 = *(LAS f32x4*)(OWR + t * 64 + 8 * s8), q1 = *(LAS f32x4*)(OWR + t * 64 + 8 * s8 + 4);
            const f32x4 w0 = *(LAS f32x4*)(OW + t * 64 + 8 * s8), w1 = *(LAS f32x4*)(OW + t * 64 + 8 * s8 + 4);
            const f32x4 b0 = *(LAS f32x4*)(OB + t * 64 + 8 * s8), b1 = *(LAS f32x4*)(OB + t * 64 + 8 * s8 + 4);
            const f32x4 k0 = *(LAS f32x4*)(OKP + t * 64 + 8 * s8), k1 = *(LAS f32x4*)(OKP + t * 64 + 8 * s8 + 4);
            const float vi = VV[t * 64 + i], br = SC[2 * t], kr = SC[2 * t + 1];
            float psa = 0.f, py = 0.f;
#pragma unroll
            for (int e = 0; e < 8; ++e) { psa += S[e] * (e < 4 ? n0[e & 3] : n1[e & 3]); py += S[e] * (e < 4 ? q0[e & 3] : q1[e & 3]); }
            const float sa = allred8(psa), y0 = allred8(py);
#pragma unroll
            for (int e = 0; e < 8; ++e) S[e] = S[e] * (e < 4 ? w0[e & 3] : w1[e & 3]) + sa * (e < 4 ? b0[e & 3] : b1[e & 3]) + vi * (e < 4 ? k0[e & 3] : k1[e & 3]);
            if (s8 == 0) YS[t * 64 + i] = y0 + sa * br + vi * kr;
        }
        { float* so = p.out + O_WKVS + ((size_t)u * 64 + i) * 64 + 8 * s8; *(f32x4*)so = (f32x4){S[0], S[1], S[2], S[3]}; *(f32x4*)(so + 4) = (f32x4){S[4], S[5], S[6], S[7]}; }
        __syncthreads();
        if (tid < 256) Z1[rowc * NZ1 + ZV + C] = (bf16)f2bf(YS[tok * 64 + c]);
        __syncthreads();
    }
}

constexpr int LL_XR = 0, LL_UB = 8704, LL_UF = 17920, LL_PR = 26112, LL_PI = 34560, LL_CA = 43008, LL_CB = 45056, LL_HC = 47104;
__device__ __forceinline__ void lru_prompt(CP& p, LAS unsigned char* lds, int unit, bool dry) {
    int tid_l = threadIdx.x; asm volatile("" : "+v"(tid_l)); const int tid = tid_l, wave = tid >> 6, lane = tid & 63;
    const int b = unit >> 5, n = (unit >> 1) & 15, hf = unit & 1;
    const int ptok = tid >> 3, pcg = tid & 7;
    bf16* Z1 = (bf16*)(p.ws + WS_Z1);
    const bf16* waT = (const bf16*)(p.ws + WS_SMALL) + 262144; const bf16* wiT = waT + 65536;
    const size_t rowbase = (size_t)b * SEQ;
    LAS bf16* XR = (LAS bf16*)(lds + LL_XR); LAS bf16* UB = (LAS bf16*)(lds + LL_UB); LAS float* UF = (LAS float*)(lds + LL_UF);
    LAS float* PR = (LAS float*)(lds + LL_PR); LAS float* PI = (LAS float*)(lds + LL_PI); LAS float* CA = (LAS float*)(lds + LL_CA);
    LAS float* CB = (LAS float*)(lds + LL_CB); LAS float* HC = (LAS float*)(lds + LL_HC);
    if (tid < 96) ((LAS unsigned*)XR)[tid] = 0u;
    if (tid < 32) HC[tid] = 0.f;
    const int mb = wave & 3, gate = wave >> 2, fr = lane & 15, q = lane >> 4;
    bf16x8 Bf[2][2];
#pragma unroll
    for (int nb = 0; nb < 2; ++nb)
#pragma unroll
        for (int ks = 0; ks < 2; ++ks) Bf[nb][ks] = *(const bf16x8*)((gate ? wiT : waT) + (size_t)n * 4096 + (32 * hf + 16 * nb + fr) * 64 + 32 * ks + 8 * q);
    const int dl = tid & 31, sub = tid >> 5, Cs = 64 * n + 32 * hf + dl;
    const int etok = tid >> 3, dg = tid & 7, Ce = 64 * n + 32 * hf + 4 * dg;
    const f32x4 ba4 = *(const f32x4*)(p.in[I_BA] + Ce), bi4 = *(const f32x4*)(p.in[I_BI] + Ce), lam4 = *(const f32x4*)(p.in[I_LAM] + Ce);
    f32x4 sp4;
#pragma unroll
    for (int e = 0; e < 4; ++e) sp4[e] = -8.f * __logf(1.f + __expf(-lam4[e]));
    const int Cc = 64 * n + 8 * pcg;
    v4u px = *(const v4u*)(Z1 + (rowbase + ptok) * NZ1 + ZXB + Cc);
    float hlast = 0.f;
    for (int c = 0; c < SEQ / 64; ++c) {
        if (ptok >= 61 && c > 0) *(LAS v4u*)(XR + (ptok - 61) * 64 + 8 * pcg) = *(LAS v4u*)(XR + (3 + ptok) * 64 + 8 * pcg);
        *(LAS v4u*)(XR + (3 + ptok) * 64 + 8 * pcg) = px;
        __syncthreads();
        if (c + 1 < SEQ / 64) px = *(const v4u*)(Z1 + (rowbase + (size_t)(c + 1) * 64 + ptok) * NZ1 + ZXB + Cc);
        unsigned short gbr[4];
#pragma unroll
        for (int i2 = 0; i2 < 4; ++i2) gbr[i2] = Z1[(rowbase + (size_t)c * 64 + 4 * sub + i2) * NZ1 + ZGB + Cs];
        { float u8[8];
          { const f32x4 c0 = *(const f32x4*)(p.in[I_CB] + Cc), c1 = *(const f32x4*)(p.in[I_CB] + Cc + 4);
#pragma unroll
            for (int e = 0; e < 8; ++e) u8[e] = e < 4 ? c0[e & 3] : c1[e & 3]; }
#pragma unroll
          for (int j = 0; j < 4; ++j) { const v4u xu = *(LAS v4u*)(XR + (ptok + j) * 64 + 8 * pcg); float xf[8]; UNPACK8(xu, xf);
              const f32x4 w0 = *(const f32x4*)(p.in[I_CW] + j * DM + Cc), w1 = *(const f32x4*)(p.in[I_CW] + j * DM + Cc + 4);
#pragma unroll
              for (int e = 0; e < 8; ++e) u8[e] += (e < 4 ? w0[e & 3] : w1[e & 3]) * xf[e]; }
          v4u w; w.x = pk2(u8[0], u8[1]); w.y = pk2(u8[2], u8[3]); w.z = pk2(u8[4], u8[5]); w.w = pk2(u8[6], u8[7]);
          *(LAS v4u*)(UB + ptok * 72 + 8 * pcg) = w;
          if ((pcg >> 2) == hf) { *(LAS f32x4*)(UF + ptok * 32 + 8 * (pcg & 3)) = (f32x4){u8[0], u8[1], u8[2], u8[3]}; *(LAS f32x4*)(UF + ptok * 32 + 8 * (pcg & 3) + 4) = (f32x4){u8[4], u8[5], u8[6], u8[7]}; }
        }
        __syncthreads();
        { const bf16x8 A0 = *(LAS bf16x8*)(UB + (16 * mb + fr) * 72 + 8 * q), A1 = *(LAS bf16x8*)(UB + (16 * mb + fr) * 72 + 32 + 8 * q);
          LAS float* P = gate ? PI : PR;
#pragma unroll
          for (int nb = 0; nb < 2; ++nb) { f32x4 acc = {0.f, 0.f, 0.f, 0.f};
              acc = __builtin_amdgcn_mfma_f32_16x16x32_bf16(A0, Bf[nb][0], acc, 0, 0, 0); acc = __builtin_amdgcn_mfma_f32_16x16x32_bf16(A1, Bf[nb][1], acc, 0, 0, 0);
#pragma unroll
              for (int r = 0; r < 4; ++r) P[(16 * mb + 4 * q + r) * 33 + 16 * nb + fr] = acc[r]; } }
        __syncthreads();
        {
#pragma unroll
          for (int e = 0; e < 4; ++e) { const int o = etok * 33 + 4 * dg + e;
              const float rg = sigm(PR[o] + ba4[e]), ig = sigm(PI[o] + bi4[e]);
              const float a = __expf(sp4[e] * rg);
              float mult = sqrtf(fmaxf(1.f - a * a, 0.f)); if (c == 0 && etok == 0) mult = 1.f;
              PR[o] = a; PI[o] = mult * ig * UF[etok * 32 + 4 * dg + e]; } }
        __syncthreads();
        { float av[4], bx[4];
#pragma unroll
          for (int i2 = 0; i2 < 4; ++i2) { av[i2] = PR[(4 * sub + i2) * 33 + dl]; bx[i2] = PI[(4 * sub + i2) * 33 + dl]; }
          float hl = 0.f, ap = 1.f;
#pragma unroll
          for (int i2 = 0; i2 < 4; ++i2) { hl = av[i2] * hl + bx[i2]; ap *= av[i2]; }
          CA[sub * 32 + dl] = ap; CB[sub * 32 + dl] = hl;
          float h = HC[dl];
          __syncthreads();
          for (int s2 = 0; s2 < sub; ++s2) h = CA[s2 * 32 + dl] * h + CB[s2 * 32 + dl];
#pragma unroll
          for (int i2 = 0; i2 < 4; ++i2) { h = av[i2] * h + bx[i2];
              if (!dry) Z1[(rowbase + (size_t)c * 64 + 4 * sub + i2) * NZ1 + ZGB + Cs] = (bf16)f2bf(h * gelu_tanh(bf2f(gbr[i2]))); }
          if (sub == 15) { HC[dl] = h; hlast = h; }
        }
        __syncthreads();
    }
    if (sub == 15 && !dry) p.out[O_LRUP + (size_t)b * DM + Cs] = hlast;
    if (hf == 0 && tid < 192 && !dry) { const int j = tid >> 6, cc = tid & 63; p.out[O_CONVP + ((size_t)b * 3 + j) * DM + 64 * n + cc] = bf2f(XR[(64 + j) * 64 + cc]); }
    __syncthreads();
}

__device__ __forceinline__ void lru_sample(CP& p, LAS unsigned char* lds) {
    int tid_l = threadIdx.x; asm volatile("" : "+v"(tid_l)); const int tid = tid_l;
    bf16* Z1 = (bf16*)(p.ws + WS_Z1);
    LAS float* U = (LAS float*)lds;
    for (int b = blockIdx.x; b < DECB; b += gridDim.x) {
        const int C = 2 * tid, n = C >> 6, d = C & 63;
        float xp0[7], xp1[7];
#pragma unroll
        for (int j = 0; j < 3; ++j) { const f32x2 v = *(const f32x2*)(p.in[I_CONV] + ((size_t)b * 3 + j) * DM + C); xp0[j] = v[0]; xp1[j] = v[1]; }
#pragma unroll
        for (int j = 0; j < 4; ++j) { const unsigned v = *(const unsigned*)(Z1 + ((size_t)MP + 4 * b + j) * NZ1 + ZXB + C); xp0[3 + j] = lo16(v); xp1[3 + j] = hi16(v); }
        { const f32x2 cb = *(const f32x2*)(p.in[I_CB] + C); f32x2 cw[4];
#pragma unroll
          for (int j = 0; j < 4; ++j) cw[j] = *(const f32x2*)(p.in[I_CW] + j * DM + C);
#pragma unroll
          for (int t = 0; t < 4; ++t) { float u0 = cb[0], u1 = cb[1];
#pragma unroll
              for (int j = 0; j < 4; ++j) { u0 += cw[j][0] * xp0[t + j]; u1 += cw[j][1] * xp1[t + j]; }
              *(LAS f32x2*)(U + t * DM + C) = (f32x2){u0, u1}; } }
        __syncthreads();
        float pr[4][2], pi[4][2];
#pragma unroll
        for (int t = 0; t < 4; ++t) { pr[t][0] = pr[t][1] = pi[t][0] = pi[t][1] = 0.f; }
        const float* wa = p.in[I_WA] + (size_t)n * 4096 + d; const float* wi = p.in[I_WI] + (size_t)n * 4096 + d;
#pragma unroll 4
        for (int cc = 0; cc < 64; ++cc) { const f32x2 a = *(const f32x2*)(wa + cc * 64), i2 = *(const f32x2*)(wi + cc * 64);
#pragma unroll
            for (int t = 0; t < 4; ++t) { const float uu = U[t * DM + 64 * n + cc]; pr[t][0] += uu * a[0]; pr[t][1] += uu * a[1]; pi[t][0] += uu * i2[0]; pi[t][1] += uu * i2[1]; } }
        const f32x2 ba = *(const f32x2*)(p.in[I_BA] + C), bi = *(const f32x2*)(p.in[I_BI] + C), lam = *(const f32x2*)(p.in[I_LAM] + C), h0 = *(const f32x2*)(p.in[I_LRU] + (size_t)b * DM + C);
        float h[2] = {h0[0], h0[1]};
        const float sp[2] = {-8.f * __logf(1.f + __expf(-lam[0])), -8.f * __logf(1.f + __expf(-lam[1]))};
#pragma unroll
        for (int t = 0; t < 4; ++t) { const f32x2 uu = *(LAS f32x2*)(U + t * DM + C);
            bf16* zp = Z1 + ((size_t)MP + 4 * b + t) * NZ1 + ZGB + C; const unsigned g = *(const unsigned*)zp; float yb[2];
#pragma unroll
            for (int e = 0; e < 2; ++e) { const float rg = sigm(pr[t][e] + ba[e]), ig = sigm(pi[t][e] + bi[e]); const float a = __expf(sp[e] * rg);
                const float mult = sqrtf(fmaxf(1.f - a * a, 0.f)); h[e] = a * h[e] + mult * ig * uu[e]; yb[e] = h[e] * gelu_tanh(e ? hi16(g) : lo16(g)); }
            *(unsigned*)zp = pk2(yb[0], yb[1]); }
        *(f32x2*)(p.out + O_LRUS + (size_t)b * DM + C) = (f32x2){h[0], h[1]};
#pragma unroll
        for (int j = 0; j < 3; ++j) *(f32x2*)(p.out + O_CONVS + ((size_t)b * 3 + j) * DM + C) = (f32x2){xp0[4 + j], xp1[4 + j]};
        __syncthreads();
    }
}

__device__ __forceinline__ void phase_merge(CP& p, LAS unsigned char* lds) {
    int tid_l = threadIdx.x; asm volatile("" : "+v"(tid_l)); const int tid = tid_l, wave = tid >> 6, lane = tid & 63, fr = lane & 15, q = lane >> 4;
    const bf16* Z1 = (const bf16*)(p.ws + WS_Z1); const bf16* BON = (const bf16*)(p.ws + WS_BONUS); const bf16* Zg = (const bf16*)p.out;
    const bf16* g2T = (const bf16*)(p.ws + WS_SMALL) + 131072; bf16* MG = (bf16*)(p.ws + WS_XB);
    LAS float* GL = (LAS float*)lds;
    const int tk = tid >> 7, cg8 = tid & 127, Cm = 8 * cg8;
    const f32x4 lg0 = *(const f32x4*)(p.in[I_LNXG] + Cm), lg1 = *(const f32x4*)(p.in[I_LNXG] + Cm + 4), lb0 = *(const f32x4*)(p.in[I_LNXB] + Cm), lb1 = *(const f32x4*)(p.in[I_LNXB] + Cm + 4);
    for (int unit = blockIdx.x; unit < MT / 16; unit += gridDim.x) {
        const int m0 = unit * 16;
        {
          const int m = m0 + fr; size_t prow; bool pz = false;
          if (m < MP) { if ((m & (SEQ - 1)) == 0) { pz = true; prow = m; } else prow = m - 1; } else { const int ms = m - MP; prow = (ms & 3) == 0 ? (size_t)MT + (ms >> 2) : (size_t)m - 1; }
          bf16x8 Tf[4];
#pragma unroll
          for (int ks = 0; ks < 4; ++ks) { const int ko = 32 * ks + 8 * q;
              const v4u cu = *(const v4u*)(Z1 + (size_t)m * NZ1 + ZGL + ko); v4u pu = *(const v4u*)(Z1 + prow * NZ1 + ZGL + ko); if (pz) pu = (v4u){0u, 0u, 0u, 0u};
              float cf[8], pf[8]; UNPACK8(cu, cf); UNPACK8(pu, pf);
              const f32x4 mu0 = *(const f32x4*)(p.in[I_MU] + ZGL + ko), mu1 = *(const f32x4*)(p.in[I_MU] + ZGL + ko + 4); float o[8];
#pragma unroll
              for (int e = 0; e < 8; ++e) o[e] = sigm(cf[e] + (e < 4 ? mu0[e & 3] : mu1[e & 3]) * (pf[e] - cf[e]));
              v4u w; w.x = pk2(o[0], o[1]); w.y = pk2(o[2], o[3]); w.z = pk2(o[4], o[5]); w.w = pk2(o[6], o[7]); Tf[ks] = __builtin_bit_cast(bf16x8, w); }
#pragma unroll 2
          for (int nbi = 0; nbi < 8; ++nbi) { const int nb = wave * 8 + nbi; f32x4 acc = {0.f, 0.f, 0.f, 0.f};
#pragma unroll
              for (int ks = 0; ks < 4; ++ks) { const bf16x8 gf = *(const bf16x8*)(g2T + (size_t)(16 * nb + fr) * 128 + 32 * ks + 8 * q); acc = __builtin_amdgcn_mfma_f32_16x16x32_bf16(gf, Tf[ks], acc, 0, 0, 0); }
              *(LAS f32x4*)(GL + fr * 1028 + 16 * nb + 4 * q) = acc; }
        }
        __syncthreads();
#pragma unroll 1
        for (int ps = 0; ps < 4; ++ps) {
            const int tok = 4 * ps + tk; const size_t m = (size_t)m0 + tok;
            const v4u yu = *(const v4u*)(Z1 + m * NZ1 + ZV + Cm), bu = *(const v4u*)(BON + m * DM + Cm), ybu = *(const v4u*)(Z1 + m * NZ1 + ZGB + Cm);
            const v4u gau = *(const v4u*)(Zg + m * 2048 + Cm), gbu = *(const v4u*)(Zg + m * 2048 + 1024 + Cm);
            const f32x4 g0 = *(LAS f32x4*)(GL + tok * 1028 + Cm), g1 = *(LAS f32x4*)(GL + tok * 1028 + Cm + 4);
            float y[8], bo[8], yb[8], ga[8], gb[8]; UNPACK8(yu, y); UNPACK8(bu, bo); UNPACK8(ybu, yb); UNPACK8(gau, ga); UNPACK8(gbu, gb);
            float sm = 0.f;
#pragma unroll
            for (int e = 0; e < 8; ++e) sm += y[e];
            const float mean = allred8(sm) * (1.f / 64.f); float sq = 0.f;
#pragma unroll
            for (int e = 0; e < 8; ++e) { y[e] -= mean; sq += y[e] * y[e]; }
            const float rstd = __builtin_amdgcn_rsqf(allred8(sq) * (1.f / 64.f) + GN_EPS);
            float o[8];
#pragma unroll
            for (int e = 0; e < 8; ++e) { const float yn = y[e] * rstd * (e < 4 ? lg0[e & 3] : lg1[e & 3]) + (e < 4 ? lb0[e & 3] : lb1[e & 3]);
                const float yA = (yn + bo[e]) * (e < 4 ? g0[e & 3] : g1[e & 3]); o[e] = sigm(ga[e]) * yA + sigm(gb[e]) * yb[e]; }
            v4u w; w.x = pk2(o[0], o[1]); w.y = pk2(o[2], o[3]); w.z = pk2(o[4], o[5]); w.w = pk2(o[6], o[7]);
            *(v4u*)(MG + m * DM + Cm) = w;
        }
        __syncthreads();
    }
}


__device__ __forceinline__ void mini_gemm_tail(LAS unsigned char* lds, const bf16* A, int lda, const bf16* Bt, int K, const float* res, float* out) {
    int tid_l = threadIdx.x; asm volatile("" : "+v"(tid_l)); const int tid = tid_l, wave = tid >> 6, lane = tid & 63, fr = lane & 15, q = lane >> 4;
    LAS float* RED = (LAS float*)lds;
    for (int task = blockIdx.x; task < 256; task += gridDim.x) {
        const int row0 = MP + 32 * (task >> 4), col0 = 64 * (task & 15);
        const int kw = K >> 3, kb = wave * kw;
        f32x4 acc[2][4];
#pragma unroll
        for (int mb = 0; mb < 2; ++mb)
#pragma unroll
            for (int nb = 0; nb < 4; ++nb) acc[mb][nb] = (f32x4){0.f, 0.f, 0.f, 0.f};
        const bf16* ap = A + (size_t)(row0 + fr) * lda + kb + 8 * q; const bf16* bp = Bt + (size_t)(col0 + fr) * K + kb + 8 * q;
#pragma unroll 2
        for (int k0 = 0; k0 < kw; k0 += 32) {
            bf16x8 af[2], bf[4];
#pragma unroll
            for (int mb = 0; mb < 2; ++mb) af[mb] = *(const bf16x8*)(ap + (size_t)(16 * mb) * lda + k0);
#pragma unroll
            for (int nb = 0; nb < 4; ++nb) bf[nb] = *(const bf16x8*)(bp + (size_t)(16 * nb) * K + k0);
#pragma unroll
            for (int mb = 0; mb < 2; ++mb)
#pragma unroll
                for (int nb = 0; nb < 4; ++nb) acc[mb][nb] = __builtin_amdgcn_mfma_f32_16x16x32_bf16(bf[nb], af[mb], acc[mb][nb], 0, 0, 0);
        }
#pragma unroll
        for (int mb = 0; mb < 2; ++mb)
#pragma unroll
            for (int nb = 0; nb < 4; ++nb) *(LAS f32x4*)(RED + wave * 2048 + (16 * mb + fr) * 64 + 16 * nb + 4 * q) = acc[mb][nb];
        __syncthreads();
        { const int r = tid >> 4, c4 = (tid & 15) * 4; f32x4 sum = *(LAS f32x4*)(RED + r * 64 + c4);
#pragma unroll
          for (int w = 1; w < 8; ++w) sum += *(LAS f32x4*)(RED + w * 2048 + r * 64 + c4);
          const size_t o = (size_t)(row0 + r) * DM + col0 + c4; const f32x4 x = *(const f32x4*)(res + o);
          *(f32x4*)(out + o) = sum + x * ALPHA; }
        __syncthreads();
    }
}

template <bool FINAL> __device__ __forceinline__ void phase_ln(CP& p, const float* g, const float* bb) {
    int tid_l = threadIdx.x; asm volatile("" : "+v"(tid_l)); const int tid = tid_l, wave = tid >> 6, lane = tid & 63;
    float* H1 = (float*)(p.ws + WS_H1); bf16* H1B = (bf16*)(p.ws + WS_H1B);
    f32x4 gv[4], bv[4];
#pragma unroll
    for (int j = 0; j < 4; ++j) { gv[j] = *(const f32x4*)(g + 4 * lane + 256 * j); bv[j] = *(const f32x4*)(bb + 4 * lane + 256 * j); }
    for (int m = blockIdx.x * 8 + wave; m < MT; m += gridDim.x * 8) {
        float* xr = H1 + (size_t)m * DM + 4 * lane; f32x4 v[4]; float s = 0.f;
#pragma unroll
        for (int j = 0; j < 4; ++j) { v[j] = *(const f32x4*)(xr + 256 * j); s += (v[j][0] + v[j][1]) + (v[j][2] + v[j][3]); }
        const float mean = wave_sum(s) * (1.f / DM); float s2 = 0.f;
#pragma unroll
        for (int j = 0; j < 4; ++j) { v[j] = v[j] - mean; s2 += (v[j][0] * v[j][0] + v[j][1] * v[j][1]) + (v[j][2] * v[j][2] + v[j][3] * v[j][3]); }
        const float rstd = 1.f / sqrtf(wave_sum(s2) * (1.f / DM) + LN_EPS);
#pragma unroll
        for (int j = 0; j < 4; ++j) { v[j] = v[j] * rstd * gv[j] + bv[j];
            if (FINAL) *(f32x4*)(p.out + O_Y + (size_t)m * DM + 4 * lane + 256 * j) = v[j];
            else { *(f32x4*)(xr + 256 * j) = v[j]; *(v2u*)(H1B + (size_t)m * DM + 4 * lane + 256 * j) = (v2u){pk2(v[j][0], v[j][1]), pk2(v[j][2], v[j][3])}; } }
    }
}

__global__ void __launch_bounds__(512, 2) hybrid_step_kernel(Params p_unused) {
    CP* pp = (CP*)__builtin_amdgcn_kernarg_segment_ptr();
#define p (*launder(pp))
    extern __shared__ __attribute__((aligned(16))) unsigned char lds_raw[];
    LAS unsigned char* lds = (LAS unsigned char*)lds_raw;
    volatile LAS unsigned* MISC = (volatile LAS unsigned*)(lds + MISC_OFF);
    if (threadIdx.x < 16) MISC[threadIdx.x] = 0u;
    __syncthreads();
    XcdBarrier bar = xcd_barrier_post((unsigned*)(p.ws + WS_CTL) + CW_BAR, MISC + 8);
    if (p.never) cg::this_grid().sync();
    const int G = gridDim.x, bx = blockIdx.x;

    phase0(p, lds);

#ifdef PROBE_INSTR
    { float x0 = threadIdx.x, x1 = x0 + 1.f, x2 = x0 + 2.f, x3 = x0 + 3.f, x4 = x0 + 4.f, x5 = x0 + 5.f, x6 = x0 + 6.f, x7 = x0 + 7.f; const float kf = 0.999f; const unsigned hh = 0x3c003c00u; f32x2 kp = {0.999f, 0.998f}; f32x2 x0p = {x0, x1}, x1p = {x1, x2}, x2p = {x2, x3}, x3p = {x3, x4}, x4p = {x4, x5}, x5p = {x5, x6}, x6p = {x6, x7}, x7p = {x7, x0};
      const int nit = (p.never == 0 ? 20000 : 1);
      for (int it = 0; it < nit; ++it) {
#if PROBE_INSTR == 1
#define PI(x) asm volatile("v_fma_f32 %0, %0, %1, %0" : "+v"(x) : "v"(kf))
#elif PROBE_INSTR == 2
#define PI(x) asm volatile("v_fma_mix_f32 %0, %1, %0, %0 op_sel_hi:[1,0,0]" : "+v"(x) : "v"(hh))
#elif PROBE_INSTR == 3
#define PI(x) asm volatile("v_add_f32_dpp %0, %0, %0 quad_perm:[1,0,3,2] row_mask:0xf bank_mask:0xf bound_ctrl:1" : "+v"(x))
#elif PROBE_INSTR == 4
#define PI(x) asm volatile("v_pk_fma_f32 %0, %0, %1, %0" : "+v"(x##p) : "v"(kp))

#endif
#if PROBE_INSTR == 4
          static_assert(true, "");
#endif
          PI(x0); PI(x1); PI(x2); PI(x3); PI(x4); PI(x5); PI(x6); PI(x7);
      }
      x0 += x0p[0] + x1p[1] + x2p[0] + x3p[1] + x4p[0] + x5p[1] + x6p[0] + x7p[1];
      if (x0 + x1 + x2 + x3 + x4 + x5 + x6 + x7 == 123.456f) ((float*)(p.ws + WS_CTL))[20000] = x0; }
#endif
    xcd_barrier(bar);
    { pg8::Gemm g{(const pg8::bf16_t*)(p.ws + WS_XB), (const pg8::bf16_t*)(p.ws + WS_WINT), MPAD, NIN, 1024}; pg8::StaticOrder S; S.init(MPAD, NIN, G, bx);
      EpiZ E{(bf16*)(p.ws + WS_Z1), (bf16*)p.out};
      pg8::gemm_phase<EpiZ, pg8::StaticOrder, true, true>(lds, g, S, E); }
    xcd_barrier(bar);
#ifdef PROBE_WKVP
    for (int u = bx; u < 256; u += G) wkv_prompt(p, lds, u, p.never == 0);
#endif
    for (int u = bx; u < 256; u += G) wkv_prompt(p, lds, u, p.never != 0);
    wkv_sample(p, lds);
#ifdef PROBE_LRUP
    for (int u = bx; u < 256; u += G) lru_prompt(p, lds, u, p.never == 0);
#endif
    for (int u = bx; u < 256; u += G) lru_prompt(p, lds, u, p.never != 0);
    lru_sample(p, lds);
    xcd_barrier(bar);
    phase_merge(p, lds);
    xcd_barrier(bar);
    phase_convert_ffn(p, lds);
    __syncthreads();
    { pg8::Gemm g{(const pg8::bf16_t*)(p.ws + WS_XB), (const pg8::bf16_t*)(p.ws + WS_WOT), MP, 1024, 1024}; pg8::StaticOrder S; S.init(MP, 1024, G, bx);
      EpiRes E{p.in[I_XP], p.in[I_XS], (float*)(p.ws + WS_H1)};
      pg8::gemm_phase<EpiRes, pg8::StaticOrder, true, true>(lds, g, S, E); }
    __syncthreads();
    mini_gemm_tail(lds, (const bf16*)(p.ws + WS_XB), 1024, (const bf16*)(p.ws + WS_WOT), 1024, p.in[I_XS] - (size_t)MP * DM, (float*)(p.ws + WS_H1));
    xcd_barrier(bar);
    phase_ln<false>(p, p.in[I_LN1G], p.in[I_LN1B]);
    xcd_barrier(bar);
    { pg8::Gemm g{(const pg8::bf16_t*)(p.ws + WS_H1B), (const pg8::bf16_t*)(p.ws + WS_WGUT), MT, 2 * DFF, 1024}; pg8::StaticOrder S; S.init(MT, 2 * DFF, G, bx);
      EpiSwi E{(bf16*)(p.ws + WS_ACT)};
      pg8::gemm_phase<EpiSwi, pg8::StaticOrder, true, true>(lds, g, S, E); }
    xcd_barrier(bar);
    { pg8::Gemm g{(const pg8::bf16_t*)(p.ws + WS_ACT), (const pg8::bf16_t*)(p.ws + WS_WDT), MP, 1024, DFF}; pg8::StaticOrder S; S.init(MP, 1024, G, bx);
      const float* h1 = (const float*)(p.ws + WS_H1);
      EpiRes E{h1, h1 + (size_t)MP * DM, (float*)(p.ws + WS_H1)};
      pg8::gemm_phase<EpiRes, pg8::StaticOrder, true, true>(lds, g, S, E); }
    __syncthreads();
    mini_gemm_tail(lds, (const bf16*)(p.ws + WS_ACT), DFF, (const bf16*)(p.ws + WS_WDT), DFF, (const float*)(p.ws + WS_H1), (float*)(p.ws + WS_H1));
    xcd_barrier(bar);
    phase_ln<true>(p, p.in[I_LN2G], p.in[I_LN2B]);
#undef p
}

extern "C" void kernel_launch(void* const* d_in, const int* in_sizes, int n_in, void* d_out, int out_size, void* d_ws, size_t ws_size, hipStream_t stream) {
    static int grid = 0;
    if (grid == 0) {
        int dev = 0, cus = 0, per_cu = 0;
        if (n_in != 33 || ws_size < 256 * MiB) { fprintf(stderr, "kernel_launch: unexpected n_in %d / ws %zu\n", n_in, ws_size); grid = -1; return; }
        hipGetDevice(&dev); hipDeviceGetAttribute(&cus, hipDeviceAttributeMultiprocessorCount, dev);
        if (hipFuncSetAttribute((const void*)hybrid_step_kernel, hipFuncAttributeMaxDynamicSharedMemorySize, LDS_BYTES) != hipSuccess) { fprintf(stderr, "kernel_launch: hipFuncSetAttribute failed\n"); grid = -1; return; }
        if (hipOccupancyMaxActiveBlocksPerMultiprocessor(&per_cu, (const void*)hybrid_step_kernel, 512, LDS_BYTES) != hipSuccess || per_cu < 1) { fprintf(stderr, "kernel_launch: occupancy query says %d blocks per CU\n", per_cu); }
        (void)hipGetLastError();
        grid = cus;
    }
    if (grid < 0) return;
    (void)hipMemsetAsync((char*)d_ws + WS_CTL, 0, CTL_ZERO_BYTES, stream);
    Params p{};
    for (int i = 0; i < 33; ++i) p.in[i] = (const float*)d_in[i];
    p.out = (float*)d_out; p.ws = (unsigned char*)d_ws; p.never = 0; p.pad = 0;
    void* args[] = {&p};
    hipError_t e = hipLaunchCooperativeKernel((const void*)hybrid_step_kernel, dim3(grid), dim3(512), args, LDS_BYTES, stream);
    if (e != hipSuccess) fprintf(stderr, "kernel_launch: cooperative launch failed: %s (grid %d)\n", hipGetErrorString(e), grid);
}
```

```cpp
#include <hip/hip_runtime.h>
#include <hip/hip_cooperative_groups.h>
#include <cstdio>
#include <cstdint>
namespace pg8 {
#define PG8_LAS __attribute__((address_space(3)))
typedef unsigned short bf16_t;
typedef short bf16x8 __attribute__((ext_vector_type(8)));
typedef float f32x4 __attribute__((ext_vector_type(4)));
typedef unsigned u32x4 __attribute__((ext_vector_type(4)));
constexpr int BM = 256, BK = 64, HALF = 128, HTB = HALF * BK * 2  , STAGE_BYTES = 8 * HTB, NXCD = 8, WGM = 8;

__host__ __device__ __forceinline__ int lds_byte(int r, int c) { const int st = (r >> 4) * 2 + (c >> 5), rr = r & 15, cc = c & 31, ob = rr * 64 + cc * 2; return st * 1024 + (ob ^ (((ob >> 9) & 1) << 5)); }
__host__ __device__ __forceinline__ void stage_rc(int b, int& R, int& C) { const int st = b / 1024, sb = b % 1024, swz = sb ^ (((sb >> 9) & 1) << 5); R = (st >> 1) * 16 + swz / 64; C = (st & 1) * 32 + (swz % 64) / 2; }
__host__ __device__ __forceinline__ int perm32(int rho) { const int n = rho >> 4, i = rho & 15; return 8 * (i >> 2) + 4 * n + (i & 3); }

struct Unit { int pm, pn; };
struct Gemm { const bf16_t* A; const bf16_t* Bt; int M, N, K; };

struct StaticOrder {
    int nM, nN, nwg, G, c;
    __host__ __device__ void init(int M, int N, int G_, int c_) { nM = M / BM; nN = N / BM; nwg = nM * nN; G = G_; c = c_; }
    __host__ __device__ bool next(int i, Unit& u) const {
        const long L = (long)i * G + c; if (L >= nwg) return false;
        int wgid = (int)L; { const int q = nwg / NXCD, r = nwg % NXCD, xcd = wgid % NXCD, off = wgid / NXCD; wgid = (xcd < r ? xcd * (q + 1) : r * (q + 1) + (xcd - r) * q) + off; }
        const int nig = WGM * nN, gid = wgid / nig, fm = gid * WGM, gsz = (nM - fm) < WGM ? (nM - fm) : WGM;
        u.pm = fm + ((wgid % nig) % gsz); u.pn = (wgid % nig) / gsz; return true;
    }
    __device__ __forceinline__ void a_ready(const Unit&) const {}
    __device__ __forceinline__ void done(const Unit&) const {}
};

__device__ __forceinline__ unsigned cvt_pk_bf16(float lo, float hi) { unsigned r; asm volatile("v_cvt_pk_bf16_f32 %0, %1, %2" : "=v"(r) : "v"(lo), "v"(hi)); return r; }
typedef float f32x2 __attribute__((ext_vector_type(2)));
__device__ __forceinline__ f32x2 gelu_pk(f32x2 v) {
    const f32x2 av = __builtin_elementwise_abs(v), d = av * 0.2316418882f + 1.0f;
    f32x2 t; t.x = __builtin_amdgcn_rcpf(d.x); t.y = __builtin_amdgcn_rcpf(d.y);
    f32x2 q = t * 0.5307027145f + (-0.7265760135f); q = q * t + 0.7107068705f; q = q * t + (-0.142248368f); q = q * t + 0.127414796f; q = q * t;
    const f32x2 s = (v * v) * (-0.72134752044f);
    f32x2 e; e.x = __builtin_amdgcn_exp2f(s.x); e.y = __builtin_amdgcn_exp2f(s.y);
    const f32x2 m = v * (q * e), r = v - m;
    f32x2 o; o.x = v.x < 0.f ? m.x : r.x; o.y = v.y < 0.f ? m.y : r.y; return o;
}

template <int ACT  > struct EpiBf16 {
    static constexpr bool PERM = true, AFTER_DRAIN = false; static_assert(ACT == 0 || ACT == 1, "EpiBf16: ACT is 0 (none) or 1 (gelu_pk)");
    bf16_t* O; int ldc; const float* bias; int split_cols; size_t split_stride; float scale0;
    __device__ __forceinline__ void operator()(const f32x4 (&acc)[2][2][4][2], const Unit& u, int wr, int wc, int fr, int fq) const {
        const int row0 = u.pm * BM + wr * 64 + fr; int colt = u.pn * BM; bf16_t* base = O;
        float sc = 1.f; if (split_cols) { const int t = colt / split_cols; base += (size_t)t * split_stride; colt -= t * split_cols; if (t == 0) sc = scale0; }
        const int col0 = colt + wc * 32 + 8 * fq, bcol0 = u.pn * BM + wc * 32 + 8 * fq;
        f32x4 bv[2][2];
#pragma unroll
        for (int bj = 0; bj < 2; ++bj)
#pragma unroll
            for (int n = 0; n < 2; ++n) bv[bj][n] = bias ? *(const f32x4*)(bias + bcol0 + bj * HALF + 4 * n) : (f32x4){0.f, 0.f, 0.f, 0.f};
#pragma unroll
        for (int ai = 0; ai < 2; ++ai)
#pragma unroll
            for (int m = 0; m < 4; ++m) { bf16_t* rowp = base + (size_t)(row0 + ai * HALF + m * 16) * ldc + col0;
#pragma unroll
                for (int bj = 0; bj < 2; ++bj) { f32x4 v0 = acc[ai][bj][m][0] + bv[bj][0], v1 = acc[ai][bj][m][1] + bv[bj][1];
                    if (ACT == 1) { f32x2 a = gelu_pk((f32x2){v0[0], v0[1]}), b = gelu_pk((f32x2){v0[2], v0[3]}), c = gelu_pk((f32x2){v1[0], v1[1]}), d = gelu_pk((f32x2){v1[2], v1[3]});
                        v0 = (f32x4){a.x, a.y, b.x, b.y}; v1 = (f32x4){c.x, c.y, d.x, d.y}; }
                    v0 = v0 * sc; v1 = v1 * sc; u32x4 w; w.x = cvt_pk_bf16(v0[0], v0[1]); w.y = cvt_pk_bf16(v0[2], v0[3]); w.z = cvt_pk_bf16(v1[0], v1[1]); w.w = cvt_pk_bf16(v1[2], v1[3]);
                    *(u32x4*)(rowp + bj * HALF) = w; } }
    }
};
template <class Epi, class Sched, bool ALIGN_EPI = false, bool SP2 = false>
__device__ __forceinline__ void gemm_phase(PG8_LAS unsigned char* lds, const Gemm g, const Sched& S, const Epi& E) {
    const int tid = threadIdx.x, wid = __builtin_amdgcn_readfirstlane(tid >> 6), lane = tid & 63, wr = wid >> 2, wc = wid & 3, fr = lane & 15, fq = lane >> 4;
    const int K = g.K, nt = K / BK;
    unsigned voffA[2], voffB[2];
#pragma unroll
    for (int i = 0; i < 2; ++i) { int R, C; stage_rc(tid * 16 + i * 8192, R, C); const int Rb = Epi::PERM ? ((R & ~31) + perm32(R & 31)) : R;
        voffA[i] = (unsigned)(R * K + C) * 2u; voffB[i] = (unsigned)(Rb * K + C) * 2u; }
    const size_t kstep = (size_t)(BK * 2);
    const size_t hstep = (size_t)HALF * K * 2;
    const size_t tstep = 2 * hstep;
    const unsigned ldsw = (unsigned)wid * 1024u;
    const int aoff = lds_byte(wr * 64 + fr, fq * 8), boff = lds_byte(wc * 32 + fr, fq * 8);
#define PG8_SA(b, h) (((b) * 2 + (h)) * HTB)
#define PG8_SB(b, h) ((4 + (b) * 2 + (h)) * HTB)
#define PG8_STAGE(bufoff, gbase, voff) do { _Pragma("unroll") for (int _i = 0; _i < 2; ++_i) \
        __builtin_amdgcn_global_load_lds((const unsigned*)((const char*)(gbase) + (voff)[_i]), (PG8_LAS unsigned*)(lds + (bufoff) + ldsw + _i * 8192), 16, 0, 0); } while (0)
#define PG8_LDA(dst, b, h) do { _Pragma("unroll") for (int m = 0; m < 4; ++m) _Pragma("unroll") for (int k = 0; k < 2; ++k) dst[m][k] = *(const PG8_LAS bf16x8*)(lds + PG8_SA(b, h) + aoff + m * 2048 + k * 1024); } while (0)
#define PG8_LDB(dst, b, h) do { _Pragma("unroll") for (int n = 0; n < 2; ++n) _Pragma("unroll") for (int k = 0; k < 2; ++k) dst[n][k] = *(const PG8_LAS bf16x8*)(lds + PG8_SB(b, h) + boff + n * 2048 + k * 1024); } while (0)
#define PG8_MMA(ai, bj, At, Bt) do { __builtin_amdgcn_s_setprio(1); _Pragma("unroll") for (int m = 0; m < 4; ++m) _Pragma("unroll") for (int n = 0; n < 2; ++n) _Pragma("unroll") for (int k = 0; k < 2; ++k) \
        acc[ai][bj][m][n] = __builtin_amdgcn_mfma_f32_16x16x32_bf16(Bt[n][k], At[m][k], acc[ai][bj][m][n], 0, 0, 0); __builtin_amdgcn_s_setprio(0); } while (0)
#define PG8_WAIT_V(n) asm volatile("s_waitcnt vmcnt(" #n ")" ::: "memory")
#define PG8_WAIT_L(n) asm volatile("s_waitcnt lgkmcnt(" #n ")" ::: "memory")
#define PG8_BAR __builtin_amdgcn_s_barrier()
#define PG8_SCHED __builtin_amdgcn_sched_barrier(0)
    Unit cur, nxt; int ui = 0;
    if (!S.next(0, cur)) return;
    f32x4 acc[2][2][4][2];
#pragma unroll
    for (int a = 0; a < 2; ++a)
#pragma unroll
        for (int b = 0; b < 2; ++b)
#pragma unroll
            for (int m = 0; m < 4; ++m)
#pragma unroll
                for (int n = 0; n < 2; ++n) acc[a][b][m][n] = (f32x4){0.f, 0.f, 0.f, 0.f};
    bf16x8 At[4][2], B0[2][2], B1[2][2];
    const char* cA = (const char*)g.A + (size_t)cur.pm * tstep; const char* cB = (const char*)g.Bt + (size_t)cur.pn * tstep;
    S.a_ready(cur);
    if constexpr (SP2) {
        PG8_STAGE(PG8_SB(0, 0), cB, voffB); PG8_STAGE(PG8_SB(0, 1), cB + hstep, voffB); PG8_STAGE(PG8_SA(0, 0), cA, voffA); PG8_STAGE(PG8_SA(0, 1), cA + hstep, voffA);
        if (wr == 1) PG8_BAR;
        PG8_WAIT_V(2); PG8_BAR;
        PG8_STAGE(PG8_SB(1, 0), cB + kstep, voffB); PG8_STAGE(PG8_SA(1, 0), cA + kstep, voffA); PG8_STAGE(PG8_SB(1, 1), cB + hstep + kstep, voffB);
        PG8_WAIT_V(6); PG8_BAR;
    } else {
        PG8_STAGE(PG8_SB(0, 0), cB, voffB); PG8_STAGE(PG8_SA(0, 0), cA, voffA); PG8_STAGE(PG8_SB(0, 1), cB + hstep, voffB); PG8_STAGE(PG8_SA(0, 1), cA + hstep, voffA);
        if (wr == 1) PG8_BAR;
        PG8_WAIT_V(4); PG8_BAR;
        PG8_STAGE(PG8_SB(1, 0), cB + kstep, voffB); PG8_STAGE(PG8_SA(1, 0), cA + kstep, voffA); PG8_STAGE(PG8_SB(1, 1), cB + hstep + kstep, voffB);
        PG8_WAIT_V(6); PG8_BAR;
    }
    for (;;) {
        const bool has_next = S.next(ui + 1, nxt);
        const char* nA = has_next ? (const char*)g.A + (size_t)nxt.pm * tstep : cA; const char* nB = has_next ? (const char*)g.Bt + (size_t)nxt.pn * tstep : cB;
        for (int t = 0; t < nt; t += 2) {
            const bool last = (t == nt - 2);
            const char* a1 = cA + (size_t)(t + 1) * kstep;
            const char* a2 = last ? nA : cA + (size_t)(t + 2) * kstep; const char* b2 = last ? nB : cB + (size_t)(t + 2) * kstep;
            const char* a3 = a2 + kstep; const char* b3 = b2 + kstep;
            if (last && has_next) S.a_ready(nxt);
            if constexpr (SP2) {
            PG8_LDB(B0, 0, 0); PG8_LDB(B1, 0, 1); PG8_SCHED; PG8_LDA(At, 0, 0); PG8_STAGE(PG8_SA(1, 1), a1 + hstep, voffA);
            PG8_WAIT_V(8); PG8_WAIT_L(0); PG8_BAR; PG8_MMA(0, 0, At, B0); PG8_MMA(0, 1, At, B1); PG8_BAR; PG8_SCHED;
            PG8_LDA(At, 0, 1); PG8_STAGE(PG8_SB(0, 0), b2, voffB); PG8_STAGE(PG8_SB(0, 1), b2 + hstep, voffB); PG8_STAGE(PG8_SA(0, 0), a2, voffA);
            PG8_WAIT_V(8); PG8_WAIT_L(0); PG8_BAR; PG8_MMA(1, 0, At, B0); PG8_MMA(1, 1, At, B1); PG8_BAR; PG8_SCHED;
            PG8_LDB(B0, 1, 0); PG8_LDB(B1, 1, 1); PG8_SCHED; PG8_LDA(At, 1, 0); PG8_STAGE(PG8_SA(0, 1), a2 + hstep, voffA);
            PG8_WAIT_V(8); PG8_WAIT_L(0); PG8_BAR; PG8_MMA(0, 0, At, B0); PG8_MMA(0, 1, At, B1); PG8_BAR; PG8_SCHED;
            PG8_LDA(At, 1, 1); PG8_STAGE(PG8_SB(1, 0), b3, voffB); PG8_STAGE(PG8_SB(1, 1), b3 + hstep, voffB); PG8_STAGE(PG8_SA(1, 0), a3, voffA);
            PG8_WAIT_V(8); PG8_WAIT_L(0); PG8_BAR; PG8_MMA(1, 0, At, B0); PG8_MMA(1, 1, At, B1); PG8_BAR; PG8_SCHED;
            } else {
            PG8_LDB(B0, 0, 0); PG8_SCHED; PG8_LDA(At, 0, 0); PG8_STAGE(PG8_SA(1, 1), a1 + hstep, voffA);
            PG8_WAIT_L(8); PG8_BAR; PG8_WAIT_L(0); PG8_MMA(0, 0, At, B0); PG8_BAR; PG8_SCHED;
            PG8_LDB(B1, 0, 1); PG8_STAGE(PG8_SB(0, 0), b2, voffB);
            PG8_BAR; PG8_WAIT_L(0); PG8_MMA(0, 1, At, B1); PG8_BAR;
            PG8_LDA(At, 0, 1); PG8_STAGE(PG8_SA(0, 0), a2, voffA);
            PG8_BAR; PG8_WAIT_L(0); PG8_MMA(1, 0, At, B0); PG8_BAR; PG8_SCHED;
            PG8_STAGE(PG8_SB(0, 1), b2 + hstep, voffB);
            PG8_WAIT_V(6); PG8_BAR; PG8_MMA(1, 1, At, B1); PG8_BAR;
            PG8_LDB(B0, 1, 0); PG8_SCHED; PG8_LDA(At, 1, 0); PG8_STAGE(PG8_SA(0, 1), a2 + hstep, voffA);
            PG8_WAIT_L(8); PG8_BAR; PG8_WAIT_L(0); PG8_MMA(0, 0, At, B0); PG8_BAR; PG8_SCHED;
            PG8_LDB(B1, 1, 1); PG8_STAGE(PG8_SB(1, 0), b3, voffB);
            PG8_BAR; PG8_WAIT_L(0); PG8_MMA(0, 1, At, B1); PG8_BAR;
            PG8_LDA(At, 1, 1); PG8_STAGE(PG8_SA(1, 0), a3, voffA);
            PG8_BAR; PG8_WAIT_L(0); PG8_MMA(1, 0, At, B0); PG8_BAR; PG8_SCHED;
            PG8_STAGE(PG8_SB(1, 1), b3 + hstep, voffB);
            PG8_WAIT_V(6); PG8_BAR; PG8_MMA(1, 1, At, B1); PG8_BAR;
            }
        }
        if constexpr (ALIGN_EPI) { if (wr == 0) PG8_BAR; }
        if constexpr (!Epi::AFTER_DRAIN) { E(acc, cur, wr, wc, fr, fq); S.done(cur); }
        if (!has_next) break;
#pragma unroll
        for (int a = 0; a < 2; ++a)
#pragma unroll
            for (int b = 0; b < 2; ++b)
#pragma unroll
                for (int m = 0; m < 4; ++m)
#pragma unroll
                    for (int n = 0; n < 2; ++n) acc[a][b][m][n] = (f32x4){0.f, 0.f, 0.f, 0.f};
        cur = nxt; cA = nA; cB = nB; ++ui;
        if constexpr (ALIGN_EPI) { if (wr == 1) PG8_BAR; }
    }
    PG8_WAIT_V(0);
    if constexpr (!ALIGN_EPI) { if (wr == 0) PG8_BAR; }
    PG8_BAR;
    if constexpr (Epi::AFTER_DRAIN) { E.fused(acc, cur, wr, wc, fr, fq, lds, wid, lane); S.done(cur); }
#undef PG8_SA
#undef PG8_SB
#undef PG8_STAGE
#undef PG8_LDA
#undef PG8_LDB
#undef PG8_MMA
#undef PG8_WAIT_V
#undef PG8_WAIT_L
#undef PG8_BAR
#undef PG8_SCHED
}
}
#define GAS __attribute__((address_space(1)))
#define LAS __attribute__((address_space(3)))
#define XB_TMO      128
#define XB_XCNT(j)  (256  + 64 * (j))
#define XB_XSUB(j)  (1280 + 64 * (j))
#define XB_XGEN(j)  (2304 + 64 * (j))
#define XB_TOP      3328
#define XB_TOPGEN   3392
#define XCD_BAR_WORDS 3456
#define XB_SPIN_CAP (1u << 18)

__device__ __forceinline__ unsigned xb_ld(unsigned* p)              { return __hip_atomic_load(p, __ATOMIC_RELAXED, __HIP_MEMORY_SCOPE_AGENT); }
__device__ __forceinline__ unsigned xb_add(unsigned* p, unsigned v) { return __hip_atomic_fetch_add(p, v, __ATOMIC_RELAXED, __HIP_MEMORY_SCOPE_AGENT); }
__device__ __forceinline__ unsigned xb_xcc_id() { return (unsigned)__builtin_amdgcn_s_getreg((3 << 11) | 20) & 0xFu; }
#define XB_SPIN(cond, bar) do { unsigned _sp = 0; while (cond) { __builtin_amdgcn_s_sleep(1); \
    if ((++_sp & 255u) == 0u) { if (xb_ld(&(bar)[XB_TMO])) break; if (_sp > XB_SPIN_CAP) { atomicAdd(&(bar)[XB_TMO], 1u); break; } } } } while (0)

struct XcdBarrier {
    unsigned* bar; unsigned x;
    volatile LAS unsigned* st;
};

__device__ __forceinline__ XcdBarrier xcd_barrier_post(unsigned* bar, volatile LAS unsigned* st) {
    XcdBarrier b; b.bar = bar; b.x = xb_xcc_id(); b.st = st;
    if (threadIdx.x == 0) (void)xb_add(&bar[XB_XCNT(b.x)], 1u);
    return b;
}
__device__ __forceinline__ void xcd_barrier_complete(unsigned* bar, unsigned x, unsigned& nloc, unsigned& nx) {
    const unsigned G = gridDim.x * gridDim.y * gridDim.z;
    unsigned sum, cnt, mine, sp = 0u;
    for (;;) {
        sum = 0u; cnt = 0u; mine = 0u;
#pragma unroll
        for (unsigned j = 0; j < 16; ++j) { const unsigned c = xb_ld(&bar[XB_XCNT(j)]); sum += c; cnt += (c > 0u) ? 1u : 0u; mine = (j == x) ? c : mine; }
        if (sum == G) break;
        __builtin_amdgcn_s_sleep(1);
        if ((++sp & 255u) == 0u) { if (xb_ld(&bar[XB_TMO])) break; if (sp > XB_SPIN_CAP) { atomicAdd(&bar[XB_TMO], 1u); break; } }
    }
    nloc = mine > 0u ? mine : 1u; nx = cnt > 0u ? cnt : 1u;
}

__device__ __forceinline__ void xcd_barrier(const XcdBarrier& b) {
    asm volatile("s_waitcnt vmcnt(0)" ::: "memory");
    __syncthreads();
    if (threadIdx.x == 0) {
        unsigned* bar = b.bar;
        __builtin_amdgcn_s_waitcnt(0);
        unsigned nloc = b.st[0], nx = b.st[1];
        if (nloc == 0u) { xcd_barrier_complete(bar, b.x, nloc, nx); b.st[0] = nloc; b.st[1] = nx; }
        const unsigned old = xb_add(&bar[XB_XSUB(b.x)], 1u);
        const unsigned gen = old / nloc;
        if (old + 1u == (gen + 1u) * nloc) {
            __builtin_amdgcn_fence(__ATOMIC_RELEASE, "agent");
            asm volatile("s_waitcnt vmcnt(0)" ::: "memory");
            const unsigned og = xb_add(&bar[XB_TOP], 1u);
            const unsigned tg = og / nx;
            if (og + 1u == (tg + 1u) * nx) xb_add(&bar[XB_TOPGEN], 1u);
            else XB_SPIN(xb_ld(&bar[XB_TOPGEN]) == tg, bar);
            __builtin_amdgcn_fence(__ATOMIC_ACQUIRE, "agent");
            xb_add(&bar[XB_XGEN(b.x)], 1u);
            asm volatile("s_waitcnt vmcnt(0)" ::: "memory");
        } else {
            XB_SPIN(xb_ld(&bar[XB_XGEN(b.x)]) == gen, bar);
            __builtin_amdgcn_fence(__ATOMIC_ACQUIRE, "agent");
            asm volatile("s_waitcnt vmcnt(0)" ::: "memory");
        }
    }
    __syncthreads();
}

namespace cg = cooperative_groups;
typedef unsigned short bf16;
typedef unsigned v4u __attribute__((ext_vector_type(4)));
typedef unsigned v2u __attribute__((ext_vector_type(2)));
typedef float f32x4 __attribute__((ext_vector_type(4)));
typedef float f32x2 __attribute__((ext_vector_type(2)));
typedef short bf16x8 __attribute__((ext_vector_type(8)));
#define LDS_WAIT() asm volatile("s_waitcnt lgkmcnt(0)" ::: "memory")

constexpr int DM = 1024, NB = 8, SEQ = 2048, DECB = 128, DECS = 4;
constexpr int MP = NB * SEQ, MS = DECB * DECS, MT = MP + MS, MPAD = 17152;
constexpr int NZ1 = 5376, NIN = 7424, DFF = 2816;
constexpr int ZR = 0, ZK = 1024, ZV = 2048, ZWL = 3072, ZAL = 3136, ZGL = 3200, ZXB = 3328, ZGB = 4352;
constexpr float ALPHA = 1.189207115002721f;
constexpr float LN_EPS = 1e-5f, GN_EPS = 64e-5f;

constexpr size_t MiB = 1u << 20;
constexpr size_t WS_CTL = 0, CTL_ZERO_BYTES = 65536;
constexpr int CW_BAR = 1024;
constexpr size_t WS_WOT = 1 * MiB;
constexpr size_t WS_SMALL = 3 * MiB;
constexpr size_t WS_XB = 4 * MiB;
constexpr size_t WS_Z1 = 38 * MiB;
constexpr size_t WS_WINT = 214 * MiB;
constexpr size_t WS_BONUS = 214 * MiB;
constexpr size_t WS_H1 = 38 * MiB;
constexpr size_t WS_H1B = 104 * MiB;
constexpr size_t WS_WGUT = 137 * MiB;
constexpr size_t WS_WDT = 148 * MiB;
constexpr size_t WS_ACT = 154 * MiB;
constexpr size_t O_Y = 0, O_SHP = 17301504, O_WKVP = 17309696, O_CONVP = 17833984, O_LRUP = 17858560,
                 O_SHS = 17866752, O_WKVS = 17997824, O_CONVS = 26386432, O_LRUS = 26779648;

constexpr int LDS_BYTES = 163840, MISC_OFF = LDS_BYTES - 64;

struct Params { const float* in[33]; float* out; unsigned char* ws; int never; int pad; };
typedef const __attribute__((address_space(4))) Params CP;
__device__ __forceinline__ CP* launder(CP* q) { asm volatile("" : "+s"(q)); return q; }
enum { I_XP = 0, I_XS, I_SHIFT, I_WKV, I_CONV, I_LRU, I_WIN, I_MU, I_W0, I_W2, I_A0, I_A2, I_G2, I_KK, I_KA, I_RK, I_LNXG, I_LNXB,
       I_CW, I_CB, I_WA, I_BA, I_WI, I_BI, I_LAM, I_WO, I_LN1G, I_LN1B, I_WG, I_WU, I_WD, I_LN2G, I_LN2B };

__device__ __forceinline__ float bf2f(unsigned b) { return __uint_as_float(b << 16); }
__device__ __forceinline__ unsigned f2bf(float f) { unsigned u = __float_as_uint(f); return (u + 0x7fffu + ((u >> 16) & 1u)) >> 16; }
__device__ __forceinline__ unsigned pk2(float lo, float hi) { return f2bf(lo) | (f2bf(hi) << 16); }
__device__ __forceinline__ float lo16(unsigned u) { return __uint_as_float(u << 16); }
__device__ __forceinline__ float hi16(unsigned u) { return __uint_as_float(u & 0xffff0000u); }
__device__ __forceinline__ float sigm(float x) { return __builtin_amdgcn_rcpf(1.f + __expf(-x)); }
__device__ __forceinline__ float tanh_(float x) { return 1.f - 2.f * __builtin_amdgcn_rcpf(__expf(2.f * x) + 1.f); }
__device__ __forceinline__ float gelu_tanh(float x) { return 0.5f * x * (1.f + tanh_(0.7978845608028654f * (x + 0.044715f * x * x * x))); }
template <int CTRL> __device__ __forceinline__ float dpp_add(float v) {
    return v + __int_as_float(__builtin_amdgcn_update_dpp(0, __float_as_int(v), CTRL, 0xF, 0xF, true)); }
__device__ __forceinline__ float allred8(float v) { v = dpp_add<0xB1>(v); v = dpp_add<0x4E>(v); v = dpp_add<0x141>(v); return v; }
__device__ __forceinline__ float allred16(float v) { v = allred8(v); v = dpp_add<0x140>(v); return v; }
__device__ __forceinline__ float wave_sum(float v) {
#pragma unroll
    for (int o = 1; o < 64; o <<= 1) v += __shfl_xor(v, o);
    return v; }
#define UNPACK8(q, f) do { f[0] = lo16(q.x); f[1] = hi16(q.x); f[2] = lo16(q.y); f[3] = hi16(q.y); f[4] = lo16(q.z); f[5] = hi16(q.z); f[6] = lo16(q.w); f[7] = hi16(q.w); } while (0)

__device__ __forceinline__ void transpose_item(const float* W, int N, bf16* WT, int ldT, int k0, int n0, int drow0, LAS float* scr, int lane) {
#pragma unroll 8
    for (int i = 0; i < 32; ++i) { const int kk = 2 * i + (lane >> 5); scr[kk * 33 + (lane & 31)] = W[(size_t)(k0 + kk) * N + n0 + (lane & 31)]; }
    LDS_WAIT();
    const int c = lane & 7;
#pragma unroll
    for (int j = 0; j < 4; ++j) { const int n = (lane >> 3) + 8 * j; const LAS float* s = scr + (8 * c) * 33 + n;
        v4u o; o.x = pk2(s[0 * 33], s[1 * 33]); o.y = pk2(s[2 * 33], s[3 * 33]); o.z = pk2(s[4 * 33], s[5 * 33]); o.w = pk2(s[6 * 33], s[7 * 33]);
        *(v4u*)(WT + (size_t)(drow0 + n) * ldT + k0 + 8 * c) = o; }
    LDS_WAIT();
}

__device__ __forceinline__ void phase0(CP& p, LAS unsigned char* lds) {
    int tid_l = threadIdx.x; asm volatile("" : "+v"(tid_l)); const int tid = tid_l, wave = tid >> 6, lane = tid & 63;
    const int gw = blockIdx.x * 8 + wave, NGW = gridDim.x * 8;
    bf16* Xb = (bf16*)(p.ws + WS_XB);
    for (int m = gw; m < MPAD; m += NGW) {
        const float* src = m < MP ? p.in[I_XP] + (size_t)m * DM : (m < MT ? p.in[I_XS] + (size_t)(m - MP) * DM : (m < MT + DECB ? p.in[I_SHIFT] + (size_t)(m - MT) * DM : nullptr));
        f32x4 v[4];
#pragma unroll
        for (int j = 0; j < 4; ++j) v[j] = src ? *(const f32x4*)(src + 4 * lane + 256 * j) : (f32x4){0.f, 0.f, 0.f, 0.f};
        unsigned long long* o8 = (unsigned long long*)(Xb + (size_t)m * DM) + lane;
#pragma unroll
        for (int j = 0; j < 4; ++j) o8[64 * j] = (unsigned long long)pk2(v[j].x, v[j].y) | ((unsigned long long)pk2(v[j].z, v[j].w) << 32);
        float* so = nullptr;
        if (m < MP) { if ((m & (SEQ - 1)) == SEQ - 1) so = p.out + O_SHP + (size_t)(m >> 11) * DM; }
        else if (m < MT) { if (((m - MP) & 3) == 3) so = p.out + O_SHS + (size_t)((m - MP) >> 2) * DM; }
        if (so) {
#pragma unroll
            for (int j = 0; j < 4; ++j) *(f32x4*)(so + 4 * lane + 256 * j) = v[j]; }
    }
    LAS float* scr = (LAS float*)(lds + wave * 16384);
    bf16* WinT = (bf16*)(p.ws + WS_WINT); bf16* WoT = (bf16*)(p.ws + WS_WOT);
    bf16* w2T = (bf16*)(p.ws + WS_SMALL); bf16* a2T = w2T + 65536; bf16* g2T = w2T + 131072; bf16* waT = w2T + 262144; bf16* wiT = w2T + 327680;
    constexpr int N_WIN = 16 * 232, N_WO = 16 * 32, N_L = 32, N_G = 64, N_B = 32;
    constexpr int NITEMS = N_WIN + N_WO + 2 * N_L + N_G + 2 * N_B;
    for (int it = gw; it < NITEMS; it += NGW) {
        int r = it;
        if (r < N_WIN) { transpose_item(p.in[I_WIN], NIN, WinT, 1024, 64 * (r / 232), 32 * (r % 232), 32 * (r % 232), scr, lane); continue; } r -= N_WIN;
        if (r < N_WO) { transpose_item(p.in[I_WO], 1024, WoT, 1024, 64 * (r / 32), 32 * (r % 32), 32 * (r % 32), scr, lane); continue; } r -= N_WO;
        if (r < N_L) { transpose_item(p.in[I_W2], 1024, w2T, 64, 0, 32 * r, 32 * r, scr, lane); continue; } r -= N_L;
        if (r < N_L) { transpose_item(p.in[I_A2], 1024, a2T, 64, 0, 32 * r, 32 * r, scr, lane); continue; } r -= N_L;
        if (r < N_G) { transpose_item(p.in[I_G2], 1024, g2T, 128, 64 * (r / 32), 32 * (r % 32), 32 * (r % 32), scr, lane); continue; } r -= N_G;
        if (r < N_B) { transpose_item(p.in[I_WA] + (r >> 1) * 4096, 64, waT + (r >> 1) * 4096, 64, 0, 32 * (r & 1), 32 * (r & 1), scr, lane); continue; } r -= N_B;
        transpose_item(p.in[I_WI] + (r >> 1) * 4096, 64, wiT + (r >> 1) * 4096, 64, 0, 32 * (r & 1), 32 * (r & 1), scr, lane);
    }
}
__device__ __forceinline__ void phase_convert_ffn(CP& p, LAS unsigned char* lds) {
    int tid_l = threadIdx.x; asm volatile("" : "+v"(tid_l)); const int tid = tid_l, wave = tid >> 6, lane = tid & 63;
    const int gw = blockIdx.x * 8 + wave, NGW = gridDim.x * 8;
    LAS float* scr = (LAS float*)(lds + wave * 16384);
    bf16* WguT = (bf16*)(p.ws + WS_WGUT); bf16* WdT = (bf16*)(p.ws + WS_WDT);
    constexpr int N_G = 16 * 88, N_D = 44 * 32;
    for (int it = gw; it < 2 * N_G + N_D; it += NGW) {
        int r = it;
        if (r < N_G) { const int n0 = 32 * (r % 88); transpose_item(p.in[I_WG], DFF, WguT, 1024, 64 * (r / 88), n0, 256 * (n0 >> 7) + (n0 & 127), scr, lane); continue; } r -= N_G;
        if (r < N_G) { const int n0 = 32 * (r % 88); transpose_item(p.in[I_WU], DFF, WguT, 1024, 64 * (r / 88), n0, 256 * (n0 >> 7) + 128 + (n0 & 127), scr, lane); continue; } r -= N_G;
        transpose_item(p.in[I_WD], 1024, WdT, DFF, 64 * (r / 32), 32 * (r % 32), 32 * (r % 32), scr, lane);
    }
}

struct EpiZ {
    static constexpr bool PERM = true, AFTER_DRAIN = false;
    bf16* Z1; bf16* Zg;
    __device__ __forceinline__ void operator()(const pg8::f32x4 (&acc)[2][2][4][2], const pg8::Unit& u, int wr, int wc, int fr, int fq) const {
        bf16* base; int ldc, colt;
        if (u.pn < 21) { base = Z1; ldc = NZ1; colt = u.pn * 256; } else { if (u.pm >= 66) return; base = Zg; ldc = 2048; colt = (u.pn - 21) * 256; }
        const int row0 = u.pm * 256 + wr * 64 + fr, col0 = colt + wc * 32 + 8 * fq;
#pragma unroll
        for (int ai = 0; ai < 2; ++ai)
#pragma unroll
            for (int m = 0; m < 4; ++m) { bf16* rowp = base + (size_t)(row0 + ai * 128 + m * 16) * ldc + col0;
#pragma unroll
                for (int bj = 0; bj < 2; ++bj) { const pg8::f32x4 v0 = acc[ai][bj][m][0], v1 = acc[ai][bj][m][1];
                    v4u w; w.x = pg8::cvt_pk_bf16(v0[0], v0[1]); w.y = pg8::cvt_pk_bf16(v0[2], v0[3]); w.z = pg8::cvt_pk_bf16(v1[0], v1[1]); w.w = pg8::cvt_pk_bf16(v1[2], v1[3]);
                    *(v4u*)(rowp + bj * 128) = w; } }
    }
};
struct EpiRes {
    static constexpr bool PERM = false, AFTER_DRAIN = false;
    const float* resA; const float* resB; float* out;
    __device__ __forceinline__ void operator()(const pg8::f32x4 (&acc)[2][2][4][2], const pg8::Unit& u, int wr, int wc, int fr, int fq) const {
        const int row0 = u.pm * 256 + wr * 64 + fr, col0 = u.pn * 256 + wc * 32 + 4 * fq;
#pragma unroll
        for (int ai = 0; ai < 2; ++ai)
#pragma unroll
            for (int m = 0; m < 4; ++m) { const int row = row0 + ai * 128 + m * 16;
                const float* rp = (row < MP ? resA + (size_t)row * DM : resB + (size_t)(row - MP) * DM) + col0; float* op = out + (size_t)row * DM + col0;
#pragma unroll
                for (int bj = 0; bj < 2; ++bj)
#pragma unroll
                    for (int n = 0; n < 2; ++n) { const pg8::f32x4 x = *(const pg8::f32x4*)(rp + bj * 128 + n * 16); *(pg8::f32x4*)(op + bj * 128 + n * 16) = acc[ai][bj][m][n] + x * ALPHA; } }
    }
};
struct EpiSwi {
    static constexpr bool PERM = true, AFTER_DRAIN = false;
    bf16* O;
    __device__ __forceinline__ void operator()(const pg8::f32x4 (&acc)[2][2][4][2], const pg8::Unit& u, int wr, int wc, int fr, int fq) const {
        const int row0 = u.pm * 256 + wr * 64 + fr, col0 = u.pn * 128 + wc * 32 + 8 * fq;
#pragma unroll
        for (int ai = 0; ai < 2; ++ai)
#pragma unroll
            for (int m = 0; m < 4; ++m) { bf16* rowp = O + (size_t)(row0 + ai * 128 + m * 16) * DFF + col0;
                float o[8];
#pragma unroll
                for (int n = 0; n < 2; ++n)
#pragma unroll
                    for (int j = 0; j < 4; ++j) { const float g = acc[ai][0][m][n][j], uu = acc[ai][1][m][n][j]; o[4 * n + j] = g * sigm(g) * uu; }
                v4u w; w.x = pg8::cvt_pk_bf16(o[0], o[1]); w.y = pg8::cvt_pk_bf16(o[2], o[3]); w.z = pg8::cvt_pk_bf16(o[4], o[5]); w.w = pg8::cvt_pk_bf16(o[6], o[7]);
                *(v4u*)rowp = w; }
    }
};

typedef _Float16 h8 __attribute__((ext_vector_type(8)));
typedef _Float16 h4 __attribute__((ext_vector_type(4)));
constexpr int L_NKK = 0, L_WR = 17408, L_W = 34816, L_B = 52224, L_KP = 69632, L_VL = 87040, L_SC = 95232, L_RAW = 95744, L_YB = L_RAW  , L_RAWL = 120704,
              L_CST = 138384, L_MUL = 140432, L_WB = 140944, L_PW = L_W, L_PA = L_B;
constexpr int OPS = 68, RLS = 136, WBS = 72;

__device__ __forceinline__ float mixmul_lo(unsigned h, float x) { float d; asm("v_fma_mix_f32 %0, %1, %2, 0 op_sel_hi:[1,0,0]" : "=v"(d) : "v"(h), "v"(x)); return d; }
__device__ __forceinline__ float mix_lo(unsigned h, float x, float acc) { float d; asm("v_fma_mix_f32 %0, %1, %2, %3 op_sel_hi:[1,0,0]" : "=v"(d) : "v"(h), "v"(x), "v"(acc)); return d; }
__device__ __forceinline__ float mix_hi(unsigned h, float x, float acc) { float d; asm("v_fma_mix_f32 %0, %1, %2, %3 op_sel:[1,0,0] op_sel_hi:[1,0,0]" : "=v"(d) : "v"(h), "v"(x), "v"(acc)); return d; }
__device__ __forceinline__ float nmix_lo(unsigned h, float x, float acc) { float d; asm("v_fma_mix_f32 %0, -%1, %2, %3 op_sel_hi:[1,0,0]" : "=v"(d) : "v"(h), "v"(x), "v"(acc)); return d; }
__device__ __forceinline__ float nmix_hi(unsigned h, float x, float acc) { float d; asm("v_fma_mix_f32 %0, -%1, %2, %3 op_sel:[1,0,0] op_sel_hi:[1,0,0]" : "=v"(d) : "v"(h), "v"(x), "v"(acc)); return d; }
__device__ __forceinline__ void allred16x2(float& a, float& b) {
    asm("s_nop 0\n\t"
        "v_add_f32_dpp %0, %0, %0 quad_perm:[1,0,3,2] row_mask:0xf bank_mask:0xf bound_ctrl:1\n\t"
        "v_add_f32_dpp %1, %1, %1 quad_perm:[1,0,3,2] row_mask:0xf bank_mask:0xf bound_ctrl:1\n\t"
        "s_nop 0\n\t"
        "v_add_f32_dpp %0, %0, %0 quad_perm:[2,3,0,1] row_mask:0xf bank_mask:0xf bound_ctrl:1\n\t"
        "v_add_f32_dpp %1, %1, %1 quad_perm:[2,3,0,1] row_mask:0xf bank_mask:0xf bound_ctrl:1\n\t"
        "s_nop 0\n\t"
        "v_add_f32_dpp %0, %0, %0 row_half_mirror row_mask:0xf bank_mask:0xf bound_ctrl:1\n\t"
        "v_add_f32_dpp %1, %1, %1 row_half_mirror row_mask:0xf bank_mask:0xf bound_ctrl:1\n\t"
        "s_nop 0\n\t"
        "v_add_f32_dpp %0, %0, %0 row_mirror row_mask:0xf bank_mask:0xf bound_ctrl:1\n\t"
        "v_add_f32_dpp %1, %1, %1 row_mirror row_mask:0xf bank_mask:0xf bound_ctrl:1"
        : "+v"(a), "+v"(b));
}

__device__ __forceinline__ f32x2 pk_mul(f32x2 a, f32x2 b) { f32x2 d; asm("v_pk_mul_f32 %0, %1, %2" : "=v"(d) : "v"(a), "v"(b)); return d; }
__device__ __forceinline__ f32x2 pk_fma(f32x2 a, f32x2 b, f32x2 c) { f32x2 d; asm("v_pk_fma_f32 %0, %1, %2, %3" : "=v"(d) : "v"(a), "v"(b), "v"(c)); return d; }
__device__ __forceinline__ f32x2 pk_fma_b(f32x2 a, f32x2 blo, f32x2 c) { f32x2 d; asm("v_pk_fma_f32 %0, %1, %2, %3 op_sel_hi:[1,0,1]" : "=v"(d) : "v"(a), "v"(blo), "v"(c)); return d; }
__device__ __forceinline__ float add_asm(float a, float b) { float d; asm("v_add_f32 %0, %1, %2" : "=v"(d) : "v"(a), "v"(b)); return d; }
struct StepOps { f32x4 nk, wr, w, b, k; f32x2 vi; };
__device__ __forceinline__ void allred8x2_decay(float& a, float& b, f32x2& s01, f32x2& s23, f32x2& s45, f32x2& s67, f32x2 w01, f32x2 w23, f32x2 w45, f32x2 w67) {
    asm volatile("s_nop 0\n\t"
        "v_add_f32_dpp %0, %0, %0 quad_perm:[1,0,3,2] row_mask:0xf bank_mask:0xf bound_ctrl:1\n\t"
        "v_add_f32_dpp %1, %1, %1 quad_perm:[1,0,3,2] row_mask:0xf bank_mask:0xf bound_ctrl:1\n\t"
        "v_pk_mul_f32 %2, %2, %6\n\t"
        "v_add_f32_dpp %0, %0, %0 quad_perm:[2,3,0,1] row_mask:0xf bank_mask:0xf bound_ctrl:1\n\t"
        "v_add_f32_dpp %1, %1, %1 quad_perm:[2,3,0,1] row_mask:0xf bank_mask:0xf bound_ctrl:1\n\t"
        "v_pk_mul_f32 %3, %3, %7\n\t"
        "v_add_f32_dpp %0, %0, %0 row_half_mirror row_mask:0xf bank_mask:0xf bound_ctrl:1\n\t"
        "v_add_f32_dpp %1, %1, %1 row_half_mirror row_mask:0xf bank_mask:0xf bound_ctrl:1\n\t"
        "v_pk_mul_f32 %4, %4, %8\n\t"
        "v_pk_mul_f32 %5, %5, %9"
        : "+v"(a), "+v"(b), "+v"(s01), "+v"(s23), "+v"(s45), "+v"(s67) : "v"(w01), "v"(w23), "v"(w45), "v"(w67));
}
struct StepOps8 { f32x4 nk0, nk1, wr0, wr1, w0, w1, b0, b1, k0, k1; f32x2 vi; };

__device__ __forceinline__ void wkv_prompt(CP& p, LAS unsigned char* lds, int unit, bool dry) {
    int tid_l = threadIdx.x; asm volatile("" : "+v"(tid_l)); const int tid = tid_l, wave = tid >> 6, lane = tid & 63;
    const int bh = unit >> 1, half = unit & 1, b = bh >> 4, h = bh & 15;
    const int rl = (wave & 3) * 8 + (lane >> 3), s = lane & 7;
    const int ptok = tid >> 3, pcg = tid & 7;
    bf16* Z1 = (bf16*)(p.ws + WS_Z1); bf16* BON = (bf16*)(p.ws + WS_BONUS);
    const size_t rowbase = (size_t)b * SEQ;
    LAS bf16* RAW = (LAS bf16*)(lds + L_RAW); LAS bf16* RAWL = (LAS bf16*)(lds + L_RAWL);
    LAS float* ONKK = (LAS float*)(lds + L_NKK); LAS float* OWR = (LAS float*)(lds + L_WR); LAS float* OW = (LAS float*)(lds + L_W); LAS float* OB = (LAS float*)(lds + L_B); LAS float* OKP = (LAS float*)(lds + L_KP);
    LAS float* VL = (LAS float*)(lds + L_VL); LAS float* SC = (LAS float*)(lds + L_SC); LAS float* YB = (LAS float*)(lds + L_YB);
    LAS float* PW = (LAS float*)(lds + L_PW); LAS float* PA = (LAS float*)(lds + L_PA);
    LAS float* CST = (LAS float*)(lds + L_CST); LAS float* MUL = (LAS float*)(lds + L_MUL); LAS bf16* WB = (LAS bf16*)(lds + L_WB);
    if (tid < 96) ((LAS unsigned*)RAW)[tid] = 0u;
    if (tid < 68) ((LAS unsigned*)RAWL)[tid] = 0u;
    {
      const int a = tid >> 6, cc = tid & 63, C = h * 64 + cc;
      const float* src = a == 0 ? p.in[I_MU] + ZR : a == 1 ? p.in[I_MU] + ZK : a == 2 ? p.in[I_MU] + ZV : a == 3 ? p.in[I_W0] : a == 4 ? p.in[I_A0] : a == 5 ? p.in[I_KK] : a == 6 ? p.in[I_KA] : p.in[I_RK];
      CST[a * 64 + cc] = src[C];
      if (tid < 128) MUL[tid] = p.in[I_MU][ZWL + tid];
      const bf16* w2T = (const bf16*)(p.ws + WS_SMALL); const bf16* a2T = w2T + 65536;
      const int n = tid >> 3, k8 = tid & 7;
      *(LAS v4u*)(WB + n * WBS + 8 * k8) = *(const v4u*)(w2T + (size_t)(h * 64 + n) * 64 + 8 * k8);
      *(LAS v4u*)(WB + 64 * WBS + n * WBS + 8 * k8) = *(const v4u*)(a2T + (size_t)(h * 64 + n) * 64 + 8 * k8); }
    f32x2 S01 = {0.f, 0.f}, S23 = {0.f, 0.f}, S45 = {0.f, 0.f}, S67 = {0.f, 0.f};
    const int C0 = h * 64 + 8 * pcg;
    const bool vmine = (pcg >> 2) == half;
    v4u pr, pk, pv, pl0, pl1;
    { const bf16* z = Z1 + (rowbase + ptok) * NZ1;
      pr = *(const v4u*)(z + ZR + C0); pk = *(const v4u*)(z + ZK + C0); pv = vmine ? *(const v4u*)(z + ZV + C0) : (v4u){0u, 0u, 0u, 0u};
      pl0 = *(const v4u*)(z + ZWL + 16 * pcg); pl1 = *(const v4u*)(z + ZWL + 16 * pcg + 8); }
    for (int c = 0; c < SEQ / 64; ++c) {
        if (ptok == 63 && c > 0) {
            *(LAS v4u*)(RAW + 0 + 8 * pcg) = *(LAS v4u*)(RAW + 64 * 192 + 8 * pcg); *(LAS v4u*)(RAW + 64 + 8 * pcg) = *(LAS v4u*)(RAW + 64 * 192 + 64 + 8 * pcg);
            *(LAS v4u*)(RAW + 128 + 8 * pcg) = *(LAS v4u*)(RAW + 64 * 192 + 128 + 8 * pcg);
            *(LAS v4u*)(RAWL + 16 * pcg) = *(LAS v4u*)(RAWL + 64 * RLS + 16 * pcg); *(LAS v4u*)(RAWL + 16 * pcg + 8) = *(LAS v4u*)(RAWL + 64 * RLS + 16 * pcg + 8); }
        { LAS bf16* rr = RAW + (ptok + 1) * 192; *(LAS v4u*)(rr + 8 * pcg) = pr; *(LAS v4u*)(rr + 64 + 8 * pcg) = pk; *(LAS v4u*)(rr + 128 + 8 * pcg) = pv;
          LAS bf16* rl2 = RAWL + (ptok + 1) * RLS; *(LAS v4u*)(rl2 + 16 * pcg) = pl0; *(LAS v4u*)(rl2 + 16 * pcg + 8) = pl1; }
        __syncthreads();
        if (c + 1 < SEQ / 64) { const bf16* z = Z1 + (rowbase + (size_t)(c + 1) * 64 + ptok) * NZ1;
            pr = *(const v4u*)(z + ZR + C0); pk = *(const v4u*)(z + ZK + C0); if (vmine) pv = *(const v4u*)(z + ZV + C0);
            pl0 = *(const v4u*)(z + ZWL + 16 * pcg); pl1 = *(const v4u*)(z + ZWL + 16 * pcg + 8); }
#ifdef PROBE_PREP2
        for (int rep = 0; rep < (p.never == 0 ? 2 : 1); ++rep) {
#else
        {
#endif
        { const int tb = wave & 3, nh = wave >> 2, fr = lane & 15, q = lane >> 4, ti = 16 * tb + fr;
          bf16x8 aw[2], aa[2];
#pragma unroll
          for (int ks = 0; ks < 2; ++ks) {
              const int ko = 32 * ks + 8 * q;
              { const v4u cu = *(LAS v4u*)(RAWL + (ti + 1) * RLS + ko), pu = *(LAS v4u*)(RAWL + ti * RLS + ko); float cf[8], pf[8]; UNPACK8(cu, cf); UNPACK8(pu, pf);
                const f32x4 m0 = *(LAS f32x4*)(MUL + ko), m1 = *(LAS f32x4*)(MUL + ko + 4); float o[8];
#pragma unroll
                for (int e = 0; e < 8; ++e) { const float mu = e < 4 ? m0[e & 3] : m1[e & 3]; o[e] = tanh_(cf[e] + mu * (pf[e] - cf[e])); }
                v4u w; w.x = pk2(o[0], o[1]); w.y = pk2(o[2], o[3]); w.z = pk2(o[4], o[5]); w.w = pk2(o[6], o[7]); aw[ks] = __builtin_bit_cast(bf16x8, w); }
              { const v4u cu = *(LAS v4u*)(RAWL + (ti + 1) * RLS + 64 + ko), pu = *(LAS v4u*)(RAWL + ti * RLS + 64 + ko); float cf[8], pf[8]; UNPACK8(cu, cf); UNPACK8(pu, pf);
                const f32x4 m0 = *(LAS f32x4*)(MUL + 64 + ko), m1 = *(LAS f32x4*)(MUL + 64 + ko + 4); float o[8];
#pragma unroll
                for (int e = 0; e < 8; ++e) { const float mu = e < 4 ? m0[e & 3] : m1[e & 3]; o[e] = cf[e] + mu * (pf[e] - cf[e]); }
                v4u w; w.x = pk2(o[0], o[1]); w.y = pk2(o[2], o[3]); w.z = pk2(o[4], o[5]); w.w = pk2(o[6], o[7]); aa[ks] = __builtin_bit_cast(bf16x8, w); }
          }
#pragma unroll
          for (int nbi = 0; nbi < 2; ++nbi) {
              const int nb = 2 * nh + nbi, n = 16 * nb + fr;
              f32x4 cw = {0.f, 0.f, 0.f, 0.f}, ca = {0.f, 0.f, 0.f, 0.f};
#pragma unroll
              for (int ks = 0; ks < 2; ++ks) {
                  const bf16x8 bw = *(LAS bf16x8*)(WB + n * WBS + 32 * ks + 8 * q), ba = *(LAS bf16x8*)(WB + 64 * WBS + n * WBS + 32 * ks + 8 * q);
                  cw = __builtin_amdgcn_mfma_f32_16x16x32_bf16(aw[ks], bw, cw, 0, 0, 0); ca = __builtin_amdgcn_mfma_f32_16x16x32_bf16(aa[ks], ba, ca, 0, 0, 0); }
#pragma unroll
              for (int r = 0; r < 4; ++r) { const int tok = 16 * tb + 4 * q + r; PW[tok * OPS + 16 * nb + fr] = cw[r]; PA[tok * OPS + 16 * nb + fr] = ca[r]; }
          }
        }
        __syncthreads();
        { float rc[8], kc[8], vc[8], t8[8];
          const int cc0 = 8 * pcg;
          { const v4u cu = *(LAS v4u*)(RAW + (ptok + 1) * 192 + cc0), pu = *(LAS v4u*)(RAW + ptok * 192 + cc0); UNPACK8(cu, rc); UNPACK8(pu, t8);
            const f32x4 m0 = *(LAS f32x4*)(CST + cc0), m1 = *(LAS f32x4*)(CST + cc0 + 4);
#pragma unroll
            for (int e = 0; e < 8; ++e) rc[e] += (e < 4 ? m0[e & 3] : m1[e & 3]) * (t8[e] - rc[e]); }
          { const v4u cu = *(LAS v4u*)(RAW + (ptok + 1) * 192 + 64 + cc0), pu = *(LAS v4u*)(RAW + ptok * 192 + 64 + cc0); UNPACK8(cu, kc); UNPACK8(pu, t8);
            const f32x4 m0 = *(LAS f32x4*)(CST + 64 + cc0), m1 = *(LAS f32x4*)(CST + 64 + cc0 + 4);
#pragma unroll
            for (int e = 0; e < 8; ++e) kc[e] += (e < 4 ? m0[e & 3] : m1[e & 3]) * (t8[e] - kc[e]); }
          { const v4u cu = *(LAS v4u*)(RAW + (ptok + 1) * 192 + 128 + cc0), pu = *(LAS v4u*)(RAW + ptok * 192 + 128 + cc0); UNPACK8(cu, vc); UNPACK8(pu, t8);
            const f32x4 m0 = *(LAS f32x4*)(CST + 128 + cc0), m1 = *(LAS f32x4*)(CST + 128 + cc0 + 4);
#pragma unroll
            for (int e = 0; e < 8; ++e) vc[e] += (e < 4 ? m0[e & 3] : m1[e & 3]) * (t8[e] - vc[e]); }
          float dec[8], av[8], kku[8], kp[8];
          { const f32x4 wa0 = *(LAS f32x4*)(PW + ptok * OPS + cc0), wa1 = *(LAS f32x4*)(PW + ptok * OPS + cc0 + 4);
            const f32x4 aa0 = *(LAS f32x4*)(PA + ptok * OPS + cc0), aa1 = *(LAS f32x4*)(PA + ptok * OPS + cc0 + 4);
            const f32x4 w00 = *(LAS f32x4*)(CST + 192 + cc0), w01 = *(LAS f32x4*)(CST + 192 + cc0 + 4);
            const f32x4 a00 = *(LAS f32x4*)(CST + 256 + cc0), a01 = *(LAS f32x4*)(CST + 256 + cc0 + 4);
            const f32x4 kk0 = *(LAS f32x4*)(CST + 320 + cc0), kk1 = *(LAS f32x4*)(CST + 320 + cc0 + 4);
            const f32x4 ka0 = *(LAS f32x4*)(CST + 384 + cc0), ka1 = *(LAS f32x4*)(CST + 384 + cc0 + 4);
#pragma unroll
            for (int e = 0; e < 8; ++e) {
                const float wl = (e < 4 ? w00[e & 3] : w01[e & 3]) + (e < 4 ? wa0[e & 3] : wa1[e & 3]);
                dec[e] = __expf(-0.6065306597126334f * sigm(wl));
                av[e] = sigm((e < 4 ? a00[e & 3] : a01[e & 3]) + (e < 4 ? aa0[e & 3] : aa1[e & 3]));
                kku[e] = kc[e] * (e < 4 ? kk0[e & 3] : kk1[e & 3]);
                kp[e] = kc[e] * (1.f + (av[e] - 1.f) * (e < 4 ? ka0[e & 3] : ka1[e & 3])); } }
          float ss = 0.f;
#pragma unroll
          for (int e = 0; e < 8; ++e) ss += kku[e] * kku[e];
          ss = allred8(ss);
          const float inv = 1.f / fmaxf(sqrtf(ss), 1e-12f);
          const f32x4 rk0 = *(LAS f32x4*)(CST + 448 + cc0), rk1 = *(LAS f32x4*)(CST + 448 + cc0 + 4);
          float nk[8], bb[8], wr8[8], br = 0.f, kr = 0.f, bon = 0.f;
#pragma unroll
          for (int e = 0; e < 8; ++e) { const float kk = kku[e] * inv; nk[e] = -kk; bb[e] = kk * av[e]; wr8[e] = dec[e] * rc[e];
              br += bb[e] * rc[e]; kr += kp[e] * rc[e]; bon += rc[e] * kp[e] * (e < 4 ? rk0[e & 3] : rk1[e & 3]); }
          br = allred8(br); kr = allred8(kr); bon = allred8(bon);
          const int o = ptok * OPS + 8 * pcg;
          *(LAS f32x4*)(ONKK + o) = (f32x4){nk[0], nk[1], nk[2], nk[3]}; *(LAS f32x4*)(ONKK + o + 4) = (f32x4){nk[4], nk[5], nk[6], nk[7]};
          *(LAS f32x4*)(OWR + o) = (f32x4){wr8[0], wr8[1], wr8[2], wr8[3]}; *(LAS f32x4*)(OWR + o + 4) = (f32x4){wr8[4], wr8[5], wr8[6], wr8[7]};
          *(LAS f32x4*)(OW + o) = (f32x4){dec[0], dec[1], dec[2], dec[3]}; *(LAS f32x4*)(OW + o + 4) = (f32x4){dec[4], dec[5], dec[6], dec[7]};
          *(LAS f32x4*)(OB + o) = (f32x4){bb[0], bb[1], bb[2], bb[3]}; *(LAS f32x4*)(OB + o + 4) = (f32x4){bb[4], bb[5], bb[6], bb[7]};
          *(LAS f32x4*)(OKP + o) = (f32x4){kp[0], kp[1], kp[2], kp[3]}; *(LAS f32x4*)(OKP + o + 4) = (f32x4){kp[4], kp[5], kp[6], kp[7]};
          if (pcg == 0) *(LAS f32x2*)(SC + 2 * ptok) = (f32x2){br, kr};
          if (vmine) { const int vo = ptok * 32 + 8 * (pcg & 3);
              *(LAS f32x4*)(VL + vo) = (f32x4){vc[0], vc[1], vc[2], vc[3]}; *(LAS f32x4*)(VL + vo + 4) = (f32x4){vc[4], vc[5], vc[6], vc[7]};
              v4u w; w.x = pk2(bon * vc[0], bon * vc[1]); w.y = pk2(bon * vc[2], bon * vc[3]); w.z = pk2(bon * vc[4], bon * vc[5]); w.w = pk2(bon * vc[6], bon * vc[7]);
              if (!dry) *(v4u*)(BON + (rowbase + (size_t)c * 64 + ptok) * DM + C0) = w; }
        }
        __syncthreads();
        }
        if (wave < 4) { float sak = 0.f, y0k = 0.f;
#define WK_LOAD(o, t) do { const int ofs = (t) * OPS + 8 * s; \
              o.nk0 = *(const LAS f32x4*)(ONKK + ofs); o.nk1 = *(const LAS f32x4*)(ONKK + ofs + 4); o.wr0 = *(const LAS f32x4*)(OWR + ofs); o.wr1 = *(const LAS f32x4*)(OWR + ofs + 4); \
              o.w0 = *(const LAS f32x4*)(OW + ofs); o.w1 = *(const LAS f32x4*)(OW + ofs + 4); o.b0 = *(const LAS f32x4*)(OB + ofs); o.b1 = *(const LAS f32x4*)(OB + ofs + 4); \
              o.k0 = *(const LAS f32x4*)(OKP + ofs); o.k1 = *(const LAS f32x4*)(OKP + ofs + 4); o.vi[0] = VL[(t) * 32 + rl]; } while (0)
#define P2(v, i) ((f32x2){v[i], v[(i) + 1]})
#define WK_STEP(o, tl) do { \
              f32x2 ac = pk_mul(S01, P2(o.nk0, 0)); ac = pk_fma(S23, P2(o.nk0, 2), ac); ac = pk_fma(S45, P2(o.nk1, 0), ac); ac = pk_fma(S67, P2(o.nk1, 2), ac); \
              f32x2 ay = pk_mul(S01, P2(o.wr0, 0)); ay = pk_fma(S23, P2(o.wr0, 2), ay); ay = pk_fma(S45, P2(o.wr1, 0), ay); ay = pk_fma(S67, P2(o.wr1, 2), ay); \
              float psa = add_asm(ac[0], ac[1]), py = add_asm(ay[0], ay[1]); \
              allred8x2_decay(psa, py, S01, S23, S45, S67, P2(o.w0, 0), P2(o.w0, 2), P2(o.w1, 0), P2(o.w1, 2)); \
              f32x2 sap; sap[0] = psa; sap[1] = 0.f; \
              S01 = pk_fma_b(P2(o.b0, 0), sap, S01); S23 = pk_fma_b(P2(o.b0, 2), sap, S23); S45 = pk_fma_b(P2(o.b1, 0), sap, S45); S67 = pk_fma_b(P2(o.b1, 2), sap, S67); \
              S01 = pk_fma_b(P2(o.k0, 0), o.vi, S01); S23 = pk_fma_b(P2(o.k0, 2), o.vi, S23); S45 = pk_fma_b(P2(o.k1, 0), o.vi, S45); S67 = pk_fma_b(P2(o.k1, 2), o.vi, S67); \
              const bool mine = (s == (tl)); sak = mine ? psa : sak; y0k = mine ? py : y0k; } while (0)
          StepOps8 A0, B0; A0.vi[1] = B0.vi[1] = 0.f;
          WK_LOAD(A0, 0);
#pragma unroll 1
          for (int tb = 0; tb < 64; tb += 8) {
              WK_LOAD(B0, tb + 1); WK_STEP(A0, 0);
              WK_LOAD(A0, tb + 2); WK_STEP(B0, 1);
              WK_LOAD(B0, tb + 3); WK_STEP(A0, 2);
              WK_LOAD(A0, tb + 4); WK_STEP(B0, 3);
              WK_LOAD(B0, tb + 5); WK_STEP(A0, 4);
              WK_LOAD(A0, tb + 6); WK_STEP(B0, 5);
              WK_LOAD(B0, tb + 7); WK_STEP(A0, 6);
              const int tn = (tb + 8) & 63;
              WK_LOAD(A0, tn);     WK_STEP(B0, 7);
              { const int t = tb + s; const f32x2 sc = *(const LAS f32x2*)(SC + 2 * t); YB[t * 32 + rl] = y0k + sak * sc[0] + VL[t * 32 + rl] * sc[1]; }
          }
#undef WK_LOAD
#undef WK_STEP
#undef P2
        }
        __syncthreads();
        { const f32x4 yv = *(LAS f32x4*)(YB + ptok * 32 + 4 * pcg); v2u w; w.x = pk2(yv[0], yv[1]); w.y = pk2(yv[2], yv[3]);
          if (!dry) *(v2u*)(Z1 + (rowbase + (size_t)c * 64 + ptok) * NZ1 + ZV + h * 64 + 32 * half + 4 * pcg) = w; }
    }
    if (!dry && wave < 4) { float* so = p.out + O_WKVP + ((size_t)(b * 16 + h) * 64 + 32 * half + rl) * 64 + 8 * s; *(f32x4*)so = (f32x4){S01[0], S01[1], S23[0], S23[1]}; *(f32x4*)(so + 4) = (f32x4){S45[0], S45[1], S67[0], S67[1]}; }
    __syncthreads();
}

constexpr int CH2 = 32, NCH2 = SEQ / CH2;
constexpr int L2_OP = 0, L2_OPSZ = 43520, L2_A = 8704  , L2_VL = 87040, L2_SC = 95232, L2_YB = 95744, L2_CST = 103936, L2_MUL = 105984, L2_WB = 106496;
struct RawRegs { v4u lw[2], la[2], lwp[2], lap[2], r, k, v, rp, kp, vp; };
__device__ __forceinline__ void wkv_prompt2(CP& p, LAS unsigned char* lds, int unit, bool dry) {
    int tid_l = threadIdx.x; asm volatile("" : "+v"(tid_l)); const int tid = tid_l, wave = tid >> 6, lane = tid & 63;
    const int bh = unit >> 1, half = unit & 1, b = bh >> 4, h = bh & 15;
    bf16* Z1 = (bf16*)(p.ws + WS_Z1); bf16* BON = (bf16*)(p.ws + WS_BONUS);
    const size_t rowbase = (size_t)b * SEQ;
    LAS float* CST = (LAS float*)(lds + L2_CST); LAS float* MUL = (LAS float*)(lds + L2_MUL); LAS bf16* WB = (LAS bf16*)(lds + L2_WB);
    { const int a = tid >> 6, cc = tid & 63, C = h * 64 + cc;
      const float* src = a == 0 ? p.in[I_MU] + ZR : a == 1 ? p.in[I_MU] + ZK : a == 2 ? p.in[I_MU] + ZV : a == 3 ? p.in[I_W0] : a == 4 ? p.in[I_A0] : a == 5 ? p.in[I_KK] : a == 6 ? p.in[I_KA] : p.in[I_RK];
      CST[a * 64 + cc] = src[C];
      if (tid < 128) MUL[tid] = p.in[I_MU][ZWL + tid];
      const bf16* w2T = (const bf16*)(p.ws + WS_SMALL); const bf16* a2T = w2T + 65536;
      const int n = tid >> 3, k8 = tid & 7;
      *(LAS v4u*)(WB + n * WBS + 8 * k8) = *(const v4u*)(w2T + (size_t)(h * 64 + n) * 64 + 8 * k8);
      *(LAS v4u*)(WB + 64 * WBS + n * WBS + 8 * k8) = *(const v4u*)(a2T + (size_t)(h * 64 + n) * 64 + 8 * k8); }
    __syncthreads();
    if (wave >= 4) {
        const int w4 = wave - 4, fr = lane & 15, q = lane >> 4, tb = w4 >> 1;
        const int ptok = 8 * w4 + (lane >> 3), pcg = lane & 7, C0 = h * 64 + 8 * pcg;
        const bool vmine = (pcg >> 2) == half;
        const int ftok = (tid - 256) >> 3;
        RawRegs R;
#define WK_LOADRAW(cc) do { const size_t rowL = rowbase + (size_t)(cc) * CH2 + 16 * tb + fr; const bf16* zl = Z1 + rowL * NZ1; const bool z0 = ((cc) == 0 && 16 * tb + fr == 0); const bf16* zlp = z0 ? zl : zl - NZ1; \
            _Pragma("unroll") for (int ks = 0; ks < 2; ++ks) { R.lw[ks] = *(const v4u*)(zl + ZWL + 32 * ks + 8 * q); R.la[ks] = *(const v4u*)(zl + ZAL + 32 * ks + 8 * q); \
                R.lwp[ks] = *(const v4u*)(zlp + ZWL + 32 * ks + 8 * q); R.lap[ks] = *(const v4u*)(zlp + ZAL + 32 * ks + 8 * q); \
                if (z0) { R.lwp[ks] = (v4u){0u, 0u, 0u, 0u}; R.lap[ks] = (v4u){0u, 0u, 0u, 0u}; } } \
            const size_t rowE = rowbase + (size_t)(cc) * CH2 + ptok; const bf16* ze = Z1 + rowE * NZ1; const bool e0 = ((cc) == 0 && ptok == 0); const bf16* zep = e0 ? ze : ze - NZ1; \
            R.r = *(const v4u*)(ze + ZR + C0); R.k = *(const v4u*)(ze + ZK + C0); R.rp = *(const v4u*)(zep + ZR + C0); R.kp = *(const v4u*)(zep + ZK + C0); \
            if (vmine) { R.v = *(const v4u*)(ze + ZV + C0); R.vp = *(const v4u*)(zep + ZV + C0); } else { R.v = (v4u){0u, 0u, 0u, 0u}; R.vp = R.v; } \
            if (e0) { R.rp = (v4u){0u, 0u, 0u, 0u}; R.kp = R.rp; R.vp = R.rp; } } while (0)
        WK_LOADRAW(0);
        for (int c = -1; c < NCH2; ++c) {
            if (c >= 1) {
                const LAS float* YBp = (const LAS float*)(lds + L2_YB + ((c - 1) & 1) * 4096);
                const f32x4 yv = *(const LAS f32x4*)(YBp + ftok * 32 + 4 * pcg); v2u w; w.x = pk2(yv[0], yv[1]); w.y = pk2(yv[2], yv[3]);
                if (!dry) *(v2u*)(Z1 + (rowbase + (size_t)(c - 1) * CH2 + ftok) * NZ1 + ZV + h * 64 + 32 * half + 4 * pcg) = w; }
            if (c + 1 < NCH2) {
                const int cc = c + 1;
                const RawRegs T = R;
                if (cc + 1 < NCH2) WK_LOADRAW(cc + 1);
                LAS unsigned char* ob = lds + L2_OP + (cc & 1) * L2_OPSZ;
                LAS float* ONKK = (LAS float*)ob; LAS float* OWR = (LAS float*)(ob + L2_A); LAS float* OW = (LAS float*)(ob + 2 * L2_A); LAS float* OB = (LAS float*)(ob + 3 * L2_A); LAS float* OKP = (LAS float*)(ob + 4 * L2_A);
                LAS float* VL = (LAS float*)(lds + L2_VL + (cc & 1) * 4096); LAS float* SC = (LAS float*)(lds + L2_SC + (cc & 1) * 256);
                { bf16x8 aw[2], aa[2];
#pragma unroll
                  for (int ks = 0; ks < 2; ++ks) { const int ko = 32 * ks + 8 * q;
                      { float cf[8], pf[8]; UNPACK8(T.lw[ks], cf); UNPACK8(T.lwp[ks], pf); const f32x4 m0 = *(LAS f32x4*)(MUL + ko), m1 = *(LAS f32x4*)(MUL + ko + 4); float o[8];
#pragma unroll
                        for (int e = 0; e < 8; ++e) { const float mu = e < 4 ? m0[e & 3] : m1[e & 3]; o[e] = tanh_(cf[e] + mu * (pf[e] - cf[e])); }
                        v4u w; w.x = pk2(o[0], o[1]); w.y = pk2(o[2], o[3]); w.z = pk2(o[4], o[5]); w.w = pk2(o[6], o[7]); aw[ks] = __builtin_bit_cast(bf16x8, w); }
                      { float cf[8], pf[8]; UNPACK8(T.la[ks], cf); UNPACK8(T.lap[ks], pf); const f32x4 m0 = *(LAS f32x4*)(MUL + 64 + ko), m1 = *(LAS f32x4*)(MUL + 64 + ko + 4); float o[8];
#pragma unroll
                        for (int e = 0; e < 8; ++e) { const float mu = e < 4 ? m0[e & 3] : m1[e & 3]; o[e] = cf[e] + mu * (pf[e] - cf[e]); }
                        v4u w; w.x = pk2(o[0], o[1]); w.y = pk2(o[2], o[3]); w.z = pk2(o[4], o[5]); w.w = pk2(o[6], o[7]); aa[ks] = __builtin_bit_cast(bf16x8, w); } }
#pragma unroll
                  for (int nb = 0; nb < 4; ++nb) { const int n = 16 * nb + fr; f32x4 cw = {0.f, 0.f, 0.f, 0.f}, ca = {0.f, 0.f, 0.f, 0.f};
#pragma unroll
                      for (int ks = 0; ks < 2; ++ks) { const bf16x8 bw = *(LAS bf16x8*)(WB + n * WBS + 32 * ks + 8 * q), ba = *(LAS bf16x8*)(WB + 64 * WBS + n * WBS + 32 * ks + 8 * q);
                          cw = __builtin_amdgcn_mfma_f32_16x16x32_bf16(aw[ks], bw, cw, 0, 0, 0); ca = __builtin_amdgcn_mfma_f32_16x16x32_bf16(aa[ks], ba, ca, 0, 0, 0); }
                      if ((q >> 1) == (w4 & 1)) {
#pragma unroll
                          for (int r = 0; r < 4; ++r) { const int tok = 16 * tb + 4 * q + r; OW[tok * OPS + 16 * nb + fr] = cw[r]; OB[tok * OPS + 16 * nb + fr] = ca[r]; } } } }
                LDS_WAIT(); asm volatile("" ::: "memory");
                { float rc[8], kc[8], vc[8], t8[8]; const int cc0 = 8 * pcg;
                  { UNPACK8(T.r, rc); UNPACK8(T.rp, t8); const f32x4 m0 = *(LAS f32x4*)(CST + cc0), m1 = *(LAS f32x4*)(CST + cc0 + 4);
#pragma unroll
                    for (int e = 0; e < 8; ++e) rc[e] += (e < 4 ? m0[e & 3] : m1[e & 3]) * (t8[e] - rc[e]); }
                  { UNPACK8(T.k, kc); UNPACK8(T.kp, t8); const f32x4 m0 = *(LAS f32x4*)(CST + 64 + cc0), m1 = *(LAS f32x4*)(CST + 64 + cc0 + 4);
#pragma unroll
                    for (int e = 0; e < 8; ++e) kc[e] += (e < 4 ? m0[e & 3] : m1[e & 3]) * (t8[e] - kc[e]); }
                  { UNPACK8(T.v, vc); UNPACK8(T.vp, t8); const f32x4 m0 = *(LAS f32x4*)(CST + 128 + cc0), m1 = *(LAS f32x4*)(CST + 128 + cc0 + 4);
#pragma unroll
                    for (int e = 0; e < 8; ++e) vc[e] += (e < 4 ? m0[e & 3] : m1[e & 3]) * (t8[e] - vc[e]); }
                  float dec[8], av[8], kku[8], kp[8];
                  { const f32x4 wa0 = *(LAS f32x4*)(OW + ptok * OPS + cc0), wa1 = *(LAS f32x4*)(OW + ptok * OPS + cc0 + 4);
                    const f32x4 aa0 = *(LAS f32x4*)(OB + ptok * OPS + cc0), aa1 = *(LAS f32x4*)(OB + ptok * OPS + cc0 + 4);
                    const f32x4 w00 = *(LAS f32x4*)(CST + 192 + cc0), w01 = *(LAS f32x4*)(CST + 192 + cc0 + 4);
                    const f32x4 a00 = *(LAS f32x4*)(CST + 256 + cc0), a01 = *(LAS f32x4*)(CST + 256 + cc0 + 4);
                    const f32x4 kk0 = *(LAS f32x4*)(CST + 320 + cc0), kk1 = *(LAS f32x4*)(CST + 320 + cc0 + 4);
                    const f32x4 ka0 = *(LAS f32x4*)(CST + 384 + cc0), ka1 = *(LAS f32x4*)(CST + 384 + cc0 + 4);
#pragma unroll
                    for (int e = 0; e < 8; ++e) {
                        const float wl = (e < 4 ? w00[e & 3] : w01[e & 3]) + (e < 4 ? wa0[e & 3] : wa1[e & 3]);
                        dec[e] = __expf(-0.6065306597126334f * sigm(wl));
                        av[e] = sigm((e < 4 ? a00[e & 3] : a01[e & 3]) + (e < 4 ? aa0[e & 3] : aa1[e & 3]));
                        kku[e] = kc[e] * (e < 4 ? kk0[e & 3] : kk1[e & 3]);
                        kp[e] = kc[e] * (1.f + (av[e] - 1.f) * (e < 4 ? ka0[e & 3] : ka1[e & 3])); } }
                  float ss = 0.f;
#pragma unroll
                  for (int e = 0; e < 8; ++e) ss += kku[e] * kku[e];
                  ss = allred8(ss);
                  const float inv = 1.f / fmaxf(sqrtf(ss), 1e-12f);
                  const f32x4 rk0 = *(LAS f32x4*)(CST + 448 + cc0), rk1 = *(LAS f32x4*)(CST + 448 + cc0 + 4);
                  float nk[8], bb[8], wr8[8], br = 0.f, kr = 0.f, bon = 0.f;
#pragma unroll
                  for (int e = 0; e < 8; ++e) { const float kk = kku[e] * inv; nk[e] = -kk; bb[e] = kk * av[e]; wr8[e] = dec[e] * rc[e];
                      br += bb[e] * rc[e]; kr += kp[e] * rc[e]; bon += rc[e] * kp[e] * (e < 4 ? rk0[e & 3] : rk1[e & 3]); }
                  br = allred8(br); kr = allred8(kr); bon = allred8(bon);
                  const int o = ptok * OPS + 8 * pcg;
                  *(LAS f32x4*)(ONKK + o) = (f32x4){nk[0], nk[1], nk[2], nk[3]}; *(LAS f32x4*)(ONKK + o + 4) = (f32x4){nk[4], nk[5], nk[6], nk[7]};
                  *(LAS f32x4*)(OWR + o) = (f32x4){wr8[0], wr8[1], wr8[2], wr8[3]}; *(LAS f32x4*)(OWR + o + 4) = (f32x4){wr8[4], wr8[5], wr8[6], wr8[7]};
                  *(LAS f32x4*)(OW + o) = (f32x4){dec[0], dec[1], dec[2], dec[3]}; *(LAS f32x4*)(OW + o + 4) = (f32x4){dec[4], dec[5], dec[6], dec[7]};
                  *(LAS f32x4*)(OB + o) = (f32x4){bb[0], bb[1], bb[2], bb[3]}; *(LAS f32x4*)(OB + o + 4) = (f32x4){bb[4], bb[5], bb[6], bb[7]};
                  *(LAS f32x4*)(OKP + o) = (f32x4){kp[0], kp[1], kp[2], kp[3]}; *(LAS f32x4*)(OKP + o + 4) = (f32x4){kp[4], kp[5], kp[6], kp[7]};
                  if (pcg == 0) *(LAS f32x2*)(SC + 2 * ptok) = (f32x2){br, kr};
                  if (vmine) { const int vo = ptok * 32 + 8 * (pcg & 3);
                      *(LAS f32x4*)(VL + vo) = (f32x4){vc[0], vc[1], vc[2], vc[3]}; *(LAS f32x4*)(VL + vo + 4) = (f32x4){vc[4], vc[5], vc[6], vc[7]};
                      v4u w; w.x = pk2(bon * vc[0], bon * vc[1]); w.y = pk2(bon * vc[2], bon * vc[3]); w.z = pk2(bon * vc[4], bon * vc[5]); w.w = pk2(bon * vc[6], bon * vc[7]);
                      if (!dry) *(v4u*)(BON + (rowbase + (size_t)cc * CH2 + ptok) * DM + C0) = w; }
                }
            }
            __syncthreads();
        }
        { const int c = NCH2;
          const LAS float* YBp = (const LAS float*)(lds + L2_YB + ((c - 1) & 1) * 4096);
          const f32x4 yv = *(const LAS f32x4*)(YBp + ftok * 32 + 4 * pcg); v2u w; w.x = pk2(yv[0], yv[1]); w.y = pk2(yv[2], yv[3]);
          if (!dry) *(v2u*)(Z1 + (rowbase + (size_t)(c - 1) * CH2 + ftok) * NZ1 + ZV + h * 64 + 32 * half + 4 * pcg) = w; }
#undef WK_LOADRAW
    } else {
        const int rl = wave * 8 + (lane >> 3), s = lane & 7;
        f32x2 S01 = {0.f, 0.f}, S23 = {0.f, 0.f}, S45 = {0.f, 0.f}, S67 = {0.f, 0.f};
        __syncthreads();
        for (int c = 0; c < NCH2; ++c) {
            const LAS unsigned char* ob = lds + L2_OP + (c & 1) * L2_OPSZ;
            const LAS float* ONKK = (const LAS float*)ob; const LAS float* OWR = (const LAS float*)(ob + L2_A); const LAS float* OW = (const LAS float*)(ob + 2 * L2_A);
            const LAS float* OB = (const LAS float*)(ob + 3 * L2_A); const LAS float* OKP = (const LAS float*)(ob + 4 * L2_A);
            const LAS float* VL = (const LAS float*)(lds + L2_VL + (c & 1) * 4096); const LAS float* SC = (const LAS float*)(lds + L2_SC + (c & 1) * 256);
            LAS float* YB = (LAS float*)(lds + L2_YB + (c & 1) * 4096);
            float sak = 0.f, y0k = 0.f;
#define WK_LOAD(o, t) do { const int ofs = (t) * OPS + 8 * s; \
              o.nk0 = *(const LAS f32x4*)(ONKK + ofs); o.nk1 = *(const LAS f32x4*)(ONKK + ofs + 4); o.wr0 = *(const LAS f32x4*)(OWR + ofs); o.wr1 = *(const LAS f32x4*)(OWR + ofs + 4); \
              o.w0 = *(const LAS f32x4*)(OW + ofs); o.w1 = *(const LAS f32x4*)(OW + ofs + 4); o.b0 = *(const LAS f32x4*)(OB + ofs); o.b1 = *(const LAS f32x4*)(OB + ofs + 4); \
              o.k0 = *(const LAS f32x4*)(OKP + ofs); o.k1 = *(const LAS f32x4*)(OKP + ofs + 4); o.vi[0] = VL[(t) * 32 + rl]; } while (0)
#define P2(v, i) ((f32x2){v[i], v[(i) + 1]})
#define WK_STEP(o, tl) do { \
              f32x2 ac = pk_mul(S01, P2(o.nk0, 0)); ac = pk_fma(S23, P2(o.nk0, 2), ac); ac = pk_fma(S45, P2(o.nk1, 0), ac); ac = pk_fma(S67, P2(o.nk1, 2), ac); \
              f32x2 ay = pk_mul(S01, P2(o.wr0, 0)); ay = pk_fma(S23, P2(o.wr0, 2), ay); ay = pk_fma(S45, P2(o.wr1, 0), ay); ay = pk_fma(S67, P2(o.wr1, 2), ay); \
              float psa = add_asm(ac[0], ac[1]), py = add_asm(ay[0], ay[1]); \
              allred8x2_decay(psa, py, S01, S23, S45, S67, P2(o.w0, 0), P2(o.w0, 2), P2(o.w1, 0), P2(o.w1, 2)); \
              f32x2 sap; sap[0] = psa; sap[1] = 0.f; \
              S01 = pk_fma_b(P2(o.b0, 0), sap, S01); S23 = pk_fma_b(P2(o.b0, 2), sap, S23); S45 = pk_fma_b(P2(o.b1, 0), sap, S45); S67 = pk_fma_b(P2(o.b1, 2), sap, S67); \
              S01 = pk_fma_b(P2(o.k0, 0), o.vi, S01); S23 = pk_fma_b(P2(o.k0, 2), o.vi, S23); S45 = pk_fma_b(P2(o.k1, 0), o.vi, S45); S67 = pk_fma_b(P2(o.k1, 2), o.vi, S67); \
              const bool mine = (s == (tl)); sak = mine ? psa : sak; y0k = mine ? py : y0k; } while (0)
            StepOps8 A0, B0; A0.vi[1] = B0.vi[1] = 0.f;
            WK_LOAD(A0, 0);
#pragma unroll 1
            for (int tb = 0; tb < CH2; tb += 8) {
                WK_LOAD(B0, tb + 1); WK_STEP(A0, 0);
                WK_LOAD(A0, tb + 2); WK_STEP(B0, 1);
                WK_LOAD(B0, tb + 3); WK_STEP(A0, 2);
                WK_LOAD(A0, tb + 4); WK_STEP(B0, 3);
                WK_LOAD(B0, tb + 5); WK_STEP(A0, 4);
                WK_LOAD(A0, tb + 6); WK_STEP(B0, 5);
                WK_LOAD(B0, tb + 7); WK_STEP(A0, 6);
                const int tn = (tb + 8) & (CH2 - 1);
                WK_LOAD(A0, tn);     WK_STEP(B0, 7);
                { const int t = tb + s; const f32x2 sc = *(const LAS f32x2*)(SC + 2 * t); YB[t * 32 + rl] = y0k + sak * sc[0] + VL[t * 32 + rl] * sc[1]; }
            }
#undef WK_LOAD
#undef WK_STEP
#undef P2
            __syncthreads();
        }
        if (!dry) { float* so = p.out + O_WKVP + ((size_t)(b * 16 + h) * 64 + 32 * half + rl) * 64 + 8 * s; *(f32x4*)so = (f32x4){S01[0], S01[1], S23[0], S23[1]}; *(f32x4*)(so + 4) = (f32x4){S45[0], S45[1], S67[0], S67[1]}; }
    }
    __syncthreads();
}

__device__ __forceinline__ void wkv_sample(CP& p, LAS unsigned char* lds, bool dry) {
    int tid_l = threadIdx.x; asm volatile("" : "+v"(tid_l)); const int tid = tid_l, lane = tid & 63;
    const int i = tid >> 3, s8 = tid & 7;
    bf16* Z1 = (bf16*)(p.ws + WS_Z1); bf16* BON = (bf16*)(p.ws + WS_BONUS);
    LAS float* TW = (LAS float*)lds; LAS float* TA = TW + 256; LAS float* ONKK = TW + 512; LAS float* OWR = TW + 768; LAS float* OW = TW + 1024;
    LAS float* OB = TW + 1280; LAS float* OKP = TW + 1536; LAS float* VV = TW + 1792; LAS float* SC = TW + 2048; LAS float* YS = TW + 2064;
    const float* Sin = p.in[I_WKV];
    int u = blockIdx.x;
    f32x4 sa0, sa1;
    if (u < DECB * 16) { const float* sp = Sin + ((size_t)u * 64 + i) * 64 + 8 * s8; sa0 = *(const f32x4*)sp; sa1 = *(const f32x4*)(sp + 4); }
    for (; u < DECB * 16; u += gridDim.x) {
        const int b = u >> 4, h = u & 15;
        float S[8] = {sa0[0], sa0[1], sa0[2], sa0[3], sa1[0], sa1[1], sa1[2], sa1[3]};
        { const int un = u + gridDim.x; if (un < DECB * 16) { const float* sp = Sin + ((size_t)un * 64 + i) * 64 + 8 * s8; sa0 = *(const f32x4*)sp; sa1 = *(const f32x4*)(sp + 4); } }
        const int tok = tid >> 6, c = lane, C = h * 64 + c;
        const size_t rowc = (size_t)MP + 4 * b + (tok & 3), rowp = (tok & 3) == 0 ? (size_t)MT + b : rowc - 1;
        float r = 0.f, k = 0.f, v = 0.f;
        if (tid < 256) {
            const bf16* zc = Z1 + rowc * NZ1; const bf16* zp = Z1 + rowp * NZ1; const float* mu = p.in[I_MU];
            r = bf2f(zc[ZR + C]); r += mu[ZR + C] * (bf2f(zp[ZR + C]) - r);
            k = bf2f(zc[ZK + C]); k += mu[ZK + C] * (bf2f(zp[ZK + C]) - k);
            v = bf2f(zc[ZV + C]); v += mu[ZV + C] * (bf2f(zp[ZV + C]) - v);
            float wl = bf2f(zc[ZWL + c]); wl += mu[ZWL + c] * (bf2f(zp[ZWL + c]) - wl);
            float al = bf2f(zc[ZAL + c]); al += mu[ZAL + c] * (bf2f(zp[ZAL + c]) - al);
            TW[tok * 64 + c] = tanh_(wl); TA[tok * 64 + c] = al;
        }
        __syncthreads();
        if (tid < 256) {
            float wp = 0.f, ap = 0.f; const float* w2 = p.in[I_W2] + C; const float* a2 = p.in[I_A2] + C;
#pragma unroll 8
            for (int kk = 0; kk < 64; ++kk) { wp += TW[tok * 64 + kk] * w2[(size_t)kk * DM]; ap += TA[tok * 64 + kk] * a2[(size_t)kk * DM]; }
            const float dec = __expf(-0.6065306597126334f * sigm(p.in[I_W0][C] + wp));
            const float a = sigm(p.in[I_A0][C] + ap);
            const float kku = k * p.in[I_KK][C];
            const float kp = k * (1.f + (a - 1.f) * p.in[I_KA][C]);
            const float ss = wave_sum(kku * kku);
            const float kk = kku / fmaxf(sqrtf(ss), 1e-12f);
            const float bb = kk * a;
            const float br = wave_sum(bb * r), kr = wave_sum(kp * r), bon = wave_sum(r * kp * p.in[I_RK][C]);
            ONKK[tok * 64 + c] = -kk; OWR[tok * 64 + c] = dec * r; OW[tok * 64 + c] = dec; OB[tok * 64 + c] = bb; OKP[tok * 64 + c] = kp; VV[tok * 64 + c] = v;
            if (c == 0) { SC[2 * tok] = br; SC[2 * tok + 1] = kr; }
            if (!dry) BON[rowc * DM + C] = (bf16)f2bf(bon * v);
        }
        __syncthreads();
#pragma unroll
        for (int t = 0; t < 4; ++t) {
            const f32x4 n0 = *(LAS f32x4*)(ONKK + t * 64 + 8 * s8), n1 = *(LAS f32x4*)(ONKK + t * 64 + 8 * s8 + 4);
            const f32x4 q0 = *(LAS f32x4*)(OWR + t * 64 + 8 * s8), q1 = *(LAS f32x4*)(OWR + t * 64 + 8 * s8 + 4);
            const f32x4 w0 = *(LAS f32x4*)(OW + t * 64 + 8 * s8), w1 = *(LAS f32x4*)(OW + t * 64 + 8 * s8 + 4);
            const f32x4 b0 = *(LAS f32x4*)(OB + t * 64 + 8 * s8), b1 = *(LAS f32x4*)(OB + t * 64 + 8 * s8 + 4);
            const f32x4 k0 = *(LAS f32x4*)(OKP + t * 64 + 8 * s8), k1 = *(LAS f32x4*)(OKP + t * 64 + 8 * s8 + 4);
            const float vi = VV[t * 64 + i], br = SC[2 * t], kr = SC[2 * t + 1];
            float psa = 0.f, py = 0.f;
#pragma unroll
            for (int e = 0; e < 8; ++e) { psa += S[e] * (e < 4 ? n0[e & 3] : n1[e & 3]); py += S[e] * (e < 4 ? q0[e & 3] : q1[e & 3]); }
            const float sa = allred8(psa), y0 = allred8(py);
#pragma unroll
            for (int e = 0; e < 8; ++e) S[e] = S[e] * (e < 4 ? w0[e & 3] : w1[e & 3]) + sa * (e < 4 ? b0[e & 3] : b1[e & 3]) + vi * (e < 4 ? k0[e & 3] : k1[e & 3]);
            if (s8 == 0) YS[t * 64 + i] = y0 + sa * br + vi * kr;
        }
        if (!dry) { float* so = p.out + O_WKVS + ((size_t)u * 64 + i) * 64 + 8 * s8; *(f32x4*)so = (f32x4){S[0], S[1], S[2], S[3]}; *(f32x4*)(so + 4) = (f32x4){S[4], S[5], S[6], S[7]}; }
        __syncthreads();
        if (tid < 256 && !dry) Z1[rowc * NZ1 + ZV + C] = (bf16)f2bf(YS[tok * 64 + c]);
        __syncthreads();
    }
}

constexpr int LL_XR = 0, LL_UB = 8704, LL_UF = 17920, LL_PR = 26112, LL_PI = 34560, LL_CA = 43008, LL_CB = 45056, LL_HC = 47104;
__device__ __forceinline__ void lru_prompt(CP& p, LAS unsigned char* lds, int unit, bool dry) {
    int tid_l = threadIdx.x; asm volatile("" : "+v"(tid_l)); const int tid = tid_l, wave = tid >> 6, lane = tid & 63;
    const int b = unit >> 5, n = (unit >> 1) & 15, hf = unit & 1;
    const int ptok = tid >> 3, pcg = tid & 7;
    bf16* Z1 = (bf16*)(p.ws + WS_Z1);
    const bf16* waT = (const bf16*)(p.ws + WS_SMALL) + 262144; const bf16* wiT = waT + 65536;
    const size_t rowbase = (size_t)b * SEQ;
    LAS bf16* XR = (LAS bf16*)(lds + LL_XR); LAS bf16* UB = (LAS bf16*)(lds + LL_UB); LAS float* UF = (LAS float*)(lds + LL_UF);
    LAS float* PR = (LAS float*)(lds + LL_PR); LAS float* PI = (LAS float*)(lds + LL_PI); LAS float* CA = (LAS float*)(lds + LL_CA);
    LAS float* CB = (LAS float*)(lds + LL_CB); LAS float* HC = (LAS float*)(lds + LL_HC);
    if (tid < 96) ((LAS unsigned*)XR)[tid] = 0u;
    if (tid < 32) HC[tid] = 0.f;
    const int mb = wave & 3, gate = wave >> 2, fr = lane & 15, q = lane >> 4;
    bf16x8 Bf[2][2];
#pragma unroll
    for (int nb = 0; nb < 2; ++nb)
#pragma unroll
        for (int ks = 0; ks < 2; ++ks) Bf[nb][ks] = *(const bf16x8*)((gate ? wiT : waT) + (size_t)n * 4096 + (32 * hf + 16 * nb + fr) * 64 + 32 * ks + 8 * q);
    const int dl = tid & 31, sub = tid >> 5, Cs = 64 * n + 32 * hf + dl;
    const int etok = tid >> 3, dg = tid & 7, Ce = 64 * n + 32 * hf + 4 * dg;
    const f32x4 ba4 = *(const f32x4*)(p.in[I_BA] + Ce), bi4 = *(const f32x4*)(p.in[I_BI] + Ce), lam4 = *(const f32x4*)(p.in[I_LAM] + Ce);
    f32x4 sp4;
#pragma unroll
    for (int e = 0; e < 4; ++e) sp4[e] = -8.f * __logf(1.f + __expf(-lam4[e]));
    const int Cc = 64 * n + 8 * pcg;
    v4u px = *(const v4u*)(Z1 + (rowbase + ptok) * NZ1 + ZXB + Cc);
    float hlast = 0.f;
    const f32x4 cb0 = *(const f32x4*)(p.in[I_CB] + Cc), cb1 = *(const f32x4*)(p.in[I_CB] + Cc + 4);
    f32x4 cw0[4], cw1[4];
#pragma unroll
    for (int j = 0; j < 4; ++j) { cw0[j] = *(const f32x4*)(p.in[I_CW] + j * DM + Cc); cw1[j] = *(const f32x4*)(p.in[I_CW] + j * DM + Cc + 4); }
    unsigned short gbn[4];
#pragma unroll
    for (int i2 = 0; i2 < 4; ++i2) gbn[i2] = Z1[(rowbase + 4 * sub + i2) * NZ1 + ZGB + Cs];
    for (int c = 0; c < SEQ / 64; ++c) {
        if (ptok >= 61 && c > 0) *(LAS v4u*)(XR + (ptok - 61) * 64 + 8 * pcg) = *(LAS v4u*)(XR + (3 + ptok) * 64 + 8 * pcg);
        *(LAS v4u*)(XR + (3 + ptok) * 64 + 8 * pcg) = px;
        __syncthreads();
        if (c + 1 < SEQ / 64) px = *(const v4u*)(Z1 + (rowbase + (size_t)(c + 1) * 64 + ptok) * NZ1 + ZXB + Cc);
        unsigned short gbr[4];
#pragma unroll
        for (int i2 = 0; i2 < 4; ++i2) gbr[i2] = gbn[i2];
        if (c + 1 < SEQ / 64) {
#pragma unroll
            for (int i2 = 0; i2 < 4; ++i2) gbn[i2] = Z1[(rowbase + (size_t)(c + 1) * 64 + 4 * sub + i2) * NZ1 + ZGB + Cs]; }
        { float u8[8];
#pragma unroll
          for (int e = 0; e < 8; ++e) u8[e] = e < 4 ? cb0[e & 3] : cb1[e & 3];
#pragma unroll
          for (int j = 0; j < 4; ++j) { const v4u xu = *(LAS v4u*)(XR + (ptok + j) * 64 + 8 * pcg); float xf[8]; UNPACK8(xu, xf);
#pragma unroll
              for (int e = 0; e < 8; ++e) u8[e] += (e < 4 ? cw0[j][e & 3] : cw1[j][e & 3]) * xf[e]; }
          v4u w; w.x = pk2(u8[0], u8[1]); w.y = pk2(u8[2], u8[3]); w.z = pk2(u8[4], u8[5]); w.w = pk2(u8[6], u8[7]);
          *(LAS v4u*)(UB + ptok * 72 + 8 * pcg) = w;
          if ((pcg >> 2) == hf) { *(LAS f32x4*)(UF + ptok * 32 + 8 * (pcg & 3)) = (f32x4){u8[0], u8[1], u8[2], u8[3]}; *(LAS f32x4*)(UF + ptok * 32 + 8 * (pcg & 3) + 4) = (f32x4){u8[4], u8[5], u8[6], u8[7]}; }
        }
        __syncthreads();
        { const bf16x8 A0 = *(LAS bf16x8*)(UB + (16 * mb + fr) * 72 + 8 * q), A1 = *(LAS bf16x8*)(UB + (16 * mb + fr) * 72 + 32 + 8 * q);
          LAS float* P = gate ? PI : PR;
#pragma unroll
          for (int nb = 0; nb < 2; ++nb) { f32x4 acc = {0.f, 0.f, 0.f, 0.f};
              acc = __builtin_amdgcn_mfma_f32_16x16x32_bf16(A0, Bf[nb][0], acc, 0, 0, 0); acc = __builtin_amdgcn_mfma_f32_16x16x32_bf16(A1, Bf[nb][1], acc, 0, 0, 0);
#pragma unroll
              for (int r = 0; r < 4; ++r) P[(16 * mb + 4 * q + r) * 33 + 16 * nb + fr] = acc[r]; } }
        __syncthreads();
        {
#pragma unroll
          for (int e = 0; e < 4; ++e) { const int o = etok * 33 + 4 * dg + e;
              const float rg = sigm(PR[o] + ba4[e]), ig = sigm(PI[o] + bi4[e]);
              const float a = __expf(sp4[e] * rg);
              float mult = sqrtf(fmaxf(1.f - a * a, 0.f)); if (c == 0 && etok == 0) mult = 1.f;
              PR[o] = a; PI[o] = mult * ig * UF[etok * 32 + 4 * dg + e]; } }
        __syncthreads();
        { float av[4], bx[4];
#pragma unroll
          for (int i2 = 0; i2 < 4; ++i2) { av[i2] = PR[(4 * sub + i2) * 33 + dl]; bx[i2] = PI[(4 * sub + i2) * 33 + dl]; }
          float hl = 0.f, ap = 1.f;
#pragma unroll
          for (int i2 = 0; i2 < 4; ++i2) { hl = av[i2] * hl + bx[i2]; ap *= av[i2]; }
          CA[sub * 32 + dl] = ap; CB[sub * 32 + dl] = hl;
          float h = HC[dl];
          __syncthreads();
          for (int s2 = 0; s2 < sub; ++s2) h = CA[s2 * 32 + dl] * h + CB[s2 * 32 + dl];
#pragma unroll
          for (int i2 = 0; i2 < 4; ++i2) { h = av[i2] * h + bx[i2];
              if (!dry) Z1[(rowbase + (size_t)c * 64 + 4 * sub + i2) * NZ1 + ZGB + Cs] = (bf16)f2bf(h * gelu_tanh(bf2f(gbr[i2]))); }
          if (sub == 15) { HC[dl] = h; hlast = h; }
        }
        __syncthreads();
    }
    if (sub == 15 && !dry) p.out[O_LRUP + (size_t)b * DM + Cs] = hlast;
    if (hf == 0 && tid < 192 && !dry) { const int j = tid >> 6, cc = tid & 63; p.out[O_CONVP + ((size_t)b * 3 + j) * DM + 64 * n + cc] = bf2f(XR[(64 + j) * 64 + cc]); }
    __syncthreads();
}

__device__ __forceinline__ void lru_sample(CP& p, LAS unsigned char* lds, bool dry) {
    int tid_l = threadIdx.x; asm volatile("" : "+v"(tid_l)); const int tid = tid_l;
    bf16* Z1 = (bf16*)(p.ws + WS_Z1);
    LAS float* U = (LAS float*)lds;
    for (int b = blockIdx.x; b < DECB; b += gridDim.x) {
        const int C = 2 * tid, n = C >> 6, d = C & 63;
        float xp0[7], xp1[7];
#pragma unroll
        for (int j = 0; j < 3; ++j) { const f32x2 v = *(const f32x2*)(p.in[I_CONV] + ((size_t)b * 3 + j) * DM + C); xp0[j] = v[0]; xp1[j] = v[1]; }
#pragma unroll
        for (int j = 0; j < 4; ++j) { const unsigned v = *(const unsigned*)(Z1 + ((size_t)MP + 4 * b + j) * NZ1 + ZXB + C); xp0[3 + j] = lo16(v); xp1[3 + j] = hi16(v); }
        { const f32x2 cb = *(const f32x2*)(p.in[I_CB] + C); f32x2 cw[4];
#pragma unroll
          for (int j = 0; j < 4; ++j) cw[j] = *(const f32x2*)(p.in[I_CW] + j * DM + C);
#pragma unroll
          for (int t = 0; t < 4; ++t) { float u0 = cb[0], u1 = cb[1];
#pragma unroll
              for (int j = 0; j < 4; ++j) { u0 += cw[j][0] * xp0[t + j]; u1 += cw[j][1] * xp1[t + j]; }
              *(LAS f32x2*)(U + t * DM + C) = (f32x2){u0, u1}; } }
        __syncthreads();
        float pr[4][2], pi[4][2];
#pragma unroll
        for (int t = 0; t < 4; ++t) { pr[t][0] = pr[t][1] = pi[t][0] = pi[t][1] = 0.f; }
        const float* wa = p.in[I_WA] + (size_t)n * 4096 + d; const float* wi = p.in[I_WI] + (size_t)n * 4096 + d;
#pragma unroll 4
        for (int cc = 0; cc < 64; ++cc) { const f32x2 a = *(const f32x2*)(wa + cc * 64), i2 = *(const f32x2*)(wi + cc * 64);
#pragma unroll
            for (int t = 0; t < 4; ++t) { const float uu = U[t * DM + 64 * n + cc]; pr[t][0] += uu * a[0]; pr[t][1] += uu * a[1]; pi[t][0] += uu * i2[0]; pi[t][1] += uu * i2[1]; } }
        const f32x2 ba = *(const f32x2*)(p.in[I_BA] + C), bi = *(const f32x2*)(p.in[I_BI] + C), lam = *(const f32x2*)(p.in[I_LAM] + C), h0 = *(const f32x2*)(p.in[I_LRU] + (size_t)b * DM + C);
        float h[2] = {h0[0], h0[1]};
        const float sp[2] = {-8.f * __logf(1.f + __expf(-lam[0])), -8.f * __logf(1.f + __expf(-lam[1]))};
#pragma unroll
        for (int t = 0; t < 4; ++t) { const f32x2 uu = *(LAS f32x2*)(U + t * DM + C);
            bf16* zp = Z1 + ((size_t)MP + 4 * b + t) * NZ1 + ZGB + C; const unsigned g = *(const unsigned*)zp; float yb[2];
#pragma unroll
            for (int e = 0; e < 2; ++e) { const float rg = sigm(pr[t][e] + ba[e]), ig = sigm(pi[t][e] + bi[e]); const float a = __expf(sp[e] * rg);
                const float mult = sqrtf(fmaxf(1.f - a * a, 0.f)); h[e] = a * h[e] + mult * ig * uu[e]; yb[e] = h[e] * gelu_tanh(e ? hi16(g) : lo16(g)); }
            if (!dry) *(unsigned*)zp = pk2(yb[0], yb[1]); }
        if (!dry) *(f32x2*)(p.out + O_LRUS + (size_t)b * DM + C) = (f32x2){h[0], h[1]};
#pragma unroll
        for (int j = 0; j < 3; ++j) if (!dry) *(f32x2*)(p.out + O_CONVS + ((size_t)b * 3 + j) * DM + C) = (f32x2){xp0[4 + j], xp1[4 + j]};
        __syncthreads();
    }
}

__device__ __forceinline__ void phase_merge(CP& p, LAS unsigned char* lds) {
    int tid_l = threadIdx.x; asm volatile("" : "+v"(tid_l)); const int tid = tid_l, wave = tid >> 6, lane = tid & 63, fr = lane & 15, q = lane >> 4;
    const bf16* Z1 = (const bf16*)(p.ws + WS_Z1); const bf16* BON = (const bf16*)(p.ws + WS_BONUS); const bf16* Zg = (const bf16*)p.out;
    const bf16* g2T = (const bf16*)(p.ws + WS_SMALL) + 131072; bf16* MG = (bf16*)(p.ws + WS_XB);
    LAS float* GL = (LAS float*)lds;
    const int tk = tid >> 7, cg8 = tid & 127, Cm = 8 * cg8;
    const f32x4 lg0 = *(const f32x4*)(p.in[I_LNXG] + Cm), lg1 = *(const f32x4*)(p.in[I_LNXG] + Cm + 4), lb0 = *(const f32x4*)(p.in[I_LNXB] + Cm), lb1 = *(const f32x4*)(p.in[I_LNXB] + Cm + 4);
    for (int unit = blockIdx.x; unit < MT / 16; unit += gridDim.x) {
        const int m0 = unit * 16;
        {
          const int m = m0 + fr; size_t prow; bool pz = false;
          if (m < MP) { if ((m & (SEQ - 1)) == 0) { pz = true; prow = m; } else prow = m - 1; } else { const int ms = m - MP; prow = (ms & 3) == 0 ? (size_t)MT + (ms >> 2) : (size_t)m - 1; }
          bf16x8 Tf[4];
#pragma unroll
          for (int ks = 0; ks < 4; ++ks) { const int ko = 32 * ks + 8 * q;
              const v4u cu = *(const v4u*)(Z1 + (size_t)m * NZ1 + ZGL + ko); v4u pu = *(const v4u*)(Z1 + prow * NZ1 + ZGL + ko); if (pz) pu = (v4u){0u, 0u, 0u, 0u};
              float cf[8], pf[8]; UNPACK8(cu, cf); UNPACK8(pu, pf);
              const f32x4 mu0 = *(const f32x4*)(p.in[I_MU] + ZGL + ko), mu1 = *(const f32x4*)(p.in[I_MU] + ZGL + ko + 4); float o[8];
#pragma unroll
              for (int e = 0; e < 8; ++e) o[e] = sigm(cf[e] + (e < 4 ? mu0[e & 3] : mu1[e & 3]) * (pf[e] - cf[e]));
              v4u w; w.x = pk2(o[0], o[1]); w.y = pk2(o[2], o[3]); w.z = pk2(o[4], o[5]); w.w = pk2(o[6], o[7]); Tf[ks] = __builtin_bit_cast(bf16x8, w); }
#pragma unroll 2
          for (int nbi = 0; nbi < 8; ++nbi) { const int nb = wave * 8 + nbi; f32x4 acc = {0.f, 0.f, 0.f, 0.f};
#pragma unroll
              for (int ks = 0; ks < 4; ++ks) { const bf16x8 gf = *(const bf16x8*)(g2T + (size_t)(16 * nb + fr) * 128 + 32 * ks + 8 * q); acc = __builtin_amdgcn_mfma_f32_16x16x32_bf16(gf, Tf[ks], acc, 0, 0, 0); }
              *(LAS f32x4*)(GL + fr * 1028 + 16 * nb + 4 * q) = acc; }
        }
        __syncthreads();
#pragma unroll 1
        for (int ps = 0; ps < 4; ++ps) {
            const int tok = 4 * ps + tk; const size_t m = (size_t)m0 + tok;
            const v4u yu = *(const v4u*)(Z1 + m * NZ1 + ZV + Cm), bu = *(const v4u*)(BON + m * DM + Cm), ybu = *(const v4u*)(Z1 + m * NZ1 + ZGB + Cm);
            const v4u gau = *(const v4u*)(Zg + m * 2048 + Cm), gbu = *(const v4u*)(Zg + m * 2048 + 1024 + Cm);
            const f32x4 g0 = *(LAS f32x4*)(GL + tok * 1028 + Cm), g1 = *(LAS f32x4*)(GL + tok * 1028 + Cm + 4);
            float y[8], bo[8], yb[8], ga[8], gb[8]; UNPACK8(yu, y); UNPACK8(bu, bo); UNPACK8(ybu, yb); UNPACK8(gau, ga); UNPACK8(gbu, gb);
            float sm = 0.f;
#pragma unroll
            for (int e = 0; e < 8; ++e) sm += y[e];
            const float mean = allred8(sm) * (1.f / 64.f); float sq = 0.f;
#pragma unroll
            for (int e = 0; e < 8; ++e) { y[e] -= mean; sq += y[e] * y[e]; }
            const float rstd = __builtin_amdgcn_rsqf(allred8(sq) * (1.f / 64.f) + GN_EPS);
            float o[8];
#pragma unroll
            for (int e = 0; e < 8; ++e) { const float yn = y[e] * rstd * (e < 4 ? lg0[e & 3] : lg1[e & 3]) + (e < 4 ? lb0[e & 3] : lb1[e & 3]);
                const float yA = (yn + bo[e]) * (e < 4 ? g0[e & 3] : g1[e & 3]); o[e] = sigm(ga[e]) * yA + sigm(gb[e]) * yb[e]; }
            v4u w; w.x = pk2(o[0], o[1]); w.y = pk2(o[2], o[3]); w.z = pk2(o[4], o[5]); w.w = pk2(o[6], o[7]);
            *(v4u*)(MG + m * DM + Cm) = w;
        }
        __syncthreads();
    }
}


__device__ __forceinline__ void mini_gemm_tail(LAS unsigned char* lds, const bf16* A, int lda, const bf16* Bt, int K, const float* res, float* out) {
    int tid_l = threadIdx.x; asm volatile("" : "+v"(tid_l)); const int tid = tid_l, wave = tid >> 6, lane = tid & 63, fr = lane & 15, q = lane >> 4;
    LAS float* RED = (LAS float*)lds;
    for (int task = blockIdx.x; task < 256; task += gridDim.x) {
        const int row0 = MP + 32 * (task >> 4), col0 = 64 * (task & 15);
        const int kw = K >> 3, kb = wave * kw;
        f32x4 acc[2][4];
#pragma unroll
        for (int mb = 0; mb < 2; ++mb)
#pragma unroll
            for (int nb = 0; nb < 4; ++nb) acc[mb][nb] = (f32x4){0.f, 0.f, 0.f, 0.f};
        const bf16* ap = A + (size_t)(row0 + fr) * lda + kb + 8 * q; const bf16* bp = Bt + (size_t)(col0 + fr) * K + kb + 8 * q;
#pragma unroll 2
        for (int k0 = 0; k0 < kw; k0 += 32) {
            bf16x8 af[2], bf[4];
#pragma unroll
            for (int mb = 0; mb < 2; ++mb) af[mb] = *(const bf16x8*)(ap + (size_t)(16 * mb) * lda + k0);
#pragma unroll
            for (int nb = 0; nb < 4; ++nb) bf[nb] = *(const bf16x8*)(bp + (size_t)(16 * nb) * K + k0);
#pragma unroll
            for (int mb = 0; mb < 2; ++mb)
#pragma unroll
                for (int nb = 0; nb < 4; ++nb) acc[mb][nb] = __builtin_amdgcn_mfma_f32_16x16x32_bf16(bf[nb], af[mb], acc[mb][nb], 0, 0, 0);
        }
#pragma unroll
        for (int mb = 0; mb < 2; ++mb)
#pragma unroll
            for (int nb = 0; nb < 4; ++nb) *(LAS f32x4*)(RED + wave * 2048 + (16 * mb + fr) * 64 + 16 * nb + 4 * q) = acc[mb][nb];
        __syncthreads();
        { const int r = tid >> 4, c4 = (tid & 15) * 4; f32x4 sum = *(LAS f32x4*)(RED + r * 64 + c4);
#pragma unroll
          for (int w = 1; w < 8; ++w) sum += *(LAS f32x4*)(RED + w * 2048 + r * 64 + c4);
          const size_t o = (size_t)(row0 + r) * DM + col0 + c4; const f32x4 x = *(const f32x4*)(res + o);
          *(f32x4*)(out + o) = sum + x * ALPHA; }
        __syncthreads();
    }
}

template <bool FINAL> __device__ __forceinline__ void phase_ln(CP& p, const float* g, const float* bb) {
    int tid_l = threadIdx.x; asm volatile("" : "+v"(tid_l)); const int tid = tid_l, wave = tid >> 6, lane = tid & 63;
    float* H1 = (float*)(p.ws + WS_H1); bf16* H1B = (bf16*)(p.ws + WS_H1B);
    f32x4 gv[4], bv[4];
#pragma unroll
    for (int j = 0; j < 4; ++j) { gv[j] = *(const f32x4*)(g + 4 * lane + 256 * j); bv[j] = *(const f32x4*)(bb + 4 * lane + 256 * j); }
    for (int m = blockIdx.x * 8 + wave; m < MT; m += gridDim.x * 8) {
        float* xr = H1 + (size_t)m * DM + 4 * lane; f32x4 v[4]; float s = 0.f;
#pragma unroll
        for (int j = 0; j < 4; ++j) { v[j] = *(const f32x4*)(xr + 256 * j); s += (v[j][0] + v[j][1]) + (v[j][2] + v[j][3]); }
        const float mean = wave_sum(s) * (1.f / DM); float s2 = 0.f;
#pragma unroll
        for (int j = 0; j < 4; ++j) { v[j] = v[j] - mean; s2 += (v[j][0] * v[j][0] + v[j][1] * v[j][1]) + (v[j][2] * v[j][2] + v[j][3] * v[j][3]); }
        const float rstd = 1.f / sqrtf(wave_sum(s2) * (1.f / DM) + LN_EPS);
#pragma unroll
        for (int j = 0; j < 4; ++j) { v[j] = v[j] * rstd * gv[j] + bv[j];
            if (FINAL) *(f32x4*)(p.out + O_Y + (size_t)m * DM + 4 * lane + 256 * j) = v[j];
            else { *(f32x4*)(xr + 256 * j) = v[j]; *(v2u*)(H1B + (size_t)m * DM + 4 * lane + 256 * j) = (v2u){pk2(v[j][0], v[j][1]), pk2(v[j][2], v[j][3])}; } }
    }
}

__global__ void __launch_bounds__(512, 2) hybrid_step_kernel(Params p_unused) {
    CP* pp = (CP*)__builtin_amdgcn_kernarg_segment_ptr();
#define p (*launder(pp))
    extern __shared__ __attribute__((aligned(16))) unsigned char lds_raw[];
    LAS unsigned char* lds = (LAS unsigned char*)lds_raw;
    volatile LAS unsigned* MISC = (volatile LAS unsigned*)(lds + MISC_OFF);
    if (threadIdx.x < 16) MISC[threadIdx.x] = 0u;
    __syncthreads();
    XcdBarrier bar = xcd_barrier_post((unsigned*)(p.ws + WS_CTL) + CW_BAR, MISC + 8);
    if (p.never) cg::this_grid().sync();
    const int G = gridDim.x, bx = blockIdx.x;

    phase0(p, lds);

#ifdef PROBE_INSTR
    { float x0 = threadIdx.x, x1 = x0 + 1.f, x2 = x0 + 2.f, x3 = x0 + 3.f, x4 = x0 + 4.f, x5 = x0 + 5.f, x6 = x0 + 6.f, x7 = x0 + 7.f; const float kf = 0.999f; const unsigned hh = 0x3c003c00u; f32x2 kp = {0.999f, 0.998f}; f32x2 x0p = {x0, x1}, x1p = {x1, x2}, x2p = {x2, x3}, x3p = {x3, x4}, x4p = {x4, x5}, x5p = {x5, x6}, x6p = {x6, x7}, x7p = {x7, x0};
      const int nit = (p.never == 0 ? 20000 : 1);
      for (int it = 0; it < nit; ++it) {
#if PROBE_INSTR == 1
#define PI(x) asm volatile("v_fma_f32 %0, %0, %1, %0" : "+v"(x) : "v"(kf))
#elif PROBE_INSTR == 2
#define PI(x) asm volatile("v_fma_mix_f32 %0, %1, %0, %0 op_sel_hi:[1,0,0]" : "+v"(x) : "v"(hh))
#elif PROBE_INSTR == 3
#define PI(x) asm volatile("v_add_f32_dpp %0, %0, %0 quad_perm:[1,0,3,2] row_mask:0xf bank_mask:0xf bound_ctrl:1" : "+v"(x))
#elif PROBE_INSTR == 4
#define PI(x) asm volatile("v_pk_fma_f32 %0, %0, %1, %0" : "+v"(x##p) : "v"(kp))

#endif
#if PROBE_INSTR == 4
          static_assert(true, "");
#endif
          PI(x0); PI(x1); PI(x2); PI(x3); PI(x4); PI(x5); PI(x6); PI(x7);
      }
      x0 += x0p[0] + x1p[1] + x2p[0] + x3p[1] + x4p[0] + x5p[1] + x6p[0] + x7p[1];
      if (x0 + x1 + x2 + x3 + x4 + x5 + x6 + x7 == 123.456f) ((float*)(p.ws + WS_CTL))[20000] = x0; }
#endif
    xcd_barrier(bar);
    { pg8::Gemm g{(const pg8::bf16_t*)(p.ws + WS_XB), (const pg8::bf16_t*)(p.ws + WS_WINT), MPAD, NIN, 1024}; pg8::StaticOrder S; S.init(MPAD, NIN, G, bx);
      EpiZ E{(bf16*)(p.ws + WS_Z1), (bf16*)p.out};
      pg8::gemm_phase<EpiZ, pg8::StaticOrder, true, true>(lds, g, S, E); }
    xcd_barrier(bar);
#ifdef PROBE_WKVP
    for (int u = bx; u < 256; u += G) wkv_prompt2(p, lds, u, p.never == 0);
#endif
    for (int u = bx; u < 256; u += G) wkv_prompt2(p, lds, u, p.never != 0);
#ifdef PROBE_WKVS
    wkv_sample(p, lds, p.never == 0);
#endif
    wkv_sample(p, lds, p.never != 0);
#ifdef PROBE_LRUP
    for (int u = bx; u < 256; u += G) lru_prompt(p, lds, u, p.never == 0);
#endif
    for (int u = bx; u < 256; u += G) lru_prompt(p, lds, u, p.never != 0);
#ifdef PROBE_LRUS
    lru_sample(p, lds, p.never == 0);
#endif
    lru_sample(p, lds, p.never != 0);
    xcd_barrier(bar);
    phase_merge(p, lds);
    xcd_barrier(bar);
    phase_convert_ffn(p, lds);
    __syncthreads();
    { pg8::Gemm g{(const pg8::bf16_t*)(p.ws + WS_XB), (const pg8::bf16_t*)(p.ws + WS_WOT), MP, 1024, 1024}; pg8::StaticOrder S; S.init(MP, 1024, G, bx);
      EpiRes E{p.in[I_XP], p.in[I_XS], (float*)(p.ws + WS_H1)};
      pg8::gemm_phase<EpiRes, pg8::StaticOrder, true, true>(lds, g, S, E); }
    __syncthreads();
    mini_gemm_tail(lds, (const bf16*)(p.ws + WS_XB), 1024, (const bf16*)(p.ws + WS_WOT), 1024, p.in[I_XS] - (size_t)MP * DM, (float*)(p.ws + WS_H1));
    xcd_barrier(bar);
    phase_ln<false>(p, p.in[I_LN1G], p.in[I_LN1B]);
    xcd_barrier(bar);
    { pg8::Gemm g{(const pg8::bf16_t*)(p.ws + WS_H1B), (const pg8::bf16_t*)(p.ws + WS_WGUT), MT, 2 * DFF, 1024}; pg8::StaticOrder S; S.init(MT, 2 * DFF, G, bx);
      EpiSwi E{(bf16*)(p.ws + WS_ACT)};
      pg8::gemm_phase<EpiSwi, pg8::StaticOrder, true, true>(lds, g, S, E); }
    xcd_barrier(bar);
    { pg8::Gemm g{(const pg8::bf16_t*)(p.ws + WS_ACT), (const pg8::bf16_t*)(p.ws + WS_WDT), MP, 1024, DFF}; pg8::StaticOrder S; S.init(MP, 1024, G, bx);
      const float* h1 = (const float*)(p.ws + WS_H1);
      EpiRes E{h1, h1 + (size_t)MP * DM, (float*)(p.ws + WS_H1)};
      pg8::gemm_phase<EpiRes, pg8::StaticOrder, true, true>(lds, g, S, E); }
    __syncthreads();
    mini_gemm_tail(lds, (const bf16*)(p.ws + WS_ACT), DFF, (const bf16*)(p.ws + WS_WDT), DFF, (const float*)(p.ws + WS_H1), (float*)(p.ws + WS_H1));
    xcd_barrier(bar);
    phase_ln<true>(p, p.in[I_LN2G], p.in[I_LN2B]);
#undef p
}

extern "C" void kernel_launch(void* const* d_in, const int* in_sizes, int n_in, void* d_out, int out_size, void* d_ws, size_t ws_size, hipStream_t stream) {
    static int grid = 0;
    if (grid == 0) {
        int dev = 0, cus = 0, per_cu = 0;
        if (n_in != 33 || ws_size < 256 * MiB) { fprintf(stderr, "kernel_launch: unexpected n_in %d / ws %zu\n", n_in, ws_size); grid = -1; return; }
        hipGetDevice(&dev); hipDeviceGetAttribute(&cus, hipDeviceAttributeMultiprocessorCount, dev);
        if (hipFuncSetAttribute((const void*)hybrid_step_kernel, hipFuncAttributeMaxDynamicSharedMemorySize, LDS_BYTES) != hipSuccess) { fprintf(stderr, "kernel_launch: hipFuncSetAttribute failed\n"); grid = -1; return; }
        if (hipOccupancyMaxActiveBlocksPerMultiprocessor(&per_cu, (const void*)hybrid_step_kernel, 512, LDS_BYTES) != hipSuccess || per_cu < 1) { fprintf(stderr, "kernel_launch: occupancy query says %d blocks per CU\n", per_cu); }
        (void)hipGetLastError();
        grid = cus;
    }
    if (grid < 0) return;
    (void)hipMemsetAsync((char*)d_ws + WS_CTL, 0, CTL_ZERO_BYTES, stream);
    Params p{};
    for (int i = 0; i < 33; ++i) p.in[i] = (const float*)d_in[i];
    p.out = (float*)d_out; p.ws = (unsigned char*)d_ws; p.never = 0; p.pad = 0;
    void* args[] = {&p};
    hipError_t e = hipLaunchCooperativeKernel((const void*)hybrid_step_kernel, dim3(grid), dim3(512), args, LDS_BYTES, stream);
    if (e != hipSuccess) fprintf(stderr, "kernel_launch: cooperative launch failed: %s (grid %d)\n", hipGetErrorString(e), grid);
}
```

```cpp
#include <hip/hip_runtime.h>
#include <hip/hip_cooperative_groups.h>
#include <cstdio>
#include <cstdint>
namespace pg8 {
#define PG8_LAS __attribute__((address_space(3)))
typedef unsigned short bf16_t;
typedef short bf16x8 __attribute__((ext_vector_type(8)));
typedef float f32x4 __attribute__((ext_vector_type(4)));
typedef unsigned u32x4 __attribute__((ext_vector_type(4)));
constexpr int BM = 256, BK = 64, HALF = 128, HTB = HALF * BK * 2  , STAGE_BYTES = 8 * HTB, NXCD = 8, WGM = 8;

__host__ __device__ __forceinline__ int lds_byte(int r, int c) { const int st = (r >> 4) * 2 + (c >> 5), rr = r & 15, cc = c & 31, ob = rr * 64 + cc * 2; return st * 1024 + (ob ^ (((ob >> 9) & 1) << 5)); }
__host__ __device__ __forceinline__ void stage_rc(int b, int& R, int& C) { const int st = b / 1024, sb = b % 1024, swz = sb ^ (((sb >> 9) & 1) << 5); R = (st >> 1) * 16 + swz / 64; C = (st & 1) * 32 + (swz % 64) / 2; }
__host__ __device__ __forceinline__ int perm32(int rho) { const int n = rho >> 4, i = rho & 15; return 8 * (i >> 2) + 4 * n + (i & 3); }

struct Unit { int pm, pn; };
struct Gemm { const bf16_t* A; const bf16_t* Bt; int M, N, K; };

struct StaticOrder {
    int nM, nN, nwg, G, c;
    __host__ __device__ void init(int M, int N, int G_, int c_) { nM = M / BM; nN = N / BM; nwg = nM * nN; G = G_; c = c_; }
    __host__ __device__ bool next(int i, Unit& u) const {
        const long L = (long)i * G + c; if (L >= nwg) return false;
        int wgid = (int)L; { const int q = nwg / NXCD, r = nwg % NXCD, xcd = wgid % NXCD, off = wgid / NXCD; wgid = (xcd < r ? xcd * (q + 1) : r * (q + 1) + (xcd - r) * q) + off; }
        const int nig = WGM * nN, gid = wgid / nig, fm = gid * WGM, gsz = (nM - fm) < WGM ? (nM - fm) : WGM;
        u.pm = fm + ((wgid % nig) % gsz); u.pn = (wgid % nig) / gsz; return true;
    }
    __device__ __forceinline__ void a_ready(const Unit&) const {}
    __device__ __forceinline__ void done(const Unit&) const {}
};

__device__ __forceinline__ unsigned cvt_pk_bf16(float lo, float hi) { unsigned r; asm volatile("v_cvt_pk_bf16_f32 %0, %1, %2" : "=v"(r) : "v"(lo), "v"(hi)); return r; }
typedef float f32x2 __attribute__((ext_vector_type(2)));
__device__ __forceinline__ f32x2 gelu_pk(f32x2 v) {
    const f32x2 av = __builtin_elementwise_abs(v), d = av * 0.2316418882f + 1.0f;
    f32x2 t; t.x = __builtin_amdgcn_rcpf(d.x); t.y = __builtin_amdgcn_rcpf(d.y);
    f32x2 q = t * 0.5307027145f + (-0.7265760135f); q = q * t + 0.7107068705f; q = q * t + (-0.142248368f); q = q * t + 0.127414796f; q = q * t;
    const f32x2 s = (v * v) * (-0.72134752044f);
    f32x2 e; e.x = __builtin_amdgcn_exp2f(s.x); e.y = __builtin_amdgcn_exp2f(s.y);
    const f32x2 m = v * (q * e), r = v - m;
    f32x2 o; o.x = v.x < 0.f ? m.x : r.x; o.y = v.y < 0.f ? m.y : r.y; return o;
}

template <int ACT  > struct EpiBf16 {
    static constexpr bool PERM = true, AFTER_DRAIN = false; static_assert(ACT == 0 || ACT == 1, "EpiBf16: ACT is 0 (none) or 1 (gelu_pk)");
    bf16_t* O; int ldc; const float* bias; int split_cols; size_t split_stride; float scale0;
    __device__ __forceinline__ void operator()(const f32x4 (&acc)[2][2][4][2], const Unit& u, int wr, int wc, int fr, int fq) const {
        const int row0 = u.pm * BM + wr * 64 + fr; int colt = u.pn * BM; bf16_t* base = O;
        float sc = 1.f; if (split_cols) { const int t = colt / split_cols; base += (size_t)t * split_stride; colt -= t * split_cols; if (t == 0) sc = scale0; }
        const int col0 = colt + wc * 32 + 8 * fq, bcol0 = u.pn * BM + wc * 32 + 8 * fq;
        f32x4 bv[2][2];
#pragma unroll
        for (int bj = 0; bj < 2; ++bj)
#pragma unroll
            for (int n = 0; n < 2; ++n) bv[bj][n] = bias ? *(const f32x4*)(bias + bcol0 + bj * HALF + 4 * n) : (f32x4){0.f, 0.f, 0.f, 0.f};
#pragma unroll
        for (int ai = 0; ai < 2; ++ai)
#pragma unroll
            for (int m = 0; m < 4; ++m) { bf16_t* rowp = base + (size_t)(row0 + ai * HALF + m * 16) * ldc + col0;
#pragma unroll
                for (int bj = 0; bj < 2; ++bj) { f32x4 v0 = acc[ai][bj][m][0] + bv[bj][0], v1 = acc[ai][bj][m][1] + bv[bj][1];
                    if (ACT == 1) { f32x2 a = gelu_pk((f32x2){v0[0], v0[1]}), b = gelu_pk((f32x2){v0[2], v0[3]}), c = gelu_pk((f32x2){v1[0], v1[1]}), d = gelu_pk((f32x2){v1[2], v1[3]});
                        v0 = (f32x4){a.x, a.y, b.x, b.y}; v1 = (f32x4){c.x, c.y, d.x, d.y}; }
                    v0 = v0 * sc; v1 = v1 * sc; u32x4 w; w.x = cvt_pk_bf16(v0[0], v0[1]); w.y = cvt_pk_bf16(v0[2], v0[3]); w.z = cvt_pk_bf16(v1[0], v1[1]); w.w = cvt_pk_bf16(v1[2], v1[3]);
                    *(u32x4*)(rowp + bj * HALF) = w; } }
    }
};
template <class Epi, class Sched, bool ALIGN_EPI = false, bool SP2 = false>
__device__ __forceinline__ void gemm_phase(PG8_LAS unsigned char* lds, const Gemm g, const Sched& S, const Epi& E) {
    const int tid = threadIdx.x, wid = __builtin_amdgcn_readfirstlane(tid >> 6), lane = tid & 63, wr = wid >> 2, wc = wid & 3, fr = lane & 15, fq = lane >> 4;
    const int K = g.K, nt = K / BK;
    unsigned voffA[2], voffB[2];
#pragma unroll
    for (int i = 0; i < 2; ++i) { int R, C; stage_rc(tid * 16 + i * 8192, R, C); const int Rb = Epi::PERM ? ((R & ~31) + perm32(R & 31)) : R;
        voffA[i] = (unsigned)(R * K + C) * 2u; voffB[i] = (unsigned)(Rb * K + C) * 2u; }
    const size_t kstep = (size_t)(BK * 2);
    const size_t hstep = (size_t)HALF * K * 2;
    const size_t tstep = 2 * hstep;
    const unsigned ldsw = (unsigned)wid * 1024u;
    const int aoff = lds_byte(wr * 64 + fr, fq * 8), boff = lds_byte(wc * 32 + fr, fq * 8);
#define PG8_SA(b, h) (((b) * 2 + (h)) * HTB)
#define PG8_SB(b, h) ((4 + (b) * 2 + (h)) * HTB)
#define PG8_STAGE(bufoff, gbase, voff) do { _Pragma("unroll") for (int _i = 0; _i < 2; ++_i) \
        __builtin_amdgcn_global_load_lds((const unsigned*)((const char*)(gbase) + (voff)[_i]), (PG8_LAS unsigned*)(lds + (bufoff) + ldsw + _i * 8192), 16, 0, 0); } while (0)
#define PG8_LDA(dst, b, h) do { _Pragma("unroll") for (int m = 0; m < 4; ++m) _Pragma("unroll") for (int k = 0; k < 2; ++k) dst[m][k] = *(const PG8_LAS bf16x8*)(lds + PG8_SA(b, h) + aoff + m * 2048 + k * 1024); } while (0)
#define PG8_LDB(dst, b, h) do { _Pragma("unroll") for (int n = 0; n < 2; ++n) _Pragma("unroll") for (int k = 0; k < 2; ++k) dst[n][k] = *(const PG8_LAS bf16x8*)(lds + PG8_SB(b, h) + boff + n * 2048 + k * 1024); } while (0)
#define PG8_MMA(ai, bj, At, Bt) do { __builtin_amdgcn_s_setprio(1); _Pragma("unroll") for (int m = 0; m < 4; ++m) _Pragma("unroll") for (int n = 0; n < 2; ++n) _Pragma("unroll") for (int k = 0; k < 2; ++k) \
        acc[ai][bj][m][n] = __builtin_amdgcn_mfma_f32_16x16x32_bf16(Bt[n][k], At[m][k], acc[ai][bj][m][n], 0, 0, 0); __builtin_amdgcn_s_setprio(0); } while (0)
#define PG8_WAIT_V(n) asm volatile("s_waitcnt vmcnt(" #n ")" ::: "memory")
#define PG8_WAIT_L(n) asm volatile("s_waitcnt lgkmcnt(" #n ")" ::: "memory")
#define PG8_BAR __builtin_amdgcn_s_barrier()
#define PG8_SCHED __builtin_amdgcn_sched_barrier(0)
    Unit cur, nxt; int ui = 0;
    if (!S.next(0, cur)) return;
    f32x4 acc[2][2][4][2];
#pragma unroll
    for (int a = 0; a < 2; ++a)
#pragma unroll
        for (int b = 0; b < 2; ++b)
#pragma unroll
            for (int m = 0; m < 4; ++m)
#pragma unroll
                for (int n = 0; n < 2; ++n) acc[a][b][m][n] = (f32x4){0.f, 0.f, 0.f, 0.f};
    bf16x8 At[4][2], B0[2][2], B1[2][2];
    const char* cA = (const char*)g.A + (size_t)cur.pm * tstep; const char* cB = (const char*)g.Bt + (size_t)cur.pn * tstep;
    S.a_ready(cur);
    if constexpr (SP2) {
        PG8_STAGE(PG8_SB(0, 0), cB, voffB); PG8_STAGE(PG8_SB(0, 1), cB + hstep, voffB); PG8_STAGE(PG8_SA(0, 0), cA, voffA); PG8_STAGE(PG8_SA(0, 1), cA + hstep, voffA);
        if (wr == 1) PG8_BAR;
        PG8_WAIT_V(2); PG8_BAR;
        PG8_STAGE(PG8_SB(1, 0), cB + kstep, voffB); PG8_STAGE(PG8_SA(1, 0), cA + kstep, voffA); PG8_STAGE(PG8_SB(1, 1), cB + hstep + kstep, voffB);
        PG8_WAIT_V(6); PG8_BAR;
    } else {
        PG8_STAGE(PG8_SB(0, 0), cB, voffB); PG8_STAGE(PG8_SA(0, 0), cA, voffA); PG8_STAGE(PG8_SB(0, 1), cB + hstep, voffB); PG8_STAGE(PG8_SA(0, 1), cA + hstep, voffA);
        if (wr == 1) PG8_BAR;
        PG8_WAIT_V(4); PG8_BAR;
        PG8_STAGE(PG8_SB(1, 0), cB + kstep, voffB); PG8_STAGE(PG8_SA(1, 0), cA + kstep, voffA); PG8_STAGE(PG8_SB(1, 1), cB + hstep + kstep, voffB);
        PG8_WAIT_V(6); PG8_BAR;
    }
    for (;;) {
        const bool has_next = S.next(ui + 1, nxt);
        const char* nA = has_next ? (const char*)g.A + (size_t)nxt.pm * tstep : cA; const char* nB = has_next ? (const char*)g.Bt + (size_t)nxt.pn * tstep : cB;
        for (int t = 0; t < nt; t += 2) {
            const bool last = (t == nt - 2);
            const char* a1 = cA + (size_t)(t + 1) * kstep;
            const char* a2 = last ? nA : cA + (size_t)(t + 2) * kstep; const char* b2 = last ? nB : cB + (size_t)(t + 2) * kstep;
            const char* a3 = a2 + kstep; const char* b3 = b2 + kstep;
            if (last && has_next) S.a_ready(nxt);
            if constexpr (SP2) {
            PG8_LDB(B0, 0, 0); PG8_LDB(B1, 0, 1); PG8_SCHED; PG8_LDA(At, 0, 0); PG8_STAGE(PG8_SA(1, 1), a1 + hstep, voffA);
            PG8_WAIT_V(8); PG8_WAIT_L(0); PG8_BAR; PG8_MMA(0, 0, At, B0); PG8_MMA(0, 1, At, B1); PG8_BAR; PG8_SCHED;
            PG8_LDA(At, 0, 1); PG8_STAGE(PG8_SB(0, 0), b2, voffB); PG8_STAGE(PG8_SB(0, 1), b2 + hstep, voffB); PG8_STAGE(PG8_SA(0, 0), a2, voffA);
            PG8_WAIT_V(8); PG8_WAIT_L(0); PG8_BAR; PG8_MMA(1, 0, At, B0); PG8_MMA(1, 1, At, B1); PG8_BAR; PG8_SCHED;
            PG8_LDB(B0, 1, 0); PG8_LDB(B1, 1, 1); PG8_SCHED; PG8_LDA(At, 1, 0); PG8_STAGE(PG8_SA(0, 1), a2 + hstep, voffA);
            PG8_WAIT_V(8); PG8_WAIT_L(0); PG8_BAR; PG8_MMA(0, 0, At, B0); PG8_MMA(0, 1, At, B1); PG8_BAR; PG8_SCHED;
            PG8_LDA(At, 1, 1); PG8_STAGE(PG8_SB(1, 0), b3, voffB); PG8_STAGE(PG8_SB(1, 1), b3 + hstep, voffB); PG8_STAGE(PG8_SA(1, 0), a3, voffA);
            PG8_WAIT_V(8); PG8_WAIT_L(0); PG8_BAR; PG8_MMA(1, 0, At, B0); PG8_MMA(1, 1, At, B1); PG8_BAR; PG8_SCHED;
            } else {
            PG8_LDB(B0, 0, 0); PG8_SCHED; PG8_LDA(At, 0, 0); PG8_STAGE(PG8_SA(1, 1), a1 + hstep, voffA);
            PG8_WAIT_L(8); PG8_BAR; PG8_WAIT_L(0); PG8_MMA(0, 0, At, B0); PG8_BAR; PG8_SCHED;
            PG8_LDB(B1, 0, 1); PG8_STAGE(PG8_SB(0, 0), b2, voffB);
            PG8_BAR; PG8_WAIT_L(0); PG8_MMA(0, 1, At, B1); PG8_BAR;
            PG8_LDA(At, 0, 1); PG8_STAGE(PG8_SA(0, 0), a2, voffA);
            PG8_BAR; PG8_WAIT_L(0); PG8_MMA(1, 0, At, B0); PG8_BAR; PG8_SCHED;
            PG8_STAGE(PG8_SB(0, 1), b2 + hstep, voffB);
            PG8_WAIT_V(6); PG8_BAR; PG8_MMA(1, 1, At, B1); PG8_BAR;
            PG8_LDB(B0, 1, 0); PG8_SCHED; PG8_LDA(At, 1, 0); PG8_STAGE(PG8_SA(0, 1), a2 + hstep, voffA);
            PG8_WAIT_L(8); PG8_BAR; PG8_WAIT_L(0); PG8_MMA(0, 0, At, B0); PG8_BAR; PG8_SCHED;
            PG8_LDB(B1, 1, 1); PG8_STAGE(PG8_SB(1, 0), b3, voffB);
            PG8_BAR; PG8_WAIT_L(0); PG8_MMA(0, 1, At, B1); PG8_BAR;
            PG8_LDA(At, 1, 1); PG8_STAGE(PG8_SA(1, 0), a3, voffA);
            PG8_BAR; PG8_WAIT_L(0); PG8_MMA(1, 0, At, B0); PG8_BAR; PG8_SCHED;
            PG8_STAGE(PG8_SB(1, 1), b3 + hstep, voffB);
            PG8_WAIT_V(6); PG8_BAR; PG8_MMA(1, 1, At, B1); PG8_BAR;
            }
        }
        if constexpr (ALIGN_EPI) { if (wr == 0) PG8_BAR; }
        if constexpr (!Epi::AFTER_DRAIN) { E(acc, cur, wr, wc, fr, fq); S.done(cur); }
        if (!has_next) break;
#pragma unroll
        for (int a = 0; a < 2; ++a)
#pragma unroll
            for (int b = 0; b < 2; ++b)
#pragma unroll
                for (int m = 0; m < 4; ++m)
#pragma unroll
                    for (int n = 0; n < 2; ++n) acc[a][b][m][n] = (f32x4){0.f, 0.f, 0.f, 0.f};
        cur = nxt; cA = nA; cB = nB; ++ui;
        if constexpr (ALIGN_EPI) { if (wr == 1) PG8_BAR; }
    }
    PG8_WAIT_V(0);
    if constexpr (!ALIGN_EPI) { if (wr == 0) PG8_BAR; }
    PG8_BAR;
    if constexpr (Epi::AFTER_DRAIN) { E.fused(acc, cur, wr, wc, fr, fq, lds, wid, lane); S.done(cur); }
#undef PG8_SA
#undef PG8_SB
#undef PG8_STAGE
#undef PG8_LDA
#undef PG8_LDB
#undef PG8_MMA
#undef PG8_WAIT_V
#undef PG8_WAIT_L
#undef PG8_BAR
#undef PG8_SCHED
}
}
#define GAS __attribute__((address_space(1)))
#define LAS __attribute__((address_space(3)))
#define XB_TMO      128
#define XB_XCNT(j)  (256  + 64 * (j))
#define XB_XSUB(j)  (1280 + 64 * (j))
#define XB_XGEN(j)  (2304 + 64 * (j))
#define XB_TOP      3328
#define XB_TOPGEN   3392
#define XCD_BAR_WORDS 3456
#define XB_SPIN_CAP (1u << 18)

__device__ __forceinline__ unsigned xb_ld(unsigned* p)              { return __hip_atomic_load(p, __ATOMIC_RELAXED, __HIP_MEMORY_SCOPE_AGENT); }
__device__ __forceinline__ unsigned xb_add(unsigned* p, unsigned v) { return __hip_atomic_fetch_add(p, v, __ATOMIC_RELAXED, __HIP_MEMORY_SCOPE_AGENT); }
__device__ __forceinline__ unsigned xb_xcc_id() { return (unsigned)__builtin_amdgcn_s_getreg((3 << 11) | 20) & 0xFu; }
#define XB_SPIN(cond, bar) do { unsigned _sp = 0; while (cond) { __builtin_amdgcn_s_sleep(1); \
    if ((++_sp & 255u) == 0u) { if (xb_ld(&(bar)[XB_TMO])) break; if (_sp > XB_SPIN_CAP) { atomicAdd(&(bar)[XB_TMO], 1u); break; } } } } while (0)

struct XcdBarrier {
    unsigned* bar; unsigned x;
    volatile LAS unsigned* st;
};

__device__ __forceinline__ XcdBarrier xcd_barrier_post(unsigned* bar, volatile LAS unsigned* st) {
    XcdBarrier b; b.bar = bar; b.x = xb_xcc_id(); b.st = st;
    if (threadIdx.x == 0) (void)xb_add(&bar[XB_XCNT(b.x)], 1u);
    return b;
}
__device__ __forceinline__ void xcd_barrier_complete(unsigned* bar, unsigned x, unsigned& nloc, unsigned& nx) {
    const unsigned G = gridDim.x * gridDim.y * gridDim.z;
    unsigned sum, cnt, mine, sp = 0u;
    for (;;) {
        sum = 0u; cnt = 0u; mine = 0u;
#pragma unroll
        for (unsigned j = 0; j < 16; ++j) { const unsigned c = xb_ld(&bar[XB_XCNT(j)]); sum += c; cnt += (c > 0u) ? 1u : 0u; mine = (j == x) ? c : mine; }
        if (sum == G) break;
        __builtin_amdgcn_s_sleep(1);
        if ((++sp & 255u) == 0u) { if (xb_ld(&bar[XB_TMO])) break; if (sp > XB_SPIN_CAP) { atomicAdd(&bar[XB_TMO], 1u); break; } }
    }
    nloc = mine > 0u ? mine : 1u; nx = cnt > 0u ? cnt : 1u;
}

__device__ __forceinline__ void xcd_barrier(const XcdBarrier& b) {
    asm volatile("s_waitcnt vmcnt(0)" ::: "memory");
    __syncthreads();
    if (threadIdx.x == 0) {
        unsigned* bar = b.bar;
        __builtin_amdgcn_s_waitcnt(0);
        unsigned nloc = b.st[0], nx = b.st[1];
        if (nloc == 0u) { xcd_barrier_complete(bar, b.x, nloc, nx); b.st[0] = nloc; b.st[1] = nx; }
        const unsigned old = xb_add(&bar[XB_XSUB(b.x)], 1u);
        const unsigned gen = old / nloc;
        if (old + 1u == (gen + 1u) * nloc) {
            __builtin_amdgcn_fence(__ATOMIC_RELEASE, "agent");
            asm volatile("s_waitcnt vmcnt(0)" ::: "memory");
            const unsigned og = xb_add(&bar[XB_TOP], 1u);
            const unsigned tg = og / nx;
            if (og + 1u == (tg + 1u) * nx) xb_add(&bar[XB_TOPGEN], 1u);
            else XB_SPIN(xb_ld(&bar[XB_TOPGEN]) == tg, bar);
            __builtin_amdgcn_fence(__ATOMIC_ACQUIRE, "agent");
            xb_add(&bar[XB_XGEN(b.x)], 1u);
            asm volatile("s_waitcnt vmcnt(0)" ::: "memory");
        } else {
            XB_SPIN(xb_ld(&bar[XB_XGEN(b.x)]) == gen, bar);
            __builtin_amdgcn_fence(__ATOMIC_ACQUIRE, "agent");
            asm volatile("s_waitcnt vmcnt(0)" ::: "memory");
        }
    }
    __syncthreads();
}

namespace cg = cooperative_groups;
typedef unsigned short bf16;
typedef unsigned v4u __attribute__((ext_vector_type(4)));
typedef unsigned v2u __attribute__((ext_vector_type(2)));
typedef float f32x4 __attribute__((ext_vector_type(4)));
typedef float f32x2 __attribute__((ext_vector_type(2)));
typedef short bf16x8 __attribute__((ext_vector_type(8)));
#define LDS_WAIT() asm volatile("s_waitcnt lgkmcnt(0)" ::: "memory")

constexpr int DM = 1024, NB = 8, SEQ = 2048, DECB = 128, DECS = 4;
constexpr int MP = NB * SEQ, MS = DECB * DECS, MT = MP + MS, MPAD = 17152;
constexpr int NZ1 = 5376, NIN = 7424, DFF = 2816;
constexpr int ZR = 0, ZK = 1024, ZV = 2048, ZWL = 3072, ZAL = 3136, ZGL = 3200, ZXB = 3328, ZGB = 4352;
constexpr float ALPHA = 1.189207115002721f;
constexpr float LN_EPS = 1e-5f, GN_EPS = 64e-5f;

constexpr size_t MiB = 1u << 20;
constexpr size_t WS_CTL = 0, CTL_ZERO_BYTES = 65536;
constexpr int CW_BAR = 1024;
constexpr size_t WS_WOT = 1 * MiB;
constexpr size_t WS_SMALL = 3 * MiB;
constexpr size_t WS_XB = 4 * MiB;
constexpr size_t WS_Z1 = 38 * MiB;
constexpr size_t WS_WINT = 214 * MiB;
constexpr size_t WS_BONUS = 214 * MiB;
constexpr size_t WS_H1 = 38 * MiB;
constexpr size_t WS_H1B = 104 * MiB;
constexpr size_t WS_WGUT = 137 * MiB;
constexpr size_t WS_WDT = 148 * MiB;
constexpr size_t WS_ACT = 154 * MiB;
constexpr size_t O_Y = 0, O_SHP = 17301504, O_WKVP = 17309696, O_CONVP = 17833984, O_LRUP = 17858560,
                 O_SHS = 17866752, O_WKVS = 17997824, O_CONVS = 26386432, O_LRUS = 26779648;

constexpr int LDS_BYTES = 163840, MISC_OFF = LDS_BYTES - 64;

struct Params { const float* in[33]; float* out; unsigned char* ws; int never; int pad; };
typedef const __attribute__((address_space(4))) Params CP;
__device__ __forceinline__ CP* launder(CP* q) { asm volatile("" : "+s"(q)); return q; }
enum { I_XP = 0, I_XS, I_SHIFT, I_WKV, I_CONV, I_LRU, I_WIN, I_MU, I_W0, I_W2, I_A0, I_A2, I_G2, I_KK, I_KA, I_RK, I_LNXG, I_LNXB,
       I_CW, I_CB, I_WA, I_BA, I_WI, I_BI, I_LAM, I_WO, I_LN1G, I_LN1B, I_WG, I_WU, I_WD, I_LN2G, I_LN2B };

__device__ __forceinline__ float bf2f(unsigned b) { return __uint_as_float(b << 16); }
__device__ __forceinline__ unsigned f2bf(float f) { unsigned u = __float_as_uint(f); return (u + 0x7fffu + ((u >> 16) & 1u)) >> 16; }
typedef __bf16 bf2_t __attribute__((ext_vector_type(2)));
__device__ __forceinline__ unsigned pk2(float lo, float hi) { bf2_t v = {(__bf16)lo, (__bf16)hi}; return __builtin_bit_cast(unsigned, v); }
__device__ __forceinline__ float lo16(unsigned u) { return __uint_as_float(u << 16); }
__device__ __forceinline__ float hi16(unsigned u) { return __uint_as_float(u & 0xffff0000u); }
__device__ __forceinline__ float sigm(float x) { return __builtin_amdgcn_rcpf(1.f + __expf(-x)); }
__device__ __forceinline__ float tanh_(float x) { return 1.f - 2.f * __builtin_amdgcn_rcpf(__expf(2.f * x) + 1.f); }
__device__ __forceinline__ float gelu_tanh(float x) { return 0.5f * x * (1.f + tanh_(0.7978845608028654f * (x + 0.044715f * x * x * x))); }
template <int CTRL> __device__ __forceinline__ float dpp_add(float v) {
    return v + __int_as_float(__builtin_amdgcn_update_dpp(0, __float_as_int(v), CTRL, 0xF, 0xF, true)); }
__device__ __forceinline__ float allred8(float v) { v = dpp_add<0xB1>(v); v = dpp_add<0x4E>(v); v = dpp_add<0x141>(v); return v; }
__device__ __forceinline__ float allred16(float v) { v = allred8(v); v = dpp_add<0x140>(v); return v; }
__device__ __forceinline__ float wave_sum(float v) {
#pragma unroll
    for (int o = 1; o < 64; o <<= 1) v += __shfl_xor(v, o);
    return v; }
#define UNPACK8(q, f) do { f[0] = lo16(q.x); f[1] = hi16(q.x); f[2] = lo16(q.y); f[3] = hi16(q.y); f[4] = lo16(q.z); f[5] = hi16(q.z); f[6] = lo16(q.w); f[7] = hi16(q.w); } while (0)

__device__ __forceinline__ void transpose_item(const float* W, int N, bf16* WT, int ldT, int k0, int n0, int drow0, LAS float* scr, int lane) {
#pragma unroll 8
    for (int i = 0; i < 32; ++i) { const int kk = 2 * i + (lane >> 5); scr[kk * 33 + (lane & 31)] = W[(size_t)(k0 + kk) * N + n0 + (lane & 31)]; }
    LDS_WAIT();
    const int c = lane & 7;
#pragma unroll
    for (int j = 0; j < 4; ++j) { const int n = (lane >> 3) + 8 * j; const LAS float* s = scr + (8 * c) * 33 + n;
        v4u o; o.x = pk2(s[0 * 33], s[1 * 33]); o.y = pk2(s[2 * 33], s[3 * 33]); o.z = pk2(s[4 * 33], s[5 * 33]); o.w = pk2(s[6 * 33], s[7 * 33]);
        *(v4u*)(WT + (size_t)(drow0 + n) * ldT + k0 + 8 * c) = o; }
    LDS_WAIT();
}

__device__ __forceinline__ void phase0(CP& p, LAS unsigned char* lds) {
    int tid_l = threadIdx.x; asm volatile("" : "+v"(tid_l)); const int tid = tid_l, wave = tid >> 6, lane = tid & 63;
    const int gw = blockIdx.x * 8 + wave, NGW = gridDim.x * 8;
    bf16* Xb = (bf16*)(p.ws + WS_XB);
    for (int m = gw; m < MPAD; m += NGW) {
        const float* src = m < MP ? p.in[I_XP] + (size_t)m * DM : (m < MT ? p.in[I_XS] + (size_t)(m - MP) * DM : (m < MT + DECB ? p.in[I_SHIFT] + (size_t)(m - MT) * DM : nullptr));
        f32x4 v[4];
#pragma unroll
        for (int j = 0; j < 4; ++j) v[j] = src ? *(const f32x4*)(src + 4 * lane + 256 * j) : (f32x4){0.f, 0.f, 0.f, 0.f};
        unsigned long long* o8 = (unsigned long long*)(Xb + (size_t)m * DM) + lane;
#pragma unroll
        for (int j = 0; j < 4; ++j) o8[64 * j] = (unsigned long long)pk2(v[j].x, v[j].y) | ((unsigned long long)pk2(v[j].z, v[j].w) << 32);
        float* so = nullptr;
        if (m < MP) { if ((m & (SEQ - 1)) == SEQ - 1) so = p.out + O_SHP + (size_t)(m >> 11) * DM; }
        else if (m < MT) { if (((m - MP) & 3) == 3) so = p.out + O_SHS + (size_t)((m - MP) >> 2) * DM; }
        if (so) {
#pragma unroll
            for (int j = 0; j < 4; ++j) *(f32x4*)(so + 4 * lane + 256 * j) = v[j]; }
    }
    LAS float* scr = (LAS float*)(lds + wave * 16384);
    bf16* WinT = (bf16*)(p.ws + WS_WINT); bf16* WoT = (bf16*)(p.ws + WS_WOT);
    bf16* w2T = (bf16*)(p.ws + WS_SMALL); bf16* a2T = w2T + 65536; bf16* g2T = w2T + 131072; bf16* waT = w2T + 262144; bf16* wiT = w2T + 327680;
    constexpr int N_WIN = 16 * 232, N_WO = 16 * 32, N_L = 32, N_G = 64, N_B = 32;
    constexpr int NITEMS = N_WIN + N_WO + 2 * N_L + N_G + 2 * N_B;
    for (int it = gw; it < NITEMS; it += NGW) {
        int r = it;
        if (r < N_WIN) { transpose_item(p.in[I_WIN], NIN, WinT, 1024, 64 * (r / 232), 32 * (r % 232), 32 * (r % 232), scr, lane); continue; } r -= N_WIN;
        if (r < N_WO) { transpose_item(p.in[I_WO], 1024, WoT, 1024, 64 * (r / 32), 32 * (r % 32), 32 * (r % 32), scr, lane); continue; } r -= N_WO;
        if (r < N_L) { transpose_item(p.in[I_W2], 1024, w2T, 64, 0, 32 * r, 32 * r, scr, lane); continue; } r -= N_L;
        if (r < N_L) { transpose_item(p.in[I_A2], 1024, a2T, 64, 0, 32 * r, 32 * r, scr, lane); continue; } r -= N_L;
        if (r < N_G) { transpose_item(p.in[I_G2], 1024, g2T, 128, 64 * (r / 32), 32 * (r % 32), 32 * (r % 32), scr, lane); continue; } r -= N_G;
        if (r < N_B) { transpose_item(p.in[I_WA] + (r >> 1) * 4096, 64, waT + (r >> 1) * 4096, 64, 0, 32 * (r & 1), 32 * (r & 1), scr, lane); continue; } r -= N_B;
        transpose_item(p.in[I_WI] + (r >> 1) * 4096, 64, wiT + (r >> 1) * 4096, 64, 0, 32 * (r & 1), 32 * (r & 1), scr, lane);
    }
}
__device__ __forceinline__ void phase_convert_ffn(CP& p, LAS unsigned char* lds) {
    int tid_l = threadIdx.x; asm volatile("" : "+v"(tid_l)); const int tid = tid_l, wave = tid >> 6, lane = tid & 63;
    const int gw = blockIdx.x * 8 + wave, NGW = gridDim.x * 8;
    LAS float* scr = (LAS float*)(lds + wave * 16384);
    bf16* WguT = (bf16*)(p.ws + WS_WGUT); bf16* WdT = (bf16*)(p.ws + WS_WDT);
    constexpr int N_G = 16 * 88, N_D = 44 * 32;
    for (int it = gw; it < 2 * N_G + N_D; it += NGW) {
        int r = it;
        if (r < N_G) { const int n0 = 32 * (r % 88); transpose_item(p.in[I_WG], DFF, WguT, 1024, 64 * (r / 88), n0, 256 * (n0 >> 7) + (n0 & 127), scr, lane); continue; } r -= N_G;
        if (r < N_G) { const int n0 = 32 * (r % 88); transpose_item(p.in[I_WU], DFF, WguT, 1024, 64 * (r / 88), n0, 256 * (n0 >> 7) + 128 + (n0 & 127), scr, lane); continue; } r -= N_G;
        transpose_item(p.in[I_WD], 1024, WdT, DFF, 64 * (r / 32), 32 * (r % 32), 32 * (r % 32), scr, lane);
    }
}

struct EpiZ {
    static constexpr bool PERM = true, AFTER_DRAIN = false;
    bf16* Z1; bf16* Zg;
    __device__ __forceinline__ void operator()(const pg8::f32x4 (&acc)[2][2][4][2], const pg8::Unit& u, int wr, int wc, int fr, int fq) const {
        bf16* base; int ldc, colt;
        if (u.pn < 21) { base = Z1; ldc = NZ1; colt = u.pn * 256; } else { if (u.pm >= 66) return; base = Zg; ldc = 2048; colt = (u.pn - 21) * 256; }
        const int row0 = u.pm * 256 + wr * 64 + fr, col0 = colt + wc * 32 + 8 * fq;
#pragma unroll
        for (int ai = 0; ai < 2; ++ai)
#pragma unroll
            for (int m = 0; m < 4; ++m) { bf16* rowp = base + (size_t)(row0 + ai * 128 + m * 16) * ldc + col0;
#pragma unroll
                for (int bj = 0; bj < 2; ++bj) { const pg8::f32x4 v0 = acc[ai][bj][m][0], v1 = acc[ai][bj][m][1];
                    v4u w; w.x = pg8::cvt_pk_bf16(v0[0], v0[1]); w.y = pg8::cvt_pk_bf16(v0[2], v0[3]); w.z = pg8::cvt_pk_bf16(v1[0], v1[1]); w.w = pg8::cvt_pk_bf16(v1[2], v1[3]);
                    *(v4u*)(rowp + bj * 128) = w; } }
    }
};
struct EpiRes {
    static constexpr bool PERM = false, AFTER_DRAIN = false;
    const float* resA; const float* resB; float* out;
    __device__ __forceinline__ void operator()(const pg8::f32x4 (&acc)[2][2][4][2], const pg8::Unit& u, int wr, int wc, int fr, int fq) const {
        const int row0 = u.pm * 256 + wr * 64 + fr, col0 = u.pn * 256 + wc * 32 + 4 * fq;
#pragma unroll
        for (int ai = 0; ai < 2; ++ai)
#pragma unroll
            for (int m = 0; m < 4; ++m) { const int row = row0 + ai * 128 + m * 16;
                const float* rp = (row < MP ? resA + (size_t)row * DM : resB + (size_t)(row - MP) * DM) + col0; float* op = out + (size_t)row * DM + col0;
#pragma unroll
                for (int bj = 0; bj < 2; ++bj)
#pragma unroll
                    for (int n = 0; n < 2; ++n) { const pg8::f32x4 x = *(const pg8::f32x4*)(rp + bj * 128 + n * 16); *(pg8::f32x4*)(op + bj * 128 + n * 16) = acc[ai][bj][m][n] + x * ALPHA; } }
    }
};

template <bool RES_BF16> struct EpiResB {
    static constexpr bool PERM = true, AFTER_DRAIN = false;
    const float* resA; const float* resB; const bf16* resH; bf16* out;
    __device__ __forceinline__ void operator()(const pg8::f32x4 (&acc)[2][2][4][2], const pg8::Unit& u, int wr, int wc, int fr, int fq) const {
        const int row0 = u.pm * 256 + wr * 64 + fr, col0 = u.pn * 256 + wc * 32 + 8 * fq;
#pragma unroll
        for (int ai = 0; ai < 2; ++ai)
#pragma unroll
            for (int m = 0; m < 4; ++m) { const int row = row0 + ai * 128 + m * 16; bf16* op = out + (size_t)row * DM + col0;
#pragma unroll
                for (int bj = 0; bj < 2; ++bj) { float x[8];
                    if (RES_BF16) { const v4u h = *(const v4u*)(resH + (size_t)row * DM + col0 + bj * 128); UNPACK8(h, x); }
                    else { const float* rp = (row < MP ? resA + (size_t)row * DM : resB + (size_t)(row - MP) * DM) + col0 + bj * 128;
                           const pg8::f32x4 x0 = *(const pg8::f32x4*)rp, x1 = *(const pg8::f32x4*)(rp + 4);
                           x[0] = x0[0]; x[1] = x0[1]; x[2] = x0[2]; x[3] = x0[3]; x[4] = x1[0]; x[5] = x1[1]; x[6] = x1[2]; x[7] = x1[3]; }
                    const pg8::f32x4 v0 = acc[ai][bj][m][0], v1 = acc[ai][bj][m][1];
                    v4u w; w.x = pk2(v0[0] + ALPHA * x[0], v0[1] + ALPHA * x[1]); w.y = pk2(v0[2] + ALPHA * x[2], v0[3] + ALPHA * x[3]);
                    w.z = pk2(v1[0] + ALPHA * x[4], v1[1] + ALPHA * x[5]); w.w = pk2(v1[2] + ALPHA * x[6], v1[3] + ALPHA * x[7]);
                    *(v4u*)(op + bj * 128) = w; } }
    }
};
struct EpiSwi {
    static constexpr bool PERM = true, AFTER_DRAIN = false;
    bf16* O;
    __device__ __forceinline__ void operator()(const pg8::f32x4 (&acc)[2][2][4][2], const pg8::Unit& u, int wr, int wc, int fr, int fq) const {
        const int row0 = u.pm * 256 + wr * 64 + fr, col0 = u.pn * 128 + wc * 32 + 8 * fq;
#pragma unroll
        for (int ai = 0; ai < 2; ++ai)
#pragma unroll
            for (int m = 0; m < 4; ++m) { bf16* rowp = O + (size_t)(row0 + ai * 128 + m * 16) * DFF + col0;
                float o[8];
#pragma unroll
                for (int n = 0; n < 2; ++n)
#pragma unroll
                    for (int j = 0; j < 4; ++j) { const float g = acc[ai][0][m][n][j], uu = acc[ai][1][m][n][j]; o[4 * n + j] = g * sigm(g) * uu; }
                v4u w; w.x = pg8::cvt_pk_bf16(o[0], o[1]); w.y = pg8::cvt_pk_bf16(o[2], o[3]); w.z = pg8::cvt_pk_bf16(o[4], o[5]); w.w = pg8::cvt_pk_bf16(o[6], o[7]);
                *(v4u*)rowp = w; }
    }
};

typedef _Float16 h8 __attribute__((ext_vector_type(8)));
typedef _Float16 h4 __attribute__((ext_vector_type(4)));
constexpr int L_NKK = 0, L_WR = 17408, L_W = 34816, L_B = 52224, L_KP = 69632, L_VL = 87040, L_SC = 95232, L_RAW = 95744, L_YB = L_RAW  , L_RAWL = 120704,
              L_CST = 138384, L_MUL = 140432, L_WB = 140944, L_PW = L_W, L_PA = L_B;
constexpr int OPS = 68, RLS = 136, WBS = 72;

__device__ __forceinline__ float mixmul_lo(unsigned h, float x) { float d; asm("v_fma_mix_f32 %0, %1, %2, 0 op_sel_hi:[1,0,0]" : "=v"(d) : "v"(h), "v"(x)); return d; }
__device__ __forceinline__ float mix_lo(unsigned h, float x, float acc) { float d; asm("v_fma_mix_f32 %0, %1, %2, %3 op_sel_hi:[1,0,0]" : "=v"(d) : "v"(h), "v"(x), "v"(acc)); return d; }
__device__ __forceinline__ float mix_hi(unsigned h, float x, float acc) { float d; asm("v_fma_mix_f32 %0, %1, %2, %3 op_sel:[1,0,0] op_sel_hi:[1,0,0]" : "=v"(d) : "v"(h), "v"(x), "v"(acc)); return d; }
__device__ __forceinline__ float nmix_lo(unsigned h, float x, float acc) { float d; asm("v_fma_mix_f32 %0, -%1, %2, %3 op_sel_hi:[1,0,0]" : "=v"(d) : "v"(h), "v"(x), "v"(acc)); return d; }
__device__ __forceinline__ float nmix_hi(unsigned h, float x, float acc) { float d; asm("v_fma_mix_f32 %0, -%1, %2, %3 op_sel:[1,0,0] op_sel_hi:[1,0,0]" : "=v"(d) : "v"(h), "v"(x), "v"(acc)); return d; }
__device__ __forceinline__ void allred16x2(float& a, float& b) {
    asm("s_nop 0\n\t"
        "v_add_f32_dpp %0, %0, %0 quad_perm:[1,0,3,2] row_mask:0xf bank_mask:0xf bound_ctrl:1\n\t"
        "v_add_f32_dpp %1, %1, %1 quad_perm:[1,0,3,2] row_mask:0xf bank_mask:0xf bound_ctrl:1\n\t"
        "s_nop 0\n\t"
        "v_add_f32_dpp %0, %0, %0 quad_perm:[2,3,0,1] row_mask:0xf bank_mask:0xf bound_ctrl:1\n\t"
        "v_add_f32_dpp %1, %1, %1 quad_perm:[2,3,0,1] row_mask:0xf bank_mask:0xf bound_ctrl:1\n\t"
        "s_nop 0\n\t"
        "v_add_f32_dpp %0, %0, %0 row_half_mirror row_mask:0xf bank_mask:0xf bound_ctrl:1\n\t"
        "v_add_f32_dpp %1, %1, %1 row_half_mirror row_mask:0xf bank_mask:0xf bound_ctrl:1\n\t"
        "s_nop 0\n\t"
        "v_add_f32_dpp %0, %0, %0 row_mirror row_mask:0xf bank_mask:0xf bound_ctrl:1\n\t"
        "v_add_f32_dpp %1, %1, %1 row_mirror row_mask:0xf bank_mask:0xf bound_ctrl:1"
        : "+v"(a), "+v"(b));
}

__device__ __forceinline__ f32x2 pk_mul(f32x2 a, f32x2 b) { f32x2 d; asm("v_pk_mul_f32 %0, %1, %2" : "=v"(d) : "v"(a), "v"(b)); return d; }
__device__ __forceinline__ f32x2 pk_fma(f32x2 a, f32x2 b, f32x2 c) { f32x2 d; asm("v_pk_fma_f32 %0, %1, %2, %3" : "=v"(d) : "v"(a), "v"(b), "v"(c)); return d; }
__device__ __forceinline__ f32x2 pk_fma_b(f32x2 a, f32x2 blo, f32x2 c) { f32x2 d; asm("v_pk_fma_f32 %0, %1, %2, %3 op_sel_hi:[1,0,1]" : "=v"(d) : "v"(a), "v"(blo), "v"(c)); return d; }
__device__ __forceinline__ float add_asm(float a, float b) { float d; asm("v_add_f32 %0, %1, %2" : "=v"(d) : "v"(a), "v"(b)); return d; }
struct StepOps { f32x4 nk, wr, w, b, k; f32x2 vi; };
__device__ __forceinline__ void allred8x2_decay(float& a, float& b, float a0, float a1, float b0, float b1, f32x2& s01, f32x2& s23, f32x2& s45, f32x2& s67, f32x2 w01, f32x2 w23, f32x2 w45, f32x2 w67) {
    asm volatile("v_add_f32 %0, %10, %11\n\t"
        "v_add_f32 %1, %12, %13\n\t"
        "v_pk_mul_f32 %2, %2, %6\n\t"
        "v_add_f32_dpp %0, %0, %0 quad_perm:[1,0,3,2] row_mask:0xf bank_mask:0xf bound_ctrl:1\n\t"
        "v_add_f32_dpp %1, %1, %1 quad_perm:[1,0,3,2] row_mask:0xf bank_mask:0xf bound_ctrl:1\n\t"
        "v_pk_mul_f32 %3, %3, %7\n\t"
        "v_add_f32_dpp %0, %0, %0 quad_perm:[2,3,0,1] row_mask:0xf bank_mask:0xf bound_ctrl:1\n\t"
        "v_add_f32_dpp %1, %1, %1 quad_perm:[2,3,0,1] row_mask:0xf bank_mask:0xf bound_ctrl:1\n\t"
        "v_pk_mul_f32 %4, %4, %8\n\t"
        "v_add_f32_dpp %0, %0, %0 row_half_mirror row_mask:0xf bank_mask:0xf bound_ctrl:1\n\t"
        "v_add_f32_dpp %1, %1, %1 row_half_mirror row_mask:0xf bank_mask:0xf bound_ctrl:1\n\t"
        "v_pk_mul_f32 %5, %5, %9"
        : "=&v"(a), "=&v"(b), "+v"(s01), "+v"(s23), "+v"(s45), "+v"(s67) : "v"(w01), "v"(w23), "v"(w45), "v"(w67), "v"(a0), "v"(a1), "v"(b0), "v"(b1));
}
struct StepOps8 { f32x4 nk0, nk1, wr0, wr1, w0, w1, b0, b1, k0, k1; f32x2 vi; };

__device__ __forceinline__ void wkv_prompt(CP& p, LAS unsigned char* lds, int unit, bool dry) {
    int tid_l = threadIdx.x; asm volatile("" : "+v"(tid_l)); const int tid = tid_l, wave = tid >> 6, lane = tid & 63;
    const int bh = unit >> 1, half = unit & 1, b = bh >> 4, h = bh & 15;
    const int rl = (wave & 3) * 8 + (lane >> 3), s = lane & 7;
    const int ptok = tid >> 3, pcg = tid & 7;
    bf16* Z1 = (bf16*)(p.ws + WS_Z1); bf16* BON = (bf16*)(p.ws + WS_BONUS);
    const size_t rowbase = (size_t)b * SEQ;
    LAS bf16* RAW = (LAS bf16*)(lds + L_RAW); LAS bf16* RAWL = (LAS bf16*)(lds + L_RAWL);
    LAS float* ONKK = (LAS float*)(lds + L_NKK); LAS float* OWR = (LAS float*)(lds + L_WR); LAS float* OW = (LAS float*)(lds + L_W); LAS float* OB = (LAS float*)(lds + L_B); LAS float* OKP = (LAS float*)(lds + L_KP);
    LAS float* VL = (LAS float*)(lds + L_VL); LAS float* SC = (LAS float*)(lds + L_SC); LAS float* YB = (LAS float*)(lds + L_YB);
    LAS float* PW = (LAS float*)(lds + L_PW); LAS float* PA = (LAS float*)(lds + L_PA);
    LAS float* CST = (LAS float*)(lds + L_CST); LAS float* MUL = (LAS float*)(lds + L_MUL); LAS bf16* WB = (LAS bf16*)(lds + L_WB);
    if (tid < 96) ((LAS unsigned*)RAW)[tid] = 0u;
    if (tid < 68) ((LAS unsigned*)RAWL)[tid] = 0u;
    {
      const int a = tid >> 6, cc = tid & 63, C = h * 64 + cc;
      const float* src = a == 0 ? p.in[I_MU] + ZR : a == 1 ? p.in[I_MU] + ZK : a == 2 ? p.in[I_MU] + ZV : a == 3 ? p.in[I_W0] : a == 4 ? p.in[I_A0] : a == 5 ? p.in[I_KK] : a == 6 ? p.in[I_KA] : p.in[I_RK];
      CST[a * 64 + cc] = src[C];
      if (tid < 128) MUL[tid] = p.in[I_MU][ZWL + tid];
      const bf16* w2T = (const bf16*)(p.ws + WS_SMALL); const bf16* a2T = w2T + 65536;
      const int n = tid >> 3, k8 = tid & 7;
      *(LAS v4u*)(WB + n * WBS + 8 * k8) = *(const v4u*)(w2T + (size_t)(h * 64 + n) * 64 + 8 * k8);
      *(LAS v4u*)(WB + 64 * WBS + n * WBS + 8 * k8) = *(const v4u*)(a2T + (size_t)(h * 64 + n) * 64 + 8 * k8); }
    f32x2 S01 = {0.f, 0.f}, S23 = {0.f, 0.f}, S45 = {0.f, 0.f}, S67 = {0.f, 0.f};
    const int C0 = h * 64 + 8 * pcg;
    const bool vmine = (pcg >> 2) == half;
    v4u pr, pk, pv, pl0, pl1;
    { const bf16* z = Z1 + (rowbase + ptok) * NZ1;
      pr = *(const v4u*)(z + ZR + C0); pk = *(const v4u*)(z + ZK + C0); pv = vmine ? *(const v4u*)(z + ZV + C0) : (v4u){0u, 0u, 0u, 0u};
      pl0 = *(const v4u*)(z + ZWL + 16 * pcg); pl1 = *(const v4u*)(z + ZWL + 16 * pcg + 8); }
    for (int c = 0; c < SEQ / 64; ++c) {
        if (ptok == 63 && c > 0) {
            *(LAS v4u*)(RAW + 0 + 8 * pcg) = *(LAS v4u*)(RAW + 64 * 192 + 8 * pcg); *(LAS v4u*)(RAW + 64 + 8 * pcg) = *(LAS v4u*)(RAW + 64 * 192 + 64 + 8 * pcg);
            *(LAS v4u*)(RAW + 128 + 8 * pcg) = *(LAS v4u*)(RAW + 64 * 192 + 128 + 8 * pcg);
            *(LAS v4u*)(RAWL + 16 * pcg) = *(LAS v4u*)(RAWL + 64 * RLS + 16 * pcg); *(LAS v4u*)(RAWL + 16 * pcg + 8) = *(LAS v4u*)(RAWL + 64 * RLS + 16 * pcg + 8); }
        { LAS bf16* rr = RAW + (ptok + 1) * 192; *(LAS v4u*)(rr + 8 * pcg) = pr; *(LAS v4u*)(rr + 64 + 8 * pcg) = pk; *(LAS v4u*)(rr + 128 + 8 * pcg) = pv;
          LAS bf16* rl2 = RAWL + (ptok + 1) * RLS; *(LAS v4u*)(rl2 + 16 * pcg) = pl0; *(LAS v4u*)(rl2 + 16 * pcg + 8) = pl1; }
        __syncthreads();
        if (c + 1 < SEQ / 64) { const bf16* z = Z1 + (rowbase + (size_t)(c + 1) * 64 + ptok) * NZ1;
            pr = *(const v4u*)(z + ZR + C0); pk = *(const v4u*)(z + ZK + C0); if (vmine) pv = *(const v4u*)(z + ZV + C0);
            pl0 = *(const v4u*)(z + ZWL + 16 * pcg); pl1 = *(const v4u*)(z + ZWL + 16 * pcg + 8); }
#ifdef PROBE_PREP2
        for (int rep = 0; rep < (p.never == 0 ? 2 : 1); ++rep) {
#else
        {
#endif
        { const int tb = wave & 3, nh = wave >> 2, fr = lane & 15, q = lane >> 4, ti = 16 * tb + fr;
          bf16x8 aw[2], aa[2];
#pragma unroll
          for (int ks = 0; ks < 2; ++ks) {
              const int ko = 32 * ks + 8 * q;
              { const v4u cu = *(LAS v4u*)(RAWL + (ti + 1) * RLS + ko), pu = *(LAS v4u*)(RAWL + ti * RLS + ko); float cf[8], pf[8]; UNPACK8(cu, cf); UNPACK8(pu, pf);
                const f32x4 m0 = *(LAS f32x4*)(MUL + ko), m1 = *(LAS f32x4*)(MUL + ko + 4); float o[8];
#pragma unroll
                for (int e = 0; e < 8; ++e) { const float mu = e < 4 ? m0[e & 3] : m1[e & 3]; o[e] = tanh_(cf[e] + mu * (pf[e] - cf[e])); }
                v4u w; w.x = pk2(o[0], o[1]); w.y = pk2(o[2], o[3]); w.z = pk2(o[4], o[5]); w.w = pk2(o[6], o[7]); aw[ks] = __builtin_bit_cast(bf16x8, w); }
              { const v4u cu = *(LAS v4u*)(RAWL + (ti + 1) * RLS + 64 + ko), pu = *(LAS v4u*)(RAWL + ti * RLS + 64 + ko); float cf[8], pf[8]; UNPACK8(cu, cf); UNPACK8(pu, pf);
                const f32x4 m0 = *(LAS f32x4*)(MUL + 64 + ko), m1 = *(LAS f32x4*)(MUL + 64 + ko + 4); float o[8];
#pragma unroll
                for (int e = 0; e < 8; ++e) { const float mu = e < 4 ? m0[e & 3] : m1[e & 3]; o[e] = cf[e] + mu * (pf[e] - cf[e]); }
                v4u w; w.x = pk2(o[0], o[1]); w.y = pk2(o[2], o[3]); w.z = pk2(o[4], o[5]); w.w = pk2(o[6], o[7]); aa[ks] = __builtin_bit_cast(bf16x8, w); }
          }
#pragma unroll
          for (int nbi = 0; nbi < 2; ++nbi) {
              const int nb = 2 * nh + nbi, n = 16 * nb + fr;
              f32x4 cw = {0.f, 0.f, 0.f, 0.f}, ca = {0.f, 0.f, 0.f, 0.f};
#pragma unroll
              for (int ks = 0; ks < 2; ++ks) {
                  const bf16x8 bw = *(LAS bf16x8*)(WB + n * WBS + 32 * ks + 8 * q), ba = *(LAS bf16x8*)(WB + 64 * WBS + n * WBS + 32 * ks + 8 * q);
                  cw = __builtin_amdgcn_mfma_f32_16x16x32_bf16(aw[ks], bw, cw, 0, 0, 0); ca = __builtin_amdgcn_mfma_f32_16x16x32_bf16(aa[ks], ba, ca, 0, 0, 0); }
#pragma unroll
              for (int r = 0; r < 4; ++r) { const int tok = 16 * tb + 4 * q + r; PW[tok * OPS + 16 * nb + fr] = cw[r]; PA[tok * OPS + 16 * nb + fr] = ca[r]; }
          }
        }
        __syncthreads();
        { float rc[8], kc[8], vc[8], t8[8];
          const int cc0 = 8 * pcg;
          { const v4u cu = *(LAS v4u*)(RAW + (ptok + 1) * 192 + cc0), pu = *(LAS v4u*)(RAW + ptok * 192 + cc0); UNPACK8(cu, rc); UNPACK8(pu, t8);
            const f32x4 m0 = *(LAS f32x4*)(CST + cc0), m1 = *(LAS f32x4*)(CST + cc0 + 4);
#pragma unroll
            for (int e = 0; e < 8; ++e) rc[e] += (e < 4 ? m0[e & 3] : m1[e & 3]) * (t8[e] - rc[e]); }
          { const v4u cu = *(LAS v4u*)(RAW + (ptok + 1) * 192 + 64 + cc0), pu = *(LAS v4u*)(RAW + ptok * 192 + 64 + cc0); UNPACK8(cu, kc); UNPACK8(pu, t8);
            const f32x4 m0 = *(LAS f32x4*)(CST + 64 + cc0), m1 = *(LAS f32x4*)(CST + 64 + cc0 + 4);
#pragma unroll
            for (int e = 0; e < 8; ++e) kc[e] += (e < 4 ? m0[e & 3] : m1[e & 3]) * (t8[e] - kc[e]); }
          { const v4u cu = *(LAS v4u*)(RAW + (ptok + 1) * 192 + 128 + cc0), pu = *(LAS v4u*)(RAW + ptok * 192 + 128 + cc0); UNPACK8(cu, vc); UNPACK8(pu, t8);
            const f32x4 m0 = *(LAS f32x4*)(CST + 128 + cc0), m1 = *(LAS f32x4*)(CST + 128 + cc0 + 4);
#pragma unroll
            for (int e = 0; e < 8; ++e) vc[e] += (e < 4 ? m0[e & 3] : m1[e & 3]) * (t8[e] - vc[e]); }
          float dec[8], av[8], kku[8], kp[8];
          { const f32x4 wa0 = *(LAS f32x4*)(PW + ptok * OPS + cc0), wa1 = *(LAS f32x4*)(PW + ptok * OPS + cc0 + 4);
            const f32x4 aa0 = *(LAS f32x4*)(PA + ptok * OPS + cc0), aa1 = *(LAS f32x4*)(PA + ptok * OPS + cc0 + 4);
            const f32x4 w00 = *(LAS f32x4*)(CST + 192 + cc0), w01 = *(LAS f32x4*)(CST + 192 + cc0 + 4);
            const f32x4 a00 = *(LAS f32x4*)(CST + 256 + cc0), a01 = *(LAS f32x4*)(CST + 256 + cc0 + 4);
            const f32x4 kk0 = *(LAS f32x4*)(CST + 320 + cc0), kk1 = *(LAS f32x4*)(CST + 320 + cc0 + 4);
            const f32x4 ka0 = *(LAS f32x4*)(CST + 384 + cc0), ka1 = *(LAS f32x4*)(CST + 384 + cc0 + 4);
#pragma unroll
            for (int e = 0; e < 8; ++e) {
                const float wl = (e < 4 ? w00[e & 3] : w01[e & 3]) + (e < 4 ? wa0[e & 3] : wa1[e & 3]);
                dec[e] = __expf(-0.6065306597126334f * sigm(wl));
                av[e] = sigm((e < 4 ? a00[e & 3] : a01[e & 3]) + (e < 4 ? aa0[e & 3] : aa1[e & 3]));
                kku[e] = kc[e] * (e < 4 ? kk0[e & 3] : kk1[e & 3]);
                kp[e] = kc[e] * (1.f + (av[e] - 1.f) * (e < 4 ? ka0[e & 3] : ka1[e & 3])); } }
          float ss = 0.f;
#pragma unroll
          for (int e = 0; e < 8; ++e) ss += kku[e] * kku[e];
          ss = allred8(ss);
          const float inv = __builtin_amdgcn_rsqf(fmaxf(ss, 1e-24f));
          const f32x4 rk0 = *(LAS f32x4*)(CST + 448 + cc0), rk1 = *(LAS f32x4*)(CST + 448 + cc0 + 4);
          float nk[8], bb[8], wr8[8], br = 0.f, kr = 0.f, bon = 0.f;
#pragma unroll
          for (int e = 0; e < 8; ++e) { const float kk = kku[e] * inv; nk[e] = -kk; bb[e] = kk * av[e]; wr8[e] = dec[e] * rc[e];
              br += bb[e] * rc[e]; kr += kp[e] * rc[e]; bon += rc[e] * kp[e] * (e < 4 ? rk0[e & 3] : rk1[e & 3]); }
          br = allred8(br); kr = allred8(kr); bon = allred8(bon);
          const int o = ptok * OPS + 8 * pcg;
          *(LAS f32x4*)(ONKK + o) = (f32x4){nk[0], nk[1], nk[2], nk[3]}; *(LAS f32x4*)(ONKK + o + 4) = (f32x4){nk[4], nk[5], nk[6], nk[7]};
          *(LAS f32x4*)(OWR + o) = (f32x4){wr8[0], wr8[1], wr8[2], wr8[3]}; *(LAS f32x4*)(OWR + o + 4) = (f32x4){wr8[4], wr8[5], wr8[6], wr8[7]};
          *(LAS f32x4*)(OW + o) = (f32x4){dec[0], dec[1], dec[2], dec[3]}; *(LAS f32x4*)(OW + o + 4) = (f32x4){dec[4], dec[5], dec[6], dec[7]};
          *(LAS f32x4*)(OB + o) = (f32x4){bb[0], bb[1], bb[2], bb[3]}; *(LAS f32x4*)(OB + o + 4) = (f32x4){bb[4], bb[5], bb[6], bb[7]};
          *(LAS f32x4*)(OKP + o) = (f32x4){kp[0], kp[1], kp[2], kp[3]}; *(LAS f32x4*)(OKP + o + 4) = (f32x4){kp[4], kp[5], kp[6], kp[7]};
          if (pcg == 0) *(LAS f32x2*)(SC + 2 * ptok) = (f32x2){br, kr};
          if (vmine) { const int vo = ptok * 32 + 8 * (pcg & 3);
              *(LAS f32x4*)(VL + vo) = (f32x4){vc[0], vc[1], vc[2], vc[3]}; *(LAS f32x4*)(VL + vo + 4) = (f32x4){vc[4], vc[5], vc[6], vc[7]};
              v4u w; w.x = pk2(bon * vc[0], bon * vc[1]); w.y = pk2(bon * vc[2], bon * vc[3]); w.z = pk2(bon * vc[4], bon * vc[5]); w.w = pk2(bon * vc[6], bon * vc[7]);
              if (!dry) *(v4u*)(BON + (rowbase + (size_t)c * 64 + ptok) * DM + C0) = w; }
        }
        __syncthreads();
        }
        if (wave < 4) { float sak = 0.f, y0k = 0.f;
#define WK_LOAD(o, t) do { const int ofs = (t) * OPS + 8 * s; \
              o.nk0 = *(const LAS f32x4*)(ONKK + ofs); o.nk1 = *(const LAS f32x4*)(ONKK + ofs + 4); o.wr0 = *(const LAS f32x4*)(OWR + ofs); o.wr1 = *(const LAS f32x4*)(OWR + ofs + 4); \
              o.w0 = *(const LAS f32x4*)(OW + ofs); o.w1 = *(const LAS f32x4*)(OW + ofs + 4); o.b0 = *(const LAS f32x4*)(OB + ofs); o.b1 = *(const LAS f32x4*)(OB + ofs + 4); \
              o.k0 = *(const LAS f32x4*)(OKP + ofs); o.k1 = *(const LAS f32x4*)(OKP + ofs + 4); o.vi[0] = VL[(t) * 32 + rl]; } while (0)
#define P2(v, i) ((f32x2){v[i], v[(i) + 1]})
#define WK_STEP(o, tl) do { \
              f32x2 ac = pk_mul(S01, P2(o.nk0, 0)); ac = pk_fma(S23, P2(o.nk0, 2), ac); ac = pk_fma(S45, P2(o.nk1, 0), ac); ac = pk_fma(S67, P2(o.nk1, 2), ac); \
              f32x2 ay = pk_mul(S01, P2(o.wr0, 0)); ay = pk_fma(S23, P2(o.wr0, 2), ay); ay = pk_fma(S45, P2(o.wr1, 0), ay); ay = pk_fma(S67, P2(o.wr1, 2), ay); \
              float psa, py; \
              allred8x2_decay(psa, py, ac[0], ac[1], ay[0], ay[1], S01, S23, S45, S67, P2(o.w0, 0), P2(o.w0, 2), P2(o.w1, 0), P2(o.w1, 2)); \
              f32x2 sap; sap[0] = psa; \
              S01 = pk_fma_b(P2(o.b0, 0), sap, S01); S23 = pk_fma_b(P2(o.b0, 2), sap, S23); S45 = pk_fma_b(P2(o.b1, 0), sap, S45); S67 = pk_fma_b(P2(o.b1, 2), sap, S67); \
              S01 = pk_fma_b(P2(o.k0, 0), o.vi, S01); S23 = pk_fma_b(P2(o.k0, 2), o.vi, S23); S45 = pk_fma_b(P2(o.k1, 0), o.vi, S45); S67 = pk_fma_b(P2(o.k1, 2), o.vi, S67); \
              const bool mine = (s == (tl)); sak = mine ? psa : sak; y0k = mine ? py : y0k; } while (0)
          StepOps8 A0, B0; A0.vi[1] = B0.vi[1] = 0.f;
          WK_LOAD(A0, 0);
#pragma unroll 1
          for (int tb = 0; tb < 64; tb += 8) {
              WK_LOAD(B0, tb + 1); WK_STEP(A0, 0);
              WK_LOAD(A0, tb + 2); WK_STEP(B0, 1);
              WK_LOAD(B0, tb + 3); WK_STEP(A0, 2);
              WK_LOAD(A0, tb + 4); WK_STEP(B0, 3);
              WK_LOAD(B0, tb + 5); WK_STEP(A0, 4);
              WK_LOAD(A0, tb + 6); WK_STEP(B0, 5);
              WK_LOAD(B0, tb + 7); WK_STEP(A0, 6);
              const int tn = (tb + 8) & 63;
              WK_LOAD(A0, tn);     WK_STEP(B0, 7);
              { const int t = tb + s; const f32x2 sc = *(const LAS f32x2*)(SC + 2 * t); YB[t * 32 + rl] = y0k + sak * sc[0] + VL[t * 32 + rl] * sc[1]; }
          }
#undef WK_LOAD
#undef WK_STEP
#undef P2
        }
        __syncthreads();
        { const f32x4 yv = *(LAS f32x4*)(YB + ptok * 32 + 4 * pcg); v2u w; w.x = pk2(yv[0], yv[1]); w.y = pk2(yv[2], yv[3]);
          if (!dry) *(v2u*)(Z1 + (rowbase + (size_t)c * 64 + ptok) * NZ1 + ZV + h * 64 + 32 * half + 4 * pcg) = w; }
    }
    if (!dry && wave < 4) { float* so = p.out + O_WKVP + ((size_t)(b * 16 + h) * 64 + 32 * half + rl) * 64 + 8 * s; *(f32x4*)so = (f32x4){S01[0], S01[1], S23[0], S23[1]}; *(f32x4*)(so + 4) = (f32x4){S45[0], S45[1], S67[0], S67[1]}; }
    __syncthreads();
}

constexpr int CH2 = 32, NCH2 = SEQ / CH2;
constexpr int L2_OP = 0, L2_OPSZ = 43520, L2_A = 8704  , L2_VL = 87040, L2_SC = 95232, L2_YB = 95744, L2_CST = 103936, L2_MUL = 105984, L2_WB = 106496;
struct RawRegs { v4u lw[2], la[2], lwp[2], lap[2], r, k, v, rp, kp, vp; };
__device__ __forceinline__ void wkv_prompt2(CP& p, LAS unsigned char* lds, int unit, bool dry) {
    int tid_l = threadIdx.x; asm volatile("" : "+v"(tid_l)); const int tid = tid_l, wave = tid >> 6, lane = tid & 63;
    const int bh = unit >> 1, half = unit & 1, b = bh >> 4, h = bh & 15;
    bf16* Z1 = (bf16*)(p.ws + WS_Z1); bf16* BON = (bf16*)(p.ws + WS_BONUS);
    const size_t rowbase = (size_t)b * SEQ;
    LAS float* CST = (LAS float*)(lds + L2_CST); LAS float* MUL = (LAS float*)(lds + L2_MUL); LAS bf16* WB = (LAS bf16*)(lds + L2_WB);
    { const int a = tid >> 6, cc = tid & 63, C = h * 64 + cc;
      const float* src = a == 0 ? p.in[I_MU] + ZR : a == 1 ? p.in[I_MU] + ZK : a == 2 ? p.in[I_MU] + ZV : a == 3 ? p.in[I_W0] : a == 4 ? p.in[I_A0] : a == 5 ? p.in[I_KK] : a == 6 ? p.in[I_KA] : p.in[I_RK];
      CST[a * 64 + cc] = src[C];
      if (tid < 128) MUL[tid] = p.in[I_MU][ZWL + tid];
      const bf16* w2T = (const bf16*)(p.ws + WS_SMALL); const bf16* a2T = w2T + 65536;
      const int n = tid >> 3, k8 = tid & 7;
      *(LAS v4u*)(WB + n * WBS + 8 * k8) = *(const v4u*)(w2T + (size_t)(h * 64 + n) * 64 + 8 * k8);
      *(LAS v4u*)(WB + 64 * WBS + n * WBS + 8 * k8) = *(const v4u*)(a2T + (size_t)(h * 64 + n) * 64 + 8 * k8); }
    __syncthreads();
    if (wave >= 4) {
        const int w4 = wave - 4, fr = lane & 15, q = lane >> 4, tb = w4 >> 1;
        const int ptok = 8 * w4 + (lane >> 3), pcg = lane & 7, C0 = h * 64 + 8 * pcg;
        const bool vmine = (pcg >> 2) == half;
        const int ftok = (tid - 256) >> 3;
        RawRegs R;
#define WK_LOADRAW(cc) do { const size_t rowL = rowbase + (size_t)(cc) * CH2 + 16 * tb + fr; const bf16* zl = Z1 + rowL * NZ1; const bool z0 = ((cc) == 0 && 16 * tb + fr == 0); const bf16* zlp = z0 ? zl : zl - NZ1; \
            _Pragma("unroll") for (int ks = 0; ks < 2; ++ks) { R.lw[ks] = *(const v4u*)(zl + ZWL + 32 * ks + 8 * q); R.la[ks] = *(const v4u*)(zl + ZAL + 32 * ks + 8 * q); \
                R.lwp[ks] = *(const v4u*)(zlp + ZWL + 32 * ks + 8 * q); R.lap[ks] = *(const v4u*)(zlp + ZAL + 32 * ks + 8 * q); \
                if (z0) { R.lwp[ks] = (v4u){0u, 0u, 0u, 0u}; R.lap[ks] = (v4u){0u, 0u, 0u, 0u}; } } \
            const size_t rowE = rowbase + (size_t)(cc) * CH2 + ptok; const bf16* ze = Z1 + rowE * NZ1; const bool e0 = ((cc) == 0 && ptok == 0); const bf16* zep = e0 ? ze : ze - NZ1; \
            R.r = *(const v4u*)(ze + ZR + C0); R.k = *(const v4u*)(ze + ZK + C0); R.rp = *(const v4u*)(zep + ZR + C0); R.kp = *(const v4u*)(zep + ZK + C0); \
            if (vmine) { R.v = *(const v4u*)(ze + ZV + C0); R.vp = *(const v4u*)(zep + ZV + C0); } else { R.v = (v4u){0u, 0u, 0u, 0u}; R.vp = R.v; } \
            if (e0) { R.rp = (v4u){0u, 0u, 0u, 0u}; R.kp = R.rp; R.vp = R.rp; } } while (0)
        WK_LOADRAW(0);
        for (int c = -1; c < NCH2; ++c) {
            if (c >= 1) {
                const LAS float* YBp = (const LAS float*)(lds + L2_YB + ((c - 1) & 1) * 4096);
                const f32x4 yv = *(const LAS f32x4*)(YBp + ftok * 32 + 4 * pcg); v2u w; w.x = pk2(yv[0], yv[1]); w.y = pk2(yv[2], yv[3]);
                if (!dry) *(v2u*)(Z1 + (rowbase + (size_t)(c - 1) * CH2 + ftok) * NZ1 + ZV + h * 64 + 32 * half + 4 * pcg) = w; }
            if (c + 1 < NCH2) {
                const int cc = c + 1;
                const RawRegs T = R;
                if (cc + 1 < NCH2) WK_LOADRAW(cc + 1);
                LAS unsigned char* ob = lds + L2_OP + (cc & 1) * L2_OPSZ;
                LAS float* ONKK = (LAS float*)ob; LAS float* OWR = (LAS float*)(ob + L2_A); LAS float* OW = (LAS float*)(ob + 2 * L2_A); LAS float* OB = (LAS float*)(ob + 3 * L2_A); LAS float* OKP = (LAS float*)(ob + 4 * L2_A);
                LAS float* VL = (LAS float*)(lds + L2_VL + (cc & 1) * 4096); LAS float* SC = (LAS float*)(lds + L2_SC + (cc & 1) * 256);
                { bf16x8 aw[2], aa[2];
#pragma unroll
                  for (int ks = 0; ks < 2; ++ks) { const int ko = 32 * ks + 8 * q;
                      { float cf[8], pf[8]; UNPACK8(T.lw[ks], cf); UNPACK8(T.lwp[ks], pf); const f32x4 m0 = *(LAS f32x4*)(MUL + ko), m1 = *(LAS f32x4*)(MUL + ko + 4); float o[8];
#pragma unroll
                        for (int e = 0; e < 8; ++e) { const float mu = e < 4 ? m0[e & 3] : m1[e & 3]; o[e] = tanh_(cf[e] + mu * (pf[e] - cf[e])); }
                        v4u w; w.x = pk2(o[0], o[1]); w.y = pk2(o[2], o[3]); w.z = pk2(o[4], o[5]); w.w = pk2(o[6], o[7]); aw[ks] = __builtin_bit_cast(bf16x8, w); }
                      { float cf[8], pf[8]; UNPACK8(T.la[ks], cf); UNPACK8(T.lap[ks], pf); const f32x4 m0 = *(LAS f32x4*)(MUL + 64 + ko), m1 = *(LAS f32x4*)(MUL + 64 + ko + 4); float o[8];
#pragma unroll
                        for (int e = 0; e < 8; ++e) { const float mu = e < 4 ? m0[e & 3] : m1[e & 3]; o[e] = cf[e] + mu * (pf[e] - cf[e]); }
                        v4u w; w.x = pk2(o[0], o[1]); w.y = pk2(o[2], o[3]); w.z = pk2(o[4], o[5]); w.w = pk2(o[6], o[7]); aa[ks] = __builtin_bit_cast(bf16x8, w); } }
#pragma unroll
                  for (int nb = 0; nb < 4; ++nb) { const int n = 16 * nb + fr; f32x4 cw = {0.f, 0.f, 0.f, 0.f}, ca = {0.f, 0.f, 0.f, 0.f};
#pragma unroll
                      for (int ks = 0; ks < 2; ++ks) { const bf16x8 bw = *(LAS bf16x8*)(WB + n * WBS + 32 * ks + 8 * q), ba = *(LAS bf16x8*)(WB + 64 * WBS + n * WBS + 32 * ks + 8 * q);
                          cw = __builtin_amdgcn_mfma_f32_16x16x32_bf16(aw[ks], bw, cw, 0, 0, 0); ca = __builtin_amdgcn_mfma_f32_16x16x32_bf16(aa[ks], ba, ca, 0, 0, 0); }
                      if ((q >> 1) == (w4 & 1)) {
#pragma unroll
                          for (int r = 0; r < 4; ++r) { const int tok = 16 * tb + 4 * q + r; OW[tok * OPS + 16 * nb + fr] = cw[r]; OB[tok * OPS + 16 * nb + fr] = ca[r]; } } } }
                LDS_WAIT(); asm volatile("" ::: "memory");
                { float rc[8], kc[8], vc[8], t8[8]; const int cc0 = 8 * pcg;
                  { UNPACK8(T.r, rc); UNPACK8(T.rp, t8); const f32x4 m0 = *(LAS f32x4*)(CST + cc0), m1 = *(LAS f32x4*)(CST + cc0 + 4);
#pragma unroll
                    for (int e = 0; e < 8; ++e) rc[e] += (e < 4 ? m0[e & 3] : m1[e & 3]) * (t8[e] - rc[e]); }
                  { UNPACK8(T.k, kc); UNPACK8(T.kp, t8); const f32x4 m0 = *(LAS f32x4*)(CST + 64 + cc0), m1 = *(LAS f32x4*)(CST + 64 + cc0 + 4);
#pragma unroll
                    for (int e = 0; e < 8; ++e) kc[e] += (e < 4 ? m0[e & 3] : m1[e & 3]) * (t8[e] - kc[e]); }
                  { UNPACK8(T.v, vc); UNPACK8(T.vp, t8); const f32x4 m0 = *(LAS f32x4*)(CST + 128 + cc0), m1 = *(LAS f32x4*)(CST + 128 + cc0 + 4);
#pragma unroll
                    for (int e = 0; e < 8; ++e) vc[e] += (e < 4 ? m0[e & 3] : m1[e & 3]) * (t8[e] - vc[e]); }
                  float dec[8], av[8], kku[8], kp[8];
                  { const f32x4 wa0 = *(LAS f32x4*)(OW + ptok * OPS + cc0), wa1 = *(LAS f32x4*)(OW + ptok * OPS + cc0 + 4);
                    const f32x4 aa0 = *(LAS f32x4*)(OB + ptok * OPS + cc0), aa1 = *(LAS f32x4*)(OB + ptok * OPS + cc0 + 4);
                    const f32x4 w00 = *(LAS f32x4*)(CST + 192 + cc0), w01 = *(LAS f32x4*)(CST + 192 + cc0 + 4);
                    const f32x4 a00 = *(LAS f32x4*)(CST + 256 + cc0), a01 = *(LAS f32x4*)(CST + 256 + cc0 + 4);
                    const f32x4 kk0 = *(LAS f32x4*)(CST + 320 + cc0), kk1 = *(LAS f32x4*)(CST + 320 + cc0 + 4);
                    const f32x4 ka0 = *(LAS f32x4*)(CST + 384 + cc0), ka1 = *(LAS f32x4*)(CST + 384 + cc0 + 4);
#pragma unroll
                    for (int e = 0; e < 8; ++e) {
                        const float wl = (e < 4 ? w00[e & 3] : w01[e & 3]) + (e < 4 ? wa0[e & 3] : wa1[e & 3]);
                        dec[e] = __expf(-0.6065306597126334f * sigm(wl));
                        av[e] = sigm((e < 4 ? a00[e & 3] : a01[e & 3]) + (e < 4 ? aa0[e & 3] : aa1[e & 3]));
                        kku[e] = kc[e] * (e < 4 ? kk0[e & 3] : kk1[e & 3]);
                        kp[e] = kc[e] * (1.f + (av[e] - 1.f) * (e < 4 ? ka0[e & 3] : ka1[e & 3])); } }
                  float ss = 0.f;
#pragma unroll
                  for (int e = 0; e < 8; ++e) ss += kku[e] * kku[e];
                  ss = allred8(ss);
                  const float inv = __builtin_amdgcn_rsqf(fmaxf(ss, 1e-24f));
                  const f32x4 rk0 = *(LAS f32x4*)(CST + 448 + cc0), rk1 = *(LAS f32x4*)(CST + 448 + cc0 + 4);
                  float nk[8], bb[8], wr8[8], br = 0.f, kr = 0.f, bon = 0.f;
#pragma unroll
                  for (int e = 0; e < 8; ++e) { const float kk = kku[e] * inv; nk[e] = -kk; bb[e] = kk * av[e]; wr8[e] = dec[e] * rc[e];
                      br += bb[e] * rc[e]; kr += kp[e] * rc[e]; bon += rc[e] * kp[e] * (e < 4 ? rk0[e & 3] : rk1[e & 3]); }
                  br = allred8(br); kr = allred8(kr); bon = allred8(bon);
                  const int o = ptok * OPS + 8 * pcg;
                  *(LAS f32x4*)(ONKK + o) = (f32x4){nk[0], nk[1], nk[2], nk[3]}; *(LAS f32x4*)(ONKK + o + 4) = (f32x4){nk[4], nk[5], nk[6], nk[7]};
                  *(LAS f32x4*)(OWR + o) = (f32x4){wr8[0], wr8[1], wr8[2], wr8[3]}; *(LAS f32x4*)(OWR + o + 4) = (f32x4){wr8[4], wr8[5], wr8[6], wr8[7]};
                  *(LAS f32x4*)(OW + o) = (f32x4){dec[0], dec[1], dec[2], dec[3]}; *(LAS f32x4*)(OW + o + 4) = (f32x4){dec[4], dec[5], dec[6], dec[7]};
                  *(LAS f32x4*)(OB + o) = (f32x4){bb[0], bb[1], bb[2], bb[3]}; *(LAS f32x4*)(OB + o + 4) = (f32x4){bb[4], bb[5], bb[6], bb[7]};
                  *(LAS f32x4*)(OKP + o) = (f32x4){kp[0], kp[1], kp[2], kp[3]}; *(LAS f32x4*)(OKP + o + 4) = (f32x4){kp[4], kp[5], kp[6], kp[7]};
                  if (pcg == 0) *(LAS f32x2*)(SC + 2 * ptok) = (f32x2){br, kr};
                  if (vmine) { const int vo = ptok * 32 + 8 * (pcg & 3);
                      *(LAS f32x4*)(VL + vo) = (f32x4){vc[0], vc[1], vc[2], vc[3]}; *(LAS f32x4*)(VL + vo + 4) = (f32x4){vc[4], vc[5], vc[6], vc[7]};
                      v4u w; w.x = pk2(bon * vc[0], bon * vc[1]); w.y = pk2(bon * vc[2], bon * vc[3]); w.z = pk2(bon * vc[4], bon * vc[5]); w.w = pk2(bon * vc[6], bon * vc[7]);
                      if (!dry) *(v4u*)(BON + (rowbase + (size_t)cc * CH2 + ptok) * DM + C0) = w; }
                }
            }
            __syncthreads();
        }
        { const int c = NCH2;
          const LAS float* YBp = (const LAS float*)(lds + L2_YB + ((c - 1) & 1) * 4096);
          const f32x4 yv = *(const LAS f32x4*)(YBp + ftok * 32 + 4 * pcg); v2u w; w.x = pk2(yv[0], yv[1]); w.y = pk2(yv[2], yv[3]);
          if (!dry) *(v2u*)(Z1 + (rowbase + (size_t)(c - 1) * CH2 + ftok) * NZ1 + ZV + h * 64 + 32 * half + 4 * pcg) = w; }
#undef WK_LOADRAW
    } else {
        const int rl = wave * 8 + (lane >> 3), s = lane & 7;
        f32x2 S01 = {0.f, 0.f}, S23 = {0.f, 0.f}, S45 = {0.f, 0.f}, S67 = {0.f, 0.f};
        __syncthreads();
        for (int c = 0; c < NCH2; ++c) {
            const LAS unsigned char* ob = lds + L2_OP + (c & 1) * L2_OPSZ;
            const LAS float* ONKK = (const LAS float*)ob; const LAS float* OWR = (const LAS float*)(ob + L2_A); const LAS float* OW = (const LAS float*)(ob + 2 * L2_A);
            const LAS float* OB = (const LAS float*)(ob + 3 * L2_A); const LAS float* OKP = (const LAS float*)(ob + 4 * L2_A);
            const LAS float* VL = (const LAS float*)(lds + L2_VL + (c & 1) * 4096); const LAS float* SC = (const LAS float*)(lds + L2_SC + (c & 1) * 256);
            LAS float* YB = (LAS float*)(lds + L2_YB + (c & 1) * 4096);
            float sak = 0.f, y0k = 0.f;
#define WK_LOAD(o, t) do { const int ofs = (t) * OPS + 8 * s; \
              o.nk0 = *(const LAS f32x4*)(ONKK + ofs); o.nk1 = *(const LAS f32x4*)(ONKK + ofs + 4); o.wr0 = *(const LAS f32x4*)(OWR + ofs); o.wr1 = *(const LAS f32x4*)(OWR + ofs + 4); \
              o.w0 = *(const LAS f32x4*)(OW + ofs); o.w1 = *(const LAS f32x4*)(OW + ofs + 4); o.b0 = *(const LAS f32x4*)(OB + ofs); o.b1 = *(const LAS f32x4*)(OB + ofs + 4); \
              o.k0 = *(const LAS f32x4*)(OKP + ofs); o.k1 = *(const LAS f32x4*)(OKP + ofs + 4); o.vi[0] = VL[(t) * 32 + rl]; } while (0)
#define P2(v, i) ((f32x2){v[i], v[(i) + 1]})
#define WK_STEP(o, tl) do { \
              f32x2 ac = pk_mul(S01, P2(o.nk0, 0)); ac = pk_fma(S23, P2(o.nk0, 2), ac); ac = pk_fma(S45, P2(o.nk1, 0), ac); ac = pk_fma(S67, P2(o.nk1, 2), ac); \
              f32x2 ay = pk_mul(S01, P2(o.wr0, 0)); ay = pk_fma(S23, P2(o.wr0, 2), ay); ay = pk_fma(S45, P2(o.wr1, 0), ay); ay = pk_fma(S67, P2(o.wr1, 2), ay); \
              float psa, py; \
              allred8x2_decay(psa, py, ac[0], ac[1], ay[0], ay[1], S01, S23, S45, S67, P2(o.w0, 0), P2(o.w0, 2), P2(o.w1, 0), P2(o.w1, 2)); \
              f32x2 sap; sap[0] = psa; \
              S01 = pk_fma_b(P2(o.b0, 0), sap, S01); S23 = pk_fma_b(P2(o.b0, 2), sap, S23); S45 = pk_fma_b(P2(o.b1, 0), sap, S45); S67 = pk_fma_b(P2(o.b1, 2), sap, S67); \
              S01 = pk_fma_b(P2(o.k0, 0), o.vi, S01); S23 = pk_fma_b(P2(o.k0, 2), o.vi, S23); S45 = pk_fma_b(P2(o.k1, 0), o.vi, S45); S67 = pk_fma_b(P2(o.k1, 2), o.vi, S67); \
              const bool mine = (s == (tl)); sak = mine ? psa : sak; y0k = mine ? py : y0k; } while (0)
            StepOps8 A0, B0; A0.vi[1] = B0.vi[1] = 0.f;
            WK_LOAD(A0, 0);
#pragma unroll 1
            for (int tb = 0; tb < CH2; tb += 8) {
                WK_LOAD(B0, tb + 1); WK_STEP(A0, 0);
                WK_LOAD(A0, tb + 2); WK_STEP(B0, 1);
                WK_LOAD(B0, tb + 3); WK_STEP(A0, 2);
                WK_LOAD(A0, tb + 4); WK_STEP(B0, 3);
                WK_LOAD(B0, tb + 5); WK_STEP(A0, 4);
                WK_LOAD(A0, tb + 6); WK_STEP(B0, 5);
                WK_LOAD(B0, tb + 7); WK_STEP(A0, 6);
                const int tn = (tb + 8) & (CH2 - 1);
                WK_LOAD(A0, tn);     WK_STEP(B0, 7);
                { const int t = tb + s; const f32x2 sc = *(const LAS f32x2*)(SC + 2 * t); YB[t * 32 + rl] = y0k + sak * sc[0] + VL[t * 32 + rl] * sc[1]; }
            }
#undef WK_LOAD
#undef WK_STEP
#undef P2
            __syncthreads();
        }
        if (!dry) { float* so = p.out + O_WKVP + ((size_t)(b * 16 + h) * 64 + 32 * half + rl) * 64 + 8 * s; *(f32x4*)so = (f32x4){S01[0], S01[1], S23[0], S23[1]}; *(f32x4*)(so + 4) = (f32x4){S45[0], S45[1], S67[0], S67[1]}; }
    }
    __syncthreads();
}

__device__ __forceinline__ void wkv_sample(CP& p, LAS unsigned char* lds, bool dry) {
    int tid_l = threadIdx.x; asm volatile("" : "+v"(tid_l)); const int tid = tid_l, lane = tid & 63;
    const int i = tid >> 3, s8 = tid & 7;
    bf16* Z1 = (bf16*)(p.ws + WS_Z1); bf16* BON = (bf16*)(p.ws + WS_BONUS);
    LAS float* TW = (LAS float*)lds; LAS float* TA = TW + 256; LAS float* ONKK = TW + 512; LAS float* OWR = TW + 768; LAS float* OW = TW + 1024;
    LAS float* OB = TW + 1280; LAS float* OKP = TW + 1536; LAS float* VV = TW + 1792; LAS float* SC = TW + 2048; LAS float* YS = TW + 2064;
    const float* Sin = p.in[I_WKV];
    int u = blockIdx.x;
    f32x4 sa0, sa1;
    if (u < DECB * 16) { const float* sp = Sin + ((size_t)u * 64 + i) * 64 + 8 * s8; sa0 = *(const f32x4*)sp; sa1 = *(const f32x4*)(sp + 4); }
    for (; u < DECB * 16; u += gridDim.x) {
        const int b = u >> 4, h = u & 15;
        float S[8] = {sa0[0], sa0[1], sa0[2], sa0[3], sa1[0], sa1[1], sa1[2], sa1[3]};
        { const int un = u + gridDim.x; if (un < DECB * 16) { const float* sp = Sin + ((size_t)un * 64 + i) * 64 + 8 * s8; sa0 = *(const f32x4*)sp; sa1 = *(const f32x4*)(sp + 4); } }
        const int tok = tid >> 6, c = lane, C = h * 64 + c;
        const size_t rowc = (size_t)MP + 4 * b + (tok & 3), rowp = (tok & 3) == 0 ? (size_t)MT + b : rowc - 1;
        float r = 0.f, k = 0.f, v = 0.f;
        if (tid < 256) {
            const bf16* zc = Z1 + rowc * NZ1; const bf16* zp = Z1 + rowp * NZ1; const float* mu = p.in[I_MU];
            r = bf2f(zc[ZR + C]); r += mu[ZR + C] * (bf2f(zp[ZR + C]) - r);
            k = bf2f(zc[ZK + C]); k += mu[ZK + C] * (bf2f(zp[ZK + C]) - k);
            v = bf2f(zc[ZV + C]); v += mu[ZV + C] * (bf2f(zp[ZV + C]) - v);
            float wl = bf2f(zc[ZWL + c]); wl += mu[ZWL + c] * (bf2f(zp[ZWL + c]) - wl);
            float al = bf2f(zc[ZAL + c]); al += mu[ZAL + c] * (bf2f(zp[ZAL + c]) - al);
            TW[tok * 64 + c] = tanh_(wl); TA[tok * 64 + c] = al;
        }
        __syncthreads();
        if (tid < 256) {
            float wp = 0.f, ap = 0.f; const float* w2 = p.in[I_W2] + C; const float* a2 = p.in[I_A2] + C;
#pragma unroll 8
            for (int kk = 0; kk < 64; ++kk) { wp += TW[tok * 64 + kk] * w2[(size_t)kk * DM]; ap += TA[tok * 64 + kk] * a2[(size_t)kk * DM]; }
            const float dec = __expf(-0.6065306597126334f * sigm(p.in[I_W0][C] + wp));
            const float a = sigm(p.in[I_A0][C] + ap);
            const float kku = k * p.in[I_KK][C];
            const float kp = k * (1.f + (a - 1.f) * p.in[I_KA][C]);
            const float ss = wave_sum(kku * kku);
            const float kk = kku / fmaxf(sqrtf(ss), 1e-12f);
            const float bb = kk * a;
            const float br = wave_sum(bb * r), kr = wave_sum(kp * r), bon = wave_sum(r * kp * p.in[I_RK][C]);
            ONKK[tok * 64 + c] = -kk; OWR[tok * 64 + c] = dec * r; OW[tok * 64 + c] = dec; OB[tok * 64 + c] = bb; OKP[tok * 64 + c] = kp; VV[tok * 64 + c] = v;
            if (c == 0) { SC[2 * tok] = br; SC[2 * tok + 1] = kr; }
            if (!dry) BON[rowc * DM + C] = (bf16)f2bf(bon * v);
        }
        __syncthreads();
#pragma unroll
        for (int t = 0; t < 4; ++t) {
            const f32x4 n0 = *(LAS f32x4*)(ONKK + t * 64 + 8 * s8), n1 = *(LAS f32x4*)(ONKK + t * 64 + 8 * s8 + 4);
            const f32x4 q0 = *(LAS f32x4*)(OWR + t * 64 + 8 * s8), q1 = *(LAS f32x4*)(OWR + t * 64 + 8 * s8 + 4);
            const f32x4 w0 = *(LAS f32x4*)(OW + t * 64 + 8 * s8), w1 = *(LAS f32x4*)(OW + t * 64 + 8 * s8 + 4);
            const f32x4 b0 = *(LAS f32x4*)(OB + t * 64 + 8 * s8), b1 = *(LAS f32x4*)(OB + t * 64 + 8 * s8 + 4);
            const f32x4 k0 = *(LAS f32x4*)(OKP + t * 64 + 8 * s8), k1 = *(LAS f32x4*)(OKP + t * 64 + 8 * s8 + 4);
            const float vi = VV[t * 64 + i], br = SC[2 * t], kr = SC[2 * t + 1];
            float psa = 0.f, py = 0.f;
#pragma unroll
            for (int e = 0; e < 8; ++e) { psa += S[e] * (e < 4 ? n0[e & 3] : n1[e & 3]); py += S[e] * (e < 4 ? q0[e & 3] : q1[e & 3]); }
            const float sa = allred8(psa), y0 = allred8(py);
#pragma unroll
            for (int e = 0; e < 8; ++e) S[e] = S[e] * (e < 4 ? w0[e & 3] : w1[e & 3]) + sa * (e < 4 ? b0[e & 3] : b1[e & 3]) + vi * (e < 4 ? k0[e & 3] : k1[e & 3]);
            if (s8 == 0) YS[t * 64 + i] = y0 + sa * br + vi * kr;
        }
        if (!dry) { float* so = p.out + O_WKVS + ((size_t)u * 64 + i) * 64 + 8 * s8; *(f32x4*)so = (f32x4){S[0], S[1], S[2], S[3]}; *(f32x4*)(so + 4) = (f32x4){S[4], S[5], S[6], S[7]}; }
        __syncthreads();
        if (tid < 256 && !dry) Z1[rowc * NZ1 + ZV + C] = (bf16)f2bf(YS[tok * 64 + c]);
        __syncthreads();
    }
}

constexpr int LL_XR = 0, LL_UB = 8704, LL_UF = 17920, LL_PR = 26112, LL_PI = 34560, LL_CA = 43008, LL_CB = 45056, LL_HC = 47104;
__device__ __forceinline__ void lru_prompt(CP& p, LAS unsigned char* lds, int unit, bool dry) {
    int tid_l = threadIdx.x; asm volatile("" : "+v"(tid_l)); const int tid = tid_l, wave = tid >> 6, lane = tid & 63;
    const int b = unit >> 5, n = (unit >> 1) & 15, hf = unit & 1;
    const int ptok = tid >> 3, pcg = tid & 7;
    bf16* Z1 = (bf16*)(p.ws + WS_Z1);
    const bf16* waT = (const bf16*)(p.ws + WS_SMALL) + 262144; const bf16* wiT = waT + 65536;
    const size_t rowbase = (size_t)b * SEQ;
    LAS bf16* XR = (LAS bf16*)(lds + LL_XR); LAS bf16* UB = (LAS bf16*)(lds + LL_UB); LAS float* UF = (LAS float*)(lds + LL_UF);
    LAS float* PR = (LAS float*)(lds + LL_PR); LAS float* PI = (LAS float*)(lds + LL_PI); LAS float* CA = (LAS float*)(lds + LL_CA);
    LAS float* CB = (LAS float*)(lds + LL_CB); LAS float* HC = (LAS float*)(lds + LL_HC);
    if (tid < 96) ((LAS unsigned*)XR)[tid] = 0u;
    if (tid < 32) HC[tid] = 0.f;
    const int mb = wave & 3, gate = wave >> 2, fr = lane & 15, q = lane >> 4;
    bf16x8 Bf[2][2];
#pragma unroll
    for (int nb = 0; nb < 2; ++nb)
#pragma unroll
        for (int ks = 0; ks < 2; ++ks) Bf[nb][ks] = *(const bf16x8*)((gate ? wiT : waT) + (size_t)n * 4096 + (32 * hf + 16 * nb + fr) * 64 + 32 * ks + 8 * q);
    const int dl = tid & 31, sub = tid >> 5, Cs = 64 * n + 32 * hf + dl;
    const int etok = tid >> 3, dg = tid & 7, Ce = 64 * n + 32 * hf + 4 * dg;
    const f32x4 ba4 = *(const f32x4*)(p.in[I_BA] + Ce), bi4 = *(const f32x4*)(p.in[I_BI] + Ce), lam4 = *(const f32x4*)(p.in[I_LAM] + Ce);
    f32x4 sp4;
#pragma unroll
    for (int e = 0; e < 4; ++e) sp4[e] = -8.f * __logf(1.f + __expf(-lam4[e]));
    const int Cc = 64 * n + 8 * pcg;
    v4u px = *(const v4u*)(Z1 + (rowbase + ptok) * NZ1 + ZXB + Cc);
    float hlast = 0.f;
    const f32x4 cb0 = *(const f32x4*)(p.in[I_CB] + Cc), cb1 = *(const f32x4*)(p.in[I_CB] + Cc + 4);
    f32x4 cw0[4], cw1[4];
#pragma unroll
    for (int j = 0; j < 4; ++j) { cw0[j] = *(const f32x4*)(p.in[I_CW] + j * DM + Cc); cw1[j] = *(const f32x4*)(p.in[I_CW] + j * DM + Cc + 4); }
    unsigned short gbn[4];
#pragma unroll
    for (int i2 = 0; i2 < 4; ++i2) gbn[i2] = Z1[(rowbase + 4 * sub + i2) * NZ1 + ZGB + Cs];
    for (int c = 0; c < SEQ / 64; ++c) {
        if (ptok >= 61 && c > 0) *(LAS v4u*)(XR + (ptok - 61) * 64 + 8 * pcg) = *(LAS v4u*)(XR + (3 + ptok) * 64 + 8 * pcg);
        *(LAS v4u*)(XR + (3 + ptok) * 64 + 8 * pcg) = px;
        __syncthreads();
        if (c + 1 < SEQ / 64) px = *(const v4u*)(Z1 + (rowbase + (size_t)(c + 1) * 64 + ptok) * NZ1 + ZXB + Cc);
        unsigned short gbr[4];
#pragma unroll
        for (int i2 = 0; i2 < 4; ++i2) gbr[i2] = gbn[i2];
        if (c + 1 < SEQ / 64) {
#pragma unroll
            for (int i2 = 0; i2 < 4; ++i2) gbn[i2] = Z1[(rowbase + (size_t)(c + 1) * 64 + 4 * sub + i2) * NZ1 + ZGB + Cs]; }
        { float u8[8];
#pragma unroll
          for (int e = 0; e < 8; ++e) u8[e] = e < 4 ? cb0[e & 3] : cb1[e & 3];
#pragma unroll
          for (int j = 0; j < 4; ++j) { const v4u xu = *(LAS v4u*)(XR + (ptok + j) * 64 + 8 * pcg); float xf[8]; UNPACK8(xu, xf);
#pragma unroll
              for (int e = 0; e < 8; ++e) u8[e] += (e < 4 ? cw0[j][e & 3] : cw1[j][e & 3]) * xf[e]; }
          v4u w; w.x = pk2(u8[0], u8[1]); w.y = pk2(u8[2], u8[3]); w.z = pk2(u8[4], u8[5]); w.w = pk2(u8[6], u8[7]);
          *(LAS v4u*)(UB + ptok * 72 + 8 * pcg) = w;
          if ((pcg >> 2) == hf) { *(LAS f32x4*)(UF + ptok * 32 + 8 * (pcg & 3)) = (f32x4){u8[0], u8[1], u8[2], u8[3]}; *(LAS f32x4*)(UF + ptok * 32 + 8 * (pcg & 3) + 4) = (f32x4){u8[4], u8[5], u8[6], u8[7]}; }
        }
        __syncthreads();
        { const bf16x8 A0 = *(LAS bf16x8*)(UB + (16 * mb + fr) * 72 + 8 * q), A1 = *(LAS bf16x8*)(UB + (16 * mb + fr) * 72 + 32 + 8 * q);
          LAS float* P = gate ? PI : PR;
#pragma unroll
          for (int nb = 0; nb < 2; ++nb) { f32x4 acc = {0.f, 0.f, 0.f, 0.f};
              acc = __builtin_amdgcn_mfma_f32_16x16x32_bf16(A0, Bf[nb][0], acc, 0, 0, 0); acc = __builtin_amdgcn_mfma_f32_16x16x32_bf16(A1, Bf[nb][1], acc, 0, 0, 0);
#pragma unroll
              for (int r = 0; r < 4; ++r) P[(16 * mb + 4 * q + r) * 33 + 16 * nb + fr] = acc[r]; } }
        __syncthreads();
        {
#pragma unroll
          for (int e = 0; e < 4; ++e) { const int o = etok * 33 + 4 * dg + e;
              const float rg = sigm(PR[o] + ba4[e]), ig = sigm(PI[o] + bi4[e]);
              const float a = __expf(sp4[e] * rg);
              float mult = sqrtf(fmaxf(1.f - a * a, 0.f)); if (c == 0 && etok == 0) mult = 1.f;
              PR[o] = a; PI[o] = mult * ig * UF[etok * 32 + 4 * dg + e]; } }
        __syncthreads();
        { float av[4], bx[4];
#pragma unroll
          for (int i2 = 0; i2 < 4; ++i2) { av[i2] = PR[(4 * sub + i2) * 33 + dl]; bx[i2] = PI[(4 * sub + i2) * 33 + dl]; }
          float hl = 0.f, ap = 1.f;
#pragma unroll
          for (int i2 = 0; i2 < 4; ++i2) { hl = av[i2] * hl + bx[i2]; ap *= av[i2]; }
          CA[sub * 32 + dl] = ap; CB[sub * 32 + dl] = hl;
          float h = HC[dl];
          __syncthreads();
          for (int s2 = 0; s2 < sub; ++s2) h = CA[s2 * 32 + dl] * h + CB[s2 * 32 + dl];
#pragma unroll
          for (int i2 = 0; i2 < 4; ++i2) { h = av[i2] * h + bx[i2];
              if (!dry) Z1[(rowbase + (size_t)c * 64 + 4 * sub + i2) * NZ1 + ZGB + Cs] = (bf16)f2bf(h * gelu_tanh(bf2f(gbr[i2]))); }
          if (sub == 15) { HC[dl] = h; hlast = h; }
        }
        __syncthreads();
    }
    if (sub == 15 && !dry) p.out[O_LRUP + (size_t)b * DM + Cs] = hlast;
    if (hf == 0 && tid < 192 && !dry) { const int j = tid >> 6, cc = tid & 63; p.out[O_CONVP + ((size_t)b * 3 + j) * DM + 64 * n + cc] = bf2f(XR[(64 + j) * 64 + cc]); }
    __syncthreads();
}

__device__ __forceinline__ void lru_sample(CP& p, LAS unsigned char* lds, bool dry) {
    int tid_l = threadIdx.x; asm volatile("" : "+v"(tid_l)); const int tid = tid_l;
    bf16* Z1 = (bf16*)(p.ws + WS_Z1);
    LAS float* U = (LAS float*)lds;
    for (int b = blockIdx.x; b < DECB; b += gridDim.x) {
        const int C = 2 * tid, n = C >> 6, d = C & 63;
        float xp0[7], xp1[7];
#pragma unroll
        for (int j = 0; j < 3; ++j) { const f32x2 v = *(const f32x2*)(p.in[I_CONV] + ((size_t)b * 3 + j) * DM + C); xp0[j] = v[0]; xp1[j] = v[1]; }
#pragma unroll
        for (int j = 0; j < 4; ++j) { const unsigned v = *(const unsigned*)(Z1 + ((size_t)MP + 4 * b + j) * NZ1 + ZXB + C); xp0[3 + j] = lo16(v); xp1[3 + j] = hi16(v); }
        { const f32x2 cb = *(const f32x2*)(p.in[I_CB] + C); f32x2 cw[4];
#pragma unroll
          for (int j = 0; j < 4; ++j) cw[j] = *(const f32x2*)(p.in[I_CW] + j * DM + C);
#pragma unroll
          for (int t = 0; t < 4; ++t) { float u0 = cb[0], u1 = cb[1];
#pragma unroll
              for (int j = 0; j < 4; ++j) { u0 += cw[j][0] * xp0[t + j]; u1 += cw[j][1] * xp1[t + j]; }
              *(LAS f32x2*)(U + t * DM + C) = (f32x2){u0, u1}; } }
        __syncthreads();
        float pr[4][2], pi[4][2];
#pragma unroll
        for (int t = 0; t < 4; ++t) { pr[t][0] = pr[t][1] = pi[t][0] = pi[t][1] = 0.f; }
        const float* wa = p.in[I_WA] + (size_t)n * 4096 + d; const float* wi = p.in[I_WI] + (size_t)n * 4096 + d;
#pragma unroll 4
        for (int cc = 0; cc < 64; ++cc) { const f32x2 a = *(const f32x2*)(wa + cc * 64), i2 = *(const f32x2*)(wi + cc * 64);
#pragma unroll
            for (int t = 0; t < 4; ++t) { const float uu = U[t * DM + 64 * n + cc]; pr[t][0] += uu * a[0]; pr[t][1] += uu * a[1]; pi[t][0] += uu * i2[0]; pi[t][1] += uu * i2[1]; } }
        const f32x2 ba = *(const f32x2*)(p.in[I_BA] + C), bi = *(const f32x2*)(p.in[I_BI] + C), lam = *(const f32x2*)(p.in[I_LAM] + C), h0 = *(const f32x2*)(p.in[I_LRU] + (size_t)b * DM + C);
        float h[2] = {h0[0], h0[1]};
        const float sp[2] = {-8.f * __logf(1.f + __expf(-lam[0])), -8.f * __logf(1.f + __expf(-lam[1]))};
#pragma unroll
        for (int t = 0; t < 4; ++t) { const f32x2 uu = *(LAS f32x2*)(U + t * DM + C);
            bf16* zp = Z1 + ((size_t)MP + 4 * b + t) * NZ1 + ZGB + C; const unsigned g = *(const unsigned*)zp; float yb[2];
#pragma unroll
            for (int e = 0; e < 2; ++e) { const float rg = sigm(pr[t][e] + ba[e]), ig = sigm(pi[t][e] + bi[e]); const float a = __expf(sp[e] * rg);
                const float mult = sqrtf(fmaxf(1.f - a * a, 0.f)); h[e] = a * h[e] + mult * ig * uu[e]; yb[e] = h[e] * gelu_tanh(e ? hi16(g) : lo16(g)); }
            if (!dry) *(unsigned*)zp = pk2(yb[0], yb[1]); }
        if (!dry) *(f32x2*)(p.out + O_LRUS + (size_t)b * DM + C) = (f32x2){h[0], h[1]};
#pragma unroll
        for (int j = 0; j < 3; ++j) if (!dry) *(f32x2*)(p.out + O_CONVS + ((size_t)b * 3 + j) * DM + C) = (f32x2){xp0[4 + j], xp1[4 + j]};
        __syncthreads();
    }
}

__device__ __forceinline__ void phase_merge(CP& p, LAS unsigned char* lds) {
    int tid_l = threadIdx.x; asm volatile("" : "+v"(tid_l)); const int tid = tid_l, wave = tid >> 6, lane = tid & 63, fr = lane & 15, q = lane >> 4;
    const bf16* Z1 = (const bf16*)(p.ws + WS_Z1); const bf16* BON = (const bf16*)(p.ws + WS_BONUS); const bf16* Zg = (const bf16*)p.out;
    const bf16* g2T = (const bf16*)(p.ws + WS_SMALL) + 131072; bf16* MG = (bf16*)(p.ws + WS_XB);
    LAS float* GL = (LAS float*)lds;
    const int tk = tid >> 7, cg8 = tid & 127, Cm = 8 * cg8;
    const f32x4 lg0 = *(const f32x4*)(p.in[I_LNXG] + Cm), lg1 = *(const f32x4*)(p.in[I_LNXG] + Cm + 4), lb0 = *(const f32x4*)(p.in[I_LNXB] + Cm), lb1 = *(const f32x4*)(p.in[I_LNXB] + Cm + 4);
    for (int unit = blockIdx.x; unit < MT / 16; unit += gridDim.x) {
        const int m0 = unit * 16;
        {
          const int m = m0 + fr; size_t prow; bool pz = false;
          if (m < MP) { if ((m & (SEQ - 1)) == 0) { pz = true; prow = m; } else prow = m - 1; } else { const int ms = m - MP; prow = (ms & 3) == 0 ? (size_t)MT + (ms >> 2) : (size_t)m - 1; }
          bf16x8 Tf[4];
#pragma unroll
          for (int ks = 0; ks < 4; ++ks) { const int ko = 32 * ks + 8 * q;
              const v4u cu = *(const v4u*)(Z1 + (size_t)m * NZ1 + ZGL + ko); v4u pu = *(const v4u*)(Z1 + prow * NZ1 + ZGL + ko); if (pz) pu = (v4u){0u, 0u, 0u, 0u};
              float cf[8], pf[8]; UNPACK8(cu, cf); UNPACK8(pu, pf);
              const f32x4 mu0 = *(const f32x4*)(p.in[I_MU] + ZGL + ko), mu1 = *(const f32x4*)(p.in[I_MU] + ZGL + ko + 4); float o[8];
#pragma unroll
              for (int e = 0; e < 8; ++e) o[e] = sigm(cf[e] + (e < 4 ? mu0[e & 3] : mu1[e & 3]) * (pf[e] - cf[e]));
              v4u w; w.x = pk2(o[0], o[1]); w.y = pk2(o[2], o[3]); w.z = pk2(o[4], o[5]); w.w = pk2(o[6], o[7]); Tf[ks] = __builtin_bit_cast(bf16x8, w); }
#pragma unroll 2
          for (int nbi = 0; nbi < 8; ++nbi) { const int nb = wave * 8 + nbi; f32x4 acc = {0.f, 0.f, 0.f, 0.f};
#pragma unroll
              for (int ks = 0; ks < 4; ++ks) { const bf16x8 gf = *(const bf16x8*)(g2T + (size_t)(16 * nb + fr) * 128 + 32 * ks + 8 * q); acc = __builtin_amdgcn_mfma_f32_16x16x32_bf16(gf, Tf[ks], acc, 0, 0, 0); }
              *(LAS f32x4*)(GL + fr * 1028 + 16 * nb + 4 * q) = acc; }
        }
        __syncthreads();
#pragma unroll 1
        for (int ps = 0; ps < 4; ++ps) {
            const int tok = 4 * ps + tk; const size_t m = (size_t)m0 + tok;
            const v4u yu = *(const v4u*)(Z1 + m * NZ1 + ZV + Cm), bu = *(const v4u*)(BON + m * DM + Cm), ybu = *(const v4u*)(Z1 + m * NZ1 + ZGB + Cm);
            const v4u gau = *(const v4u*)(Zg + m * 2048 + Cm), gbu = *(const v4u*)(Zg + m * 2048 + 1024 + Cm);
            const f32x4 g0 = *(LAS f32x4*)(GL + tok * 1028 + Cm), g1 = *(LAS f32x4*)(GL + tok * 1028 + Cm + 4);
            float y[8], bo[8], yb[8], ga[8], gb[8]; UNPACK8(yu, y); UNPACK8(bu, bo); UNPACK8(ybu, yb); UNPACK8(gau, ga); UNPACK8(gbu, gb);
            float sm = 0.f;
#pragma unroll
            for (int e = 0; e < 8; ++e) sm += y[e];
            const float mean = allred8(sm) * (1.f / 64.f); float sq = 0.f;
#pragma unroll
            for (int e = 0; e < 8; ++e) { y[e] -= mean; sq += y[e] * y[e]; }
            const float rstd = __builtin_amdgcn_rsqf(allred8(sq) * (1.f / 64.f) + GN_EPS);
            float o[8];
#pragma unroll
            for (int e = 0; e < 8; ++e) { const float yn = y[e] * rstd * (e < 4 ? lg0[e & 3] : lg1[e & 3]) + (e < 4 ? lb0[e & 3] : lb1[e & 3]);
                const float yA = (yn + bo[e]) * (e < 4 ? g0[e & 3] : g1[e & 3]); o[e] = sigm(ga[e]) * yA + sigm(gb[e]) * yb[e]; }
            v4u w; w.x = pk2(o[0], o[1]); w.y = pk2(o[2], o[3]); w.z = pk2(o[4], o[5]); w.w = pk2(o[6], o[7]);
            *(v4u*)(MG + m * DM + Cm) = w;
        }
        __syncthreads();
    }
}


template <bool RES_BF16> __device__ __forceinline__ void mini_gemm_tail(LAS unsigned char* lds, const bf16* A, int lda, const bf16* Bt, int K, const float* resF, const bf16* resH, bf16* out) {
    int tid_l = threadIdx.x; asm volatile("" : "+v"(tid_l)); const int tid = tid_l, wave = tid >> 6, lane = tid & 63, fr = lane & 15, q = lane >> 4;
    LAS float* RED = (LAS float*)lds;
    for (int task = blockIdx.x; task < 256; task += gridDim.x) {
        const int row0 = MP + 32 * (task >> 4), col0 = 64 * (task & 15);
        const int kw = K >> 3, kb = wave * kw;
        f32x4 acc[2][4];
#pragma unroll
        for (int mb = 0; mb < 2; ++mb)
#pragma unroll
            for (int nb = 0; nb < 4; ++nb) acc[mb][nb] = (f32x4){0.f, 0.f, 0.f, 0.f};
        const bf16* ap = A + (size_t)(row0 + fr) * lda + kb + 8 * q; const bf16* bp = Bt + (size_t)(col0 + fr) * K + kb + 8 * q;
#pragma unroll 2
        for (int k0 = 0; k0 < kw; k0 += 32) {
            bf16x8 af[2], bf[4];
#pragma unroll
            for (int mb = 0; mb < 2; ++mb) af[mb] = *(const bf16x8*)(ap + (size_t)(16 * mb) * lda + k0);
#pragma unroll
            for (int nb = 0; nb < 4; ++nb) bf[nb] = *(const bf16x8*)(bp + (size_t)(16 * nb) * K + k0);
#pragma unroll
            for (int mb = 0; mb < 2; ++mb)
#pragma unroll
                for (int nb = 0; nb < 4; ++nb) acc[mb][nb] = __builtin_amdgcn_mfma_f32_16x16x32_bf16(bf[nb], af[mb], acc[mb][nb], 0, 0, 0);
        }
#pragma unroll
        for (int mb = 0; mb < 2; ++mb)
#pragma unroll
            for (int nb = 0; nb < 4; ++nb) *(LAS f32x4*)(RED + wave * 2048 + (16 * mb + fr) * 64 + 16 * nb + 4 * q) = acc[mb][nb];
        __syncthreads();
        { const int r = tid >> 4, c4 = (tid & 15) * 4; f32x4 sum = *(LAS f32x4*)(RED + r * 64 + c4);
#pragma unroll
          for (int w = 1; w < 8; ++w) sum += *(LAS f32x4*)(RED + w * 2048 + r * 64 + c4);
          const size_t o = (size_t)(row0 + r) * DM + col0 + c4; f32x4 x;
          if (RES_BF16) { const v2u hx = *(const v2u*)(resH + o); x = (f32x4){lo16(hx.x), hi16(hx.x), lo16(hx.y), hi16(hx.y)}; } else x = *(const f32x4*)(resF + o);
          sum += x * ALPHA; *(v2u*)(out + o) = (v2u){pk2(sum[0], sum[1]), pk2(sum[2], sum[3])}; }
        __syncthreads();
    }
}

template <bool FINAL> __device__ __forceinline__ void phase_ln(CP& p, const float* g, const float* bb) {
    int tid_l = threadIdx.x; asm volatile("" : "+v"(tid_l)); const int tid = tid_l, wave = tid >> 6, lane = tid & 63;
    const bf16* PRE = (const bf16*)(p.ws + WS_H1); bf16* H1B = (bf16*)(p.ws + WS_H1B);
    f32x4 gv[4], bv[4];
#pragma unroll
    for (int j = 0; j < 4; ++j) { gv[j] = *(const f32x4*)(g + 16 * lane + 4 * j); bv[j] = *(const f32x4*)(bb + 16 * lane + 4 * j); }
    const int m0 = blockIdx.x * 8 + wave, mstep = gridDim.x * 8;
    v4u n0 = {0u, 0u, 0u, 0u}, n1 = n0;
    if (m0 < MT) { n0 = *(const v4u*)(PRE + (size_t)m0 * DM + 16 * lane); n1 = *(const v4u*)(PRE + (size_t)m0 * DM + 16 * lane + 8); }
    for (int m = m0; m < MT; m += mstep) {
        float x[16]; UNPACK8(n0, x); { float* x8 = x + 8; UNPACK8(n1, x8); }
        if (m + mstep < MT) { n0 = *(const v4u*)(PRE + (size_t)(m + mstep) * DM + 16 * lane); n1 = *(const v4u*)(PRE + (size_t)(m + mstep) * DM + 16 * lane + 8); }
        float sm = 0.f;
#pragma unroll
        for (int e = 0; e < 16; ++e) sm += x[e];
        const float mean = wave_sum(sm) * (1.f / DM); float s2 = 0.f;
#pragma unroll
        for (int e = 0; e < 16; ++e) { x[e] -= mean; s2 += x[e] * x[e]; }
        const float rstd = 1.f / sqrtf(wave_sum(s2) * (1.f / DM) + LN_EPS);
#pragma unroll
        for (int e = 0; e < 16; ++e) x[e] = x[e] * rstd * gv[e >> 2][e & 3] + bv[e >> 2][e & 3];
        if (FINAL) {
#pragma unroll
            for (int j = 0; j < 4; ++j) *(f32x4*)(p.out + O_Y + (size_t)m * DM + 16 * lane + 4 * j) = (f32x4){x[4 * j], x[4 * j + 1], x[4 * j + 2], x[4 * j + 3]};
        } else {
            *(v4u*)(H1B + (size_t)m * DM + 16 * lane) = (v4u){pk2(x[0], x[1]), pk2(x[2], x[3]), pk2(x[4], x[5]), pk2(x[6], x[7])};
            *(v4u*)(H1B + (size_t)m * DM + 16 * lane + 8) = (v4u){pk2(x[8], x[9]), pk2(x[10], x[11]), pk2(x[12], x[13]), pk2(x[14], x[15])}; }
    }
}

__global__ void __launch_bounds__(512, 2) hybrid_step_kernel(Params p_unused) {
    CP* pp = (CP*)__builtin_amdgcn_kernarg_segment_ptr();
#define p (*launder(pp))
    extern __shared__ __attribute__((aligned(16))) unsigned char lds_raw[];
    LAS unsigned char* lds = (LAS unsigned char*)lds_raw;
    volatile LAS unsigned* MISC = (volatile LAS unsigned*)(lds + MISC_OFF);
    if (threadIdx.x < 16) MISC[threadIdx.x] = 0u;
    __syncthreads();
    XcdBarrier bar = xcd_barrier_post((unsigned*)(p.ws + WS_CTL) + CW_BAR, MISC + 8);
    if (p.never) cg::this_grid().sync();
    const int G = gridDim.x, bx = blockIdx.x;

    phase0(p, lds);
#ifdef PROBE_P0M
    if (p.never == 0) { __syncthreads(); phase0(p, lds); }
#endif

#ifdef PROBE_INSTR
    { float x0 = threadIdx.x, x1 = x0 + 1.f, x2 = x0 + 2.f, x3 = x0 + 3.f, x4 = x0 + 4.f, x5 = x0 + 5.f, x6 = x0 + 6.f, x7 = x0 + 7.f; const float kf = 0.999f; const unsigned hh = 0x3c003c00u; f32x2 kp = {0.999f, 0.998f}; f32x2 x0p = {x0, x1}, x1p = {x1, x2}, x2p = {x2, x3}, x3p = {x3, x4}, x4p = {x4, x5}, x5p = {x5, x6}, x6p = {x6, x7}, x7p = {x7, x0};
      const int nit = (p.never == 0 ? 20000 : 1);
      for (int it = 0; it < nit; ++it) {
#if PROBE_INSTR == 1
#define PI(x) asm volatile("v_fma_f32 %0, %0, %1, %0" : "+v"(x) : "v"(kf))
#elif PROBE_INSTR == 2
#define PI(x) asm volatile("v_fma_mix_f32 %0, %1, %0, %0 op_sel_hi:[1,0,0]" : "+v"(x) : "v"(hh))
#elif PROBE_INSTR == 3
#define PI(x) asm volatile("v_add_f32_dpp %0, %0, %0 quad_perm:[1,0,3,2] row_mask:0xf bank_mask:0xf bound_ctrl:1" : "+v"(x))
#elif PROBE_INSTR == 4
#define PI(x) asm volatile("v_pk_fma_f32 %0, %0, %1, %0" : "+v"(x##p) : "v"(kp))

#endif
#if PROBE_INSTR == 4
          static_assert(true, "");
#endif
          PI(x0); PI(x1); PI(x2); PI(x3); PI(x4); PI(x5); PI(x6); PI(x7);
      }
      x0 += x0p[0] + x1p[1] + x2p[0] + x3p[1] + x4p[0] + x5p[1] + x6p[0] + x7p[1];
      if (x0 + x1 + x2 + x3 + x4 + x5 + x6 + x7 == 123.456f) ((float*)(p.ws + WS_CTL))[20000] = x0; }
#endif
    xcd_barrier(bar);
    { pg8::Gemm g{(const pg8::bf16_t*)(p.ws + WS_XB), (const pg8::bf16_t*)(p.ws + WS_WINT), MPAD, NIN, 1024}; pg8::StaticOrder S; S.init(MPAD, NIN, G, bx);
      EpiZ E{(bf16*)(p.ws + WS_Z1), (bf16*)p.out};
      pg8::gemm_phase<EpiZ, pg8::StaticOrder, true, true>(lds, g, S, E); }
    xcd_barrier(bar);
#ifdef PROBE_WKVP
    for (int u = bx; u < 256; u += G) wkv_prompt2(p, lds, u, p.never == 0);
#endif
    for (int u = bx; u < 256; u += G) wkv_prompt2(p, lds, u, p.never != 0);
#ifdef PROBE_WKVS
    wkv_sample(p, lds, p.never == 0);
#endif
    wkv_sample(p, lds, p.never != 0);
#ifdef PROBE_LRUP
    for (int u = bx; u < 256; u += G) lru_prompt(p, lds, u, p.never == 0);
#endif
    for (int u = bx; u < 256; u += G) lru_prompt(p, lds, u, p.never != 0);
#ifdef PROBE_LRUS
    lru_sample(p, lds, p.never == 0);
#endif
    lru_sample(p, lds, p.never != 0);
    xcd_barrier(bar);
    phase_merge(p, lds);
#ifdef PROBE_P0M
    if (p.never == 0) { __syncthreads(); phase_merge(p, lds); }
#endif
    xcd_barrier(bar);
    phase_convert_ffn(p, lds);
    __syncthreads();
    { pg8::Gemm g{(const pg8::bf16_t*)(p.ws + WS_XB), (const pg8::bf16_t*)(p.ws + WS_WOT), MP, 1024, 1024}; pg8::StaticOrder S; S.init(MP, 1024, G, bx);
      EpiResB<false> E{p.in[I_XP], p.in[I_XS], nullptr, (bf16*)(p.ws + WS_H1)};
      pg8::gemm_phase<EpiResB<false>, pg8::StaticOrder, true, true>(lds, g, S, E); }
    __syncthreads();
    mini_gemm_tail<false>(lds, (const bf16*)(p.ws + WS_XB), 1024, (const bf16*)(p.ws + WS_WOT), 1024, p.in[I_XS] - (size_t)MP * DM, nullptr, (bf16*)(p.ws + WS_H1));
    xcd_barrier(bar);
    phase_ln<false>(p, p.in[I_LN1G], p.in[I_LN1B]);
    xcd_barrier(bar);
    { pg8::Gemm g{(const pg8::bf16_t*)(p.ws + WS_H1B), (const pg8::bf16_t*)(p.ws + WS_WGUT), MT, 2 * DFF, 1024}; pg8::StaticOrder S; S.init(MT, 2 * DFF, G, bx);
      EpiSwi E{(bf16*)(p.ws + WS_ACT)};
      pg8::gemm_phase<EpiSwi, pg8::StaticOrder, true, true>(lds, g, S, E); }
    xcd_barrier(bar);
    { pg8::Gemm g{(const pg8::bf16_t*)(p.ws + WS_ACT), (const pg8::bf16_t*)(p.ws + WS_WDT), MP, 1024, DFF}; pg8::StaticOrder S; S.init(MP, 1024, G, bx);
      EpiResB<true> E{nullptr, nullptr, (const bf16*)(p.ws + WS_H1B), (bf16*)(p.ws + WS_H1)};
      pg8::gemm_phase<EpiResB<true>, pg8::StaticOrder, true, true>(lds, g, S, E); }
    __syncthreads();
    mini_gemm_tail<true>(lds, (const bf16*)(p.ws + WS_ACT), DFF, (const bf16*)(p.ws + WS_WDT), DFF, nullptr, (const bf16*)(p.ws + WS_H1B), (bf16*)(p.ws + WS_H1));
    xcd_barrier(bar);
    phase_ln<true>(p, p.in[I_LN2G], p.in[I_LN2B]);
#undef p
}

extern "C" void kernel_launch(void* const* d_in, const int* in_sizes, int n_in, void* d_out, int out_size, void* d_ws, size_t ws_size, hipStream_t stream) {
    static int grid = 0;
    if (grid == 0) {
        int dev = 0, cus = 0, per_cu = 0;
        if (n_in != 33 || ws_size < 256 * MiB) { fprintf(stderr, "kernel_launch: unexpected n_in %d / ws %zu\n", n_in, ws_size); grid = -1; return; }
        hipGetDevice(&dev); hipDeviceGetAttribute(&cus, hipDeviceAttributeMultiprocessorCount, dev);
        if (hipFuncSetAttribute((const void*)hybrid_step_kernel, hipFuncAttributeMaxDynamicSharedMemorySize, LDS_BYTES) != hipSuccess) { fprintf(stderr, "kernel_launch: hipFuncSetAttribute failed\n"); grid = -1; return; }
        if (hipOccupancyMaxActiveBlocksPerMultiprocessor(&per_cu, (const void*)hybrid_step_kernel, 512, LDS_BYTES) != hipSuccess || per_cu < 1) { fprintf(stderr, "kernel_launch: occupancy query says %d blocks per CU\n", per_cu); }
        (void)hipGetLastError();
        grid = cus;
    }
    if (grid < 0) return;
    (void)hipMemsetAsync((char*)d_ws + WS_CTL, 0, CTL_ZERO_BYTES, stream);
    Params p{};
    for (int i = 0; i < 33; ++i) p.in[i] = (const float*)d_in[i];
    p.out = (float*)d_out; p.ws = (unsigned char*)d_ws; p.never = 0; p.pad = 0;
    void* args[] = {&p};
    hipError_t e = hipLaunchCooperativeKernel((const void*)hybrid_step_kernel, dim3(grid), dim3(512), args, LDS_BYTES, stream);
    if (e != hipSuccess) fprintf(stderr, "kernel_launch: cooperative launch failed: %s (grid %d)\n", hipGetErrorString(e), grid);
}
```

```cpp
#include <hip/hip_runtime.h>
#include <hip/hip_cooperative_groups.h>
#include <cstdio>
#include <cstdint>
namespace pg8 {
#define PG8_LAS __attribute__((address_space(3)))
typedef unsigned short bf16_t;
typedef short bf16x8 __attribute__((ext_vector_type(8)));
typedef float f32x4 __attribute__((ext_vector_type(4)));
typedef unsigned u32x4 __attribute__((ext_vector_type(4)));
constexpr int BM = 256, BK = 64, HALF = 128, HTB = HALF * BK * 2  , STAGE_BYTES = 8 * HTB, NXCD = 8, WGM = 8;

__host__ __device__ __forceinline__ int lds_byte(int r, int c) { const int st = (r >> 4) * 2 + (c >> 5), rr = r & 15, cc = c & 31, ob = rr * 64 + cc * 2; return st * 1024 + (ob ^ (((ob >> 9) & 1) << 5)); }
__host__ __device__ __forceinline__ void stage_rc(int b, int& R, int& C) { const int st = b / 1024, sb = b % 1024, swz = sb ^ (((sb >> 9) & 1) << 5); R = (st >> 1) * 16 + swz / 64; C = (st & 1) * 32 + (swz % 64) / 2; }
__host__ __device__ __forceinline__ int perm32(int rho) { const int n = rho >> 4, i = rho & 15; return 8 * (i >> 2) + 4 * n + (i & 3); }

struct Unit { int pm, pn; };
struct Gemm { const bf16_t* A; const bf16_t* Bt; int M, N, K; };

struct StaticOrder {
    int nM, nN, nwg, G, c;
    __host__ __device__ void init(int M, int N, int G_, int c_) { nM = M / BM; nN = N / BM; nwg = nM * nN; G = G_; c = c_; }
    __host__ __device__ bool next(int i, Unit& u) const {
        const long L = (long)i * G + c; if (L >= nwg) return false;
        int wgid = (int)L; { const int q = nwg / NXCD, r = nwg % NXCD, xcd = wgid % NXCD, off = wgid / NXCD; wgid = (xcd < r ? xcd * (q + 1) : r * (q + 1) + (xcd - r) * q) + off; }
        const int nig = WGM * nN, gid = wgid / nig, fm = gid * WGM, gsz = (nM - fm) < WGM ? (nM - fm) : WGM;
        u.pm = fm + ((wgid % nig) % gsz); u.pn = (wgid % nig) / gsz; return true;
    }
    __device__ __forceinline__ void a_ready(const Unit&) const {}
    __device__ __forceinline__ void done(const Unit&) const {}
};

__device__ __forceinline__ unsigned cvt_pk_bf16(float lo, float hi) { unsigned r; asm volatile("v_cvt_pk_bf16_f32 %0, %1, %2" : "=v"(r) : "v"(lo), "v"(hi)); return r; }
typedef float f32x2 __attribute__((ext_vector_type(2)));
__device__ __forceinline__ f32x2 gelu_pk(f32x2 v) {
    const f32x2 av = __builtin_elementwise_abs(v), d = av * 0.2316418882f + 1.0f;
    f32x2 t; t.x = __builtin_amdgcn_rcpf(d.x); t.y = __builtin_amdgcn_rcpf(d.y);
    f32x2 q = t * 0.5307027145f + (-0.7265760135f); q = q * t + 0.7107068705f; q = q * t + (-0.142248368f); q = q * t + 0.127414796f; q = q * t;
    const f32x2 s = (v * v) * (-0.72134752044f);
    f32x2 e; e.x = __builtin_amdgcn_exp2f(s.x); e.y = __builtin_amdgcn_exp2f(s.y);
    const f32x2 m = v * (q * e), r = v - m;
    f32x2 o; o.x = v.x < 0.f ? m.x : r.x; o.y = v.y < 0.f ? m.y : r.y; return o;
}

template <int ACT  > struct EpiBf16 {
    static constexpr bool PERM = true, AFTER_DRAIN = false; static_assert(ACT == 0 || ACT == 1, "EpiBf16: ACT is 0 (none) or 1 (gelu_pk)");
    bf16_t* O; int ldc; const float* bias; int split_cols; size_t split_stride; float scale0;
    __device__ __forceinline__ void operator()(const f32x4 (&acc)[2][2][4][2], const Unit& u, int wr, int wc, int fr, int fq) const {
        const int row0 = u.pm * BM + wr * 64 + fr; int colt = u.pn * BM; bf16_t* base = O;
        float sc = 1.f; if (split_cols) { const int t = colt / split_cols; base += (size_t)t * split_stride; colt -= t * split_cols; if (t == 0) sc = scale0; }
        const int col0 = colt + wc * 32 + 8 * fq, bcol0 = u.pn * BM + wc * 32 + 8 * fq;
        f32x4 bv[2][2];
#pragma unroll
        for (int bj = 0; bj < 2; ++bj)
#pragma unroll
            for (int n = 0; n < 2; ++n) bv[bj][n] = bias ? *(const f32x4*)(bias + bcol0 + bj * HALF + 4 * n) : (f32x4){0.f, 0.f, 0.f, 0.f};
#pragma unroll
        for (int ai = 0; ai < 2; ++ai)
#pragma unroll
            for (int m = 0; m < 4; ++m) { bf16_t* rowp = base + (size_t)(row0 + ai * HALF + m * 16) * ldc + col0;
#pragma unroll
                for (int bj = 0; bj < 2; ++bj) { f32x4 v0 = acc[ai][bj][m][0] + bv[bj][0], v1 = acc[ai][bj][m][1] + bv[bj][1];
                    if (ACT == 1) { f32x2 a = gelu_pk((f32x2){v0[0], v0[1]}), b = gelu_pk((f32x2){v0[2], v0[3]}), c = gelu_pk((f32x2){v1[0], v1[1]}), d = gelu_pk((f32x2){v1[2], v1[3]});
                        v0 = (f32x4){a.x, a.y, b.x, b.y}; v1 = (f32x4){c.x, c.y, d.x, d.y}; }
                    v0 = v0 * sc; v1 = v1 * sc; u32x4 w; w.x = cvt_pk_bf16(v0[0], v0[1]); w.y = cvt_pk_bf16(v0[2], v0[3]); w.z = cvt_pk_bf16(v1[0], v1[1]); w.w = cvt_pk_bf16(v1[2], v1[3]);
                    *(u32x4*)(rowp + bj * HALF) = w; } }
    }
};
template <class Epi, class Sched, bool ALIGN_EPI = false, bool SP2 = false>
__device__ __forceinline__ void gemm_phase(PG8_LAS unsigned char* lds, const Gemm g, const Sched& S, const Epi& E) {
    const int tid = threadIdx.x, wid = __builtin_amdgcn_readfirstlane(tid >> 6), lane = tid & 63, wr = wid >> 2, wc = wid & 3, fr = lane & 15, fq = lane >> 4;
    const int K = g.K, nt = K / BK;
    unsigned voffA[2], voffB[2];
#pragma unroll
    for (int i = 0; i < 2; ++i) { int R, C; stage_rc(tid * 16 + i * 8192, R, C); const int Rb = Epi::PERM ? ((R & ~31) + perm32(R & 31)) : R;
        voffA[i] = (unsigned)(R * K + C) * 2u; voffB[i] = (unsigned)(Rb * K + C) * 2u; }
    const size_t kstep = (size_t)(BK * 2);
    const size_t hstep = (size_t)HALF * K * 2;
    const size_t tstep = 2 * hstep;
    const unsigned ldsw = (unsigned)wid * 1024u;
    const int aoff = lds_byte(wr * 64 + fr, fq * 8), boff = lds_byte(wc * 32 + fr, fq * 8);
#define PG8_SA(b, h) (((b) * 2 + (h)) * HTB)
#define PG8_SB(b, h) ((4 + (b) * 2 + (h)) * HTB)
#define PG8_STAGE(bufoff, gbase, voff) do { _Pragma("unroll") for (int _i = 0; _i < 2; ++_i) \
        __builtin_amdgcn_global_load_lds((const unsigned*)((const char*)(gbase) + (voff)[_i]), (PG8_LAS unsigned*)(lds + (bufoff) + ldsw + _i * 8192), 16, 0, 0); } while (0)
#define PG8_LDA(dst, b, h) do { _Pragma("unroll") for (int m = 0; m < 4; ++m) _Pragma("unroll") for (int k = 0; k < 2; ++k) dst[m][k] = *(const PG8_LAS bf16x8*)(lds + PG8_SA(b, h) + aoff + m * 2048 + k * 1024); } while (0)
#define PG8_LDB(dst, b, h) do { _Pragma("unroll") for (int n = 0; n < 2; ++n) _Pragma("unroll") for (int k = 0; k < 2; ++k) dst[n][k] = *(const PG8_LAS bf16x8*)(lds + PG8_SB(b, h) + boff + n * 2048 + k * 1024); } while (0)
#define PG8_MMA(ai, bj, At, Bt) do { __builtin_amdgcn_s_setprio(1); _Pragma("unroll") for (int m = 0; m < 4; ++m) _Pragma("unroll") for (int n = 0; n < 2; ++n) _Pragma("unroll") for (int k = 0; k < 2; ++k) \
        acc[ai][bj][m][n] = __builtin_amdgcn_mfma_f32_16x16x32_bf16(Bt[n][k], At[m][k], acc[ai][bj][m][n], 0, 0, 0); __builtin_amdgcn_s_setprio(0); } while (0)
#define PG8_WAIT_V(n) asm volatile("s_waitcnt vmcnt(" #n ")" ::: "memory")
#define PG8_WAIT_L(n) asm volatile("s_waitcnt lgkmcnt(" #n ")" ::: "memory")
#define PG8_BAR __builtin_amdgcn_s_barrier()
#define PG8_SCHED __builtin_amdgcn_sched_barrier(0)
    Unit cur, nxt; int ui = 0;
    if (!S.next(0, cur)) return;
    f32x4 acc[2][2][4][2];
#pragma unroll
    for (int a = 0; a < 2; ++a)
#pragma unroll
        for (int b = 0; b < 2; ++b)
#pragma unroll
            for (int m = 0; m < 4; ++m)
#pragma unroll
                for (int n = 0; n < 2; ++n) acc[a][b][m][n] = (f32x4){0.f, 0.f, 0.f, 0.f};
    bf16x8 At[4][2], B0[2][2], B1[2][2];
    const char* cA = (const char*)g.A + (size_t)cur.pm * tstep; const char* cB = (const char*)g.Bt + (size_t)cur.pn * tstep;
    S.a_ready(cur);
    if constexpr (SP2) {
        PG8_STAGE(PG8_SB(0, 0), cB, voffB); PG8_STAGE(PG8_SB(0, 1), cB + hstep, voffB); PG8_STAGE(PG8_SA(0, 0), cA, voffA); PG8_STAGE(PG8_SA(0, 1), cA + hstep, voffA);
        if (wr == 1) PG8_BAR;
        PG8_WAIT_V(2); PG8_BAR;
        PG8_STAGE(PG8_SB(1, 0), cB + kstep, voffB); PG8_STAGE(PG8_SA(1, 0), cA + kstep, voffA); PG8_STAGE(PG8_SB(1, 1), cB + hstep + kstep, voffB);
        PG8_WAIT_V(6); PG8_BAR;
    } else {
        PG8_STAGE(PG8_SB(0, 0), cB, voffB); PG8_STAGE(PG8_SA(0, 0), cA, voffA); PG8_STAGE(PG8_SB(0, 1), cB + hstep, voffB); PG8_STAGE(PG8_SA(0, 1), cA + hstep, voffA);
        if (wr == 1) PG8_BAR;
        PG8_WAIT_V(4); PG8_BAR;
        PG8_STAGE(PG8_SB(1, 0), cB + kstep, voffB); PG8_STAGE(PG8_SA(1, 0), cA + kstep, voffA); PG8_STAGE(PG8_SB(1, 1), cB + hstep + kstep, voffB);
        PG8_WAIT_V(6); PG8_BAR;
    }
    for (;;) {
        const bool has_next = S.next(ui + 1, nxt);
        const char* nA = has_next ? (const char*)g.A + (size_t)nxt.pm * tstep : cA; const char* nB = has_next ? (const char*)g.Bt + (size_t)nxt.pn * tstep : cB;
        for (int t = 0; t < nt; t += 2) {
            const bool last = (t == nt - 2);
            const char* a1 = cA + (size_t)(t + 1) * kstep;
            const char* a2 = last ? nA : cA + (size_t)(t + 2) * kstep; const char* b2 = last ? nB : cB + (size_t)(t + 2) * kstep;
            const char* a3 = a2 + kstep; const char* b3 = b2 + kstep;
            if (last && has_next) S.a_ready(nxt);
            if constexpr (SP2) {
            PG8_LDB(B0, 0, 0); PG8_LDB(B1, 0, 1); PG8_SCHED; PG8_LDA(At, 0, 0); PG8_STAGE(PG8_SA(1, 1), a1 + hstep, voffA);
            PG8_WAIT_V(8); PG8_WAIT_L(0); PG8_BAR; PG8_MMA(0, 0, At, B0); PG8_MMA(0, 1, At, B1); PG8_BAR; PG8_SCHED;
            PG8_LDA(At, 0, 1); PG8_STAGE(PG8_SB(0, 0), b2, voffB); PG8_STAGE(PG8_SB(0, 1), b2 + hstep, voffB); PG8_STAGE(PG8_SA(0, 0), a2, voffA);
            PG8_WAIT_V(8); PG8_WAIT_L(0); PG8_BAR; PG8_MMA(1, 0, At, B0); PG8_MMA(1, 1, At, B1); PG8_BAR; PG8_SCHED;
            PG8_LDB(B0, 1, 0); PG8_LDB(B1, 1, 1); PG8_SCHED; PG8_LDA(At, 1, 0); PG8_STAGE(PG8_SA(0, 1), a2 + hstep, voffA);
            PG8_WAIT_V(8); PG8_WAIT_L(0); PG8_BAR; PG8_MMA(0, 0, At, B0); PG8_MMA(0, 1, At, B1); PG8_BAR; PG8_SCHED;
            PG8_LDA(At, 1, 1); PG8_STAGE(PG8_SB(1, 0), b3, voffB); PG8_STAGE(PG8_SB(1, 1), b3 + hstep, voffB); PG8_STAGE(PG8_SA(1, 0), a3, voffA);
            PG8_WAIT_V(8); PG8_WAIT_L(0); PG8_BAR; PG8_MMA(1, 0, At, B0); PG8_MMA(1, 1, At, B1); PG8_BAR; PG8_SCHED;
            } else {
            PG8_LDB(B0, 0, 0); PG8_SCHED; PG8_LDA(At, 0, 0); PG8_STAGE(PG8_SA(1, 1), a1 + hstep, voffA);
            PG8_WAIT_L(8); PG8_BAR; PG8_WAIT_L(0); PG8_MMA(0, 0, At, B0); PG8_BAR; PG8_SCHED;
            PG8_LDB(B1, 0, 1); PG8_STAGE(PG8_SB(0, 0), b2, voffB);
            PG8_BAR; PG8_WAIT_L(0); PG8_MMA(0, 1, At, B1); PG8_BAR;
            PG8_LDA(At, 0, 1); PG8_STAGE(PG8_SA(0, 0), a2, voffA);
            PG8_BAR; PG8_WAIT_L(0); PG8_MMA(1, 0, At, B0); PG8_BAR; PG8_SCHED;
            PG8_STAGE(PG8_SB(0, 1), b2 + hstep, voffB);
            PG8_WAIT_V(6); PG8_BAR; PG8_MMA(1, 1, At, B1); PG8_BAR;
            PG8_LDB(B0, 1, 0); PG8_SCHED; PG8_LDA(At, 1, 0); PG8_STAGE(PG8_SA(0, 1), a2 + hstep, voffA);
            PG8_WAIT_L(8); PG8_BAR; PG8_WAIT_L(0); PG8_MMA(0, 0, At, B0); PG8_BAR; PG8_SCHED;
            PG8_LDB(B1, 1, 1); PG8_STAGE(PG8_SB(1, 0), b3, voffB);
            PG8_BAR; PG8_WAIT_L(0); PG8_MMA(0, 1, At, B1); PG8_BAR;
            PG8_LDA(At, 1, 1); PG8_STAGE(PG8_SA(1, 0), a3, voffA);
            PG8_BAR; PG8_WAIT_L(0); PG8_MMA(1, 0, At, B0); PG8_BAR; PG8_SCHED;
            PG8_STAGE(PG8_SB(1, 1), b3 + hstep, voffB);
            PG8_WAIT_V(6); PG8_BAR; PG8_MMA(1, 1, At, B1); PG8_BAR;
            }
        }
        if constexpr (ALIGN_EPI) { if (wr == 0) PG8_BAR; }
        if constexpr (!Epi::AFTER_DRAIN) { E(acc, cur, wr, wc, fr, fq); S.done(cur); }
        if (!has_next) break;
#pragma unroll
        for (int a = 0; a < 2; ++a)
#pragma unroll
            for (int b = 0; b < 2; ++b)
#pragma unroll
                for (int m = 0; m < 4; ++m)
#pragma unroll
                    for (int n = 0; n < 2; ++n) acc[a][b][m][n] = (f32x4){0.f, 0.f, 0.f, 0.f};
        cur = nxt; cA = nA; cB = nB; ++ui;
        if constexpr (ALIGN_EPI) { if (wr == 1) PG8_BAR; }
    }
    PG8_WAIT_V(0);
    if constexpr (!ALIGN_EPI) { if (wr == 0) PG8_BAR; }
    PG8_BAR;
    if constexpr (Epi::AFTER_DRAIN) { E.fused(acc, cur, wr, wc, fr, fq, lds, wid, lane); S.done(cur); }
#undef PG8_SA
#undef PG8_SB
#undef PG8_STAGE
#undef PG8_LDA
#undef PG8_LDB
#undef PG8_MMA
#undef PG8_WAIT_V
#undef PG8_WAIT_L
#undef PG8_BAR
#undef PG8_SCHED
}
}
#define GAS __attribute__((address_space(1)))
#define LAS __attribute__((address_space(3)))
#define XB_TMO      128
#define XB_XCNT(j)  (256  + 64 * (j))
#define XB_XSUB(j)  (1280 + 64 * (j))
#define XB_XGEN(j)  (2304 + 64 * (j))
#define XB_TOP      3328
#define XB_TOPGEN   3392
#define XCD_BAR_WORDS 3456
#define XB_SPIN_CAP (1u << 18)

__device__ __forceinline__ unsigned xb_ld(unsigned* p)              { return __hip_atomic_load(p, __ATOMIC_RELAXED, __HIP_MEMORY_SCOPE_AGENT); }
__device__ __forceinline__ unsigned xb_add(unsigned* p, unsigned v) { return __hip_atomic_fetch_add(p, v, __ATOMIC_RELAXED, __HIP_MEMORY_SCOPE_AGENT); }
__device__ __forceinline__ unsigned xb_xcc_id() { return (unsigned)__builtin_amdgcn_s_getreg((3 << 11) | 20) & 0xFu; }
#define XB_SPIN(cond, bar) do { unsigned _sp = 0; while (cond) { __builtin_amdgcn_s_sleep(1); \
    if ((++_sp & 255u) == 0u) { if (xb_ld(&(bar)[XB_TMO])) break; if (_sp > XB_SPIN_CAP) { atomicAdd(&(bar)[XB_TMO], 1u); break; } } } } while (0)

struct XcdBarrier {
    unsigned* bar; unsigned x;
    volatile LAS unsigned* st;
};

__device__ __forceinline__ XcdBarrier xcd_barrier_post(unsigned* bar, volatile LAS unsigned* st) {
    XcdBarrier b; b.bar = bar; b.x = xb_xcc_id(); b.st = st;
    if (threadIdx.x == 0) (void)xb_add(&bar[XB_XCNT(b.x)], 1u);
    return b;
}
__device__ __forceinline__ void xcd_barrier_complete(unsigned* bar, unsigned x, unsigned& nloc, unsigned& nx) {
    const unsigned G = gridDim.x * gridDim.y * gridDim.z;
    unsigned sum, cnt, mine, sp = 0u;
    for (;;) {
        sum = 0u; cnt = 0u; mine = 0u;
#pragma unroll
        for (unsigned j = 0; j < 16; ++j) { const unsigned c = xb_ld(&bar[XB_XCNT(j)]); sum += c; cnt += (c > 0u) ? 1u : 0u; mine = (j == x) ? c : mine; }
        if (sum == G) break;
        __builtin_amdgcn_s_sleep(1);
        if ((++sp & 255u) == 0u) { if (xb_ld(&bar[XB_TMO])) break; if (sp > XB_SPIN_CAP) { atomicAdd(&bar[XB_TMO], 1u); break; } }
    }
    nloc = mine > 0u ? mine : 1u; nx = cnt > 0u ? cnt : 1u;
}

__device__ __forceinline__ void xcd_barrier(const XcdBarrier& b) {
    asm volatile("s_waitcnt vmcnt(0)" ::: "memory");
    __syncthreads();
    if (threadIdx.x == 0) {
        unsigned* bar = b.bar;
        __builtin_amdgcn_s_waitcnt(0);
        unsigned nloc = b.st[0], nx = b.st[1];
        if (nloc == 0u) { xcd_barrier_complete(bar, b.x, nloc, nx); b.st[0] = nloc; b.st[1] = nx; }
        const unsigned old = xb_add(&bar[XB_XSUB(b.x)], 1u);
        const unsigned gen = old / nloc;
        if (old + 1u == (gen + 1u) * nloc) {
            __builtin_amdgcn_fence(__ATOMIC_RELEASE, "agent");
            asm volatile("s_waitcnt vmcnt(0)" ::: "memory");
            const unsigned og = xb_add(&bar[XB_TOP], 1u);
            const unsigned tg = og / nx;
            if (og + 1u == (tg + 1u) * nx) xb_add(&bar[XB_TOPGEN], 1u);
            else XB_SPIN(xb_ld(&bar[XB_TOPGEN]) == tg, bar);
            __builtin_amdgcn_fence(__ATOMIC_ACQUIRE, "agent");
            xb_add(&bar[XB_XGEN(b.x)], 1u);
            asm volatile("s_waitcnt vmcnt(0)" ::: "memory");
        } else {
            XB_SPIN(xb_ld(&bar[XB_XGEN(b.x)]) == gen, bar);
            __builtin_amdgcn_fence(__ATOMIC_ACQUIRE, "agent");
            asm volatile("s_waitcnt vmcnt(0)" ::: "memory");
        }
    }
    __syncthreads();
}

namespace cg = cooperative_groups;
typedef unsigned short bf16;
typedef unsigned v4u __attribute__((ext_vector_type(4)));
typedef unsigned v2u __attribute__((ext_vector_type(2)));
typedef float f32x4 __attribute__((ext_vector_type(4)));
typedef float f32x2 __attribute__((ext_vector_type(2)));
typedef short bf16x8 __attribute__((ext_vector_type(8)));
#define LDS_WAIT() asm volatile("s_waitcnt lgkmcnt(0)" ::: "memory")

constexpr int DM = 1024, NB = 8, SEQ = 2048, DECB = 128, DECS = 4;
constexpr int MP = NB * SEQ, MS = DECB * DECS, MT = MP + MS, MPAD = 17152;
constexpr int NZ1 = 5376, NIN = 7424, DFF = 2816;
constexpr int ZR = 0, ZK = 1024, ZV = 2048, ZWL = 3072, ZAL = 3136, ZGL = 3200, ZXB = 3328, ZGB = 4352;
constexpr float ALPHA = 1.189207115002721f;
constexpr float LN_EPS = 1e-5f, GN_EPS = 64e-5f;

constexpr size_t MiB = 1u << 20;
constexpr size_t WS_CTL = 0, CTL_ZERO_BYTES = 65536;
constexpr int CW_BAR = 1024;
constexpr size_t WS_WOT = 1 * MiB;
constexpr size_t WS_SMALL = 3 * MiB;
constexpr size_t WS_XB = 4 * MiB;
constexpr size_t WS_Z1 = 38 * MiB;
constexpr size_t WS_WINT = 214 * MiB;
constexpr size_t WS_BONUS = 214 * MiB;
constexpr size_t WS_H1 = 38 * MiB;
constexpr size_t WS_H1B = 104 * MiB;
constexpr size_t WS_WGUT = 137 * MiB;
constexpr size_t WS_WDT = 148 * MiB;
constexpr size_t WS_ACT = 154 * MiB;
constexpr size_t O_Y = 0, O_SHP = 17301504, O_WKVP = 17309696, O_CONVP = 17833984, O_LRUP = 17858560,
                 O_SHS = 17866752, O_WKVS = 17997824, O_CONVS = 26386432, O_LRUS = 26779648;

constexpr int LDS_BYTES = 163840, MISC_OFF = LDS_BYTES - 64;

struct Params { const float* in[33]; float* out; unsigned char* ws; int never; int pad; };
typedef const __attribute__((address_space(4))) Params CP;
__device__ __forceinline__ CP* launder(CP* q) { asm volatile("" : "+s"(q)); return q; }
enum { I_XP = 0, I_XS, I_SHIFT, I_WKV, I_CONV, I_LRU, I_WIN, I_MU, I_W0, I_W2, I_A0, I_A2, I_G2, I_KK, I_KA, I_RK, I_LNXG, I_LNXB,
       I_CW, I_CB, I_WA, I_BA, I_WI, I_BI, I_LAM, I_WO, I_LN1G, I_LN1B, I_WG, I_WU, I_WD, I_LN2G, I_LN2B };

__device__ __forceinline__ float bf2f(unsigned b) { return __uint_as_float(b << 16); }
__device__ __forceinline__ unsigned f2bf(float f) { unsigned u = __float_as_uint(f); return (u + 0x7fffu + ((u >> 16) & 1u)) >> 16; }
typedef __bf16 bf2_t __attribute__((ext_vector_type(2)));
__device__ __forceinline__ unsigned pk2(float lo, float hi) { bf2_t v = {(__bf16)lo, (__bf16)hi}; return __builtin_bit_cast(unsigned, v); }
__device__ __forceinline__ float lo16(unsigned u) { return __uint_as_float(u << 16); }
__device__ __forceinline__ float hi16(unsigned u) { return __uint_as_float(u & 0xffff0000u); }
__device__ __forceinline__ float sigm(float x) { return __builtin_amdgcn_rcpf(1.f + __expf(-x)); }
__device__ __forceinline__ float tanh_(float x) { return 1.f - 2.f * __builtin_amdgcn_rcpf(__expf(2.f * x) + 1.f); }
__device__ __forceinline__ float gelu_tanh(float x) { return 0.5f * x * (1.f + tanh_(0.7978845608028654f * (x + 0.044715f * x * x * x))); }
template <int CTRL> __device__ __forceinline__ float dpp_add(float v) {
    return v + __int_as_float(__builtin_amdgcn_update_dpp(0, __float_as_int(v), CTRL, 0xF, 0xF, true)); }
__device__ __forceinline__ float allred8(float v) { v = dpp_add<0xB1>(v); v = dpp_add<0x4E>(v); v = dpp_add<0x141>(v); return v; }
__device__ __forceinline__ float allred16(float v) { v = allred8(v); v = dpp_add<0x140>(v); return v; }
__device__ __forceinline__ float wave_sum(float v) {
#pragma unroll
    for (int o = 1; o < 64; o <<= 1) v += __shfl_xor(v, o);
    return v; }
#define UNPACK8(q, f) do { f[0] = lo16(q.x); f[1] = hi16(q.x); f[2] = lo16(q.y); f[3] = hi16(q.y); f[4] = lo16(q.z); f[5] = hi16(q.z); f[6] = lo16(q.w); f[7] = hi16(q.w); } while (0)

__device__ __forceinline__ void transpose_item(const float* W, int N, bf16* WT, int ldT, int k0, int n0, int drow0, LAS float* scr, int lane) {
#pragma unroll 8
    for (int i = 0; i < 32; ++i) { const int kk = 2 * i + (lane >> 5); scr[kk * 33 + (lane & 31)] = W[(size_t)(k0 + kk) * N + n0 + (lane & 31)]; }
    LDS_WAIT();
    const int c = lane & 7;
#pragma unroll
    for (int j = 0; j < 4; ++j) { const int n = (lane >> 3) + 8 * j; const LAS float* s = scr + (8 * c) * 33 + n;
        v4u o; o.x = pk2(s[0 * 33], s[1 * 33]); o.y = pk2(s[2 * 33], s[3 * 33]); o.z = pk2(s[4 * 33], s[5 * 33]); o.w = pk2(s[6 * 33], s[7 * 33]);
        *(v4u*)(WT + (size_t)(drow0 + n) * ldT + k0 + 8 * c) = o; }
    LDS_WAIT();
}

__device__ __forceinline__ void phase0(CP& p, LAS unsigned char* lds) {
    int tid_l = threadIdx.x; asm volatile("" : "+v"(tid_l)); const int tid = tid_l, wave = tid >> 6, lane = tid & 63;
    const int gw = blockIdx.x * 8 + wave, NGW = gridDim.x * 8;
    bf16* Xb = (bf16*)(p.ws + WS_XB);
    for (int m = gw; m < MPAD; m += NGW) {
        const float* src = m < MP ? p.in[I_XP] + (size_t)m * DM : (m < MT ? p.in[I_XS] + (size_t)(m - MP) * DM : (m < MT + DECB ? p.in[I_SHIFT] + (size_t)(m - MT) * DM : nullptr));
        f32x4 v[4];
#pragma unroll
        for (int j = 0; j < 4; ++j) v[j] = src ? *(const f32x4*)(src + 4 * lane + 256 * j) : (f32x4){0.f, 0.f, 0.f, 0.f};
        unsigned long long* o8 = (unsigned long long*)(Xb + (size_t)m * DM) + lane;
#pragma unroll
        for (int j = 0; j < 4; ++j) o8[64 * j] = (unsigned long long)pk2(v[j].x, v[j].y) | ((unsigned long long)pk2(v[j].z, v[j].w) << 32);
        float* so = nullptr;
        if (m < MP) { if ((m & (SEQ - 1)) == SEQ - 1) so = p.out + O_SHP + (size_t)(m >> 11) * DM; }
        else if (m < MT) { if (((m - MP) & 3) == 3) so = p.out + O_SHS + (size_t)((m - MP) >> 2) * DM; }
        if (so) {
#pragma unroll
            for (int j = 0; j < 4; ++j) *(f32x4*)(so + 4 * lane + 256 * j) = v[j]; }
    }
    LAS float* scr = (LAS float*)(lds + wave * 16384);
    bf16* WinT = (bf16*)(p.ws + WS_WINT); bf16* WoT = (bf16*)(p.ws + WS_WOT);
    bf16* w2T = (bf16*)(p.ws + WS_SMALL); bf16* a2T = w2T + 65536; bf16* g2T = w2T + 131072; bf16* waT = w2T + 262144; bf16* wiT = w2T + 327680;
    constexpr int N_WIN = 16 * 232, N_WO = 16 * 32, N_L = 32, N_G = 64, N_B = 32;
    constexpr int NITEMS = N_WIN + N_WO + 2 * N_L + N_G + 2 * N_B;
    for (int it = gw; it < NITEMS; it += NGW) {
        int r = it;
        if (r < N_WIN) { transpose_item(p.in[I_WIN], NIN, WinT, 1024, 64 * (r / 232), 32 * (r % 232), 32 * (r % 232), scr, lane); continue; } r -= N_WIN;
        if (r < N_WO) { transpose_item(p.in[I_WO], 1024, WoT, 1024, 64 * (r / 32), 32 * (r % 32), 32 * (r % 32), scr, lane); continue; } r -= N_WO;
        if (r < N_L) { transpose_item(p.in[I_W2], 1024, w2T, 64, 0, 32 * r, 32 * r, scr, lane); continue; } r -= N_L;
        if (r < N_L) { transpose_item(p.in[I_A2], 1024, a2T, 64, 0, 32 * r, 32 * r, scr, lane); continue; } r -= N_L;
        if (r < N_G) { transpose_item(p.in[I_G2], 1024, g2T, 128, 64 * (r / 32), 32 * (r % 32), 32 * (r % 32), scr, lane); continue; } r -= N_G;
        if (r < N_B) { transpose_item(p.in[I_WA] + (r >> 1) * 4096, 64, waT + (r >> 1) * 4096, 64, 0, 32 * (r & 1), 32 * (r & 1), scr, lane); continue; } r -= N_B;
        transpose_item(p.in[I_WI] + (r >> 1) * 4096, 64, wiT + (r >> 1) * 4096, 64, 0, 32 * (r & 1), 32 * (r & 1), scr, lane);
    }
}
__device__ __forceinline__ void phase_convert_ffn(CP& p, LAS unsigned char* lds) {
    int tid_l = threadIdx.x; asm volatile("" : "+v"(tid_l)); const int tid = tid_l, wave = tid >> 6, lane = tid & 63;
    const int gw = blockIdx.x * 8 + wave, NGW = gridDim.x * 8;
    LAS float* scr = (LAS float*)(lds + wave * 16384);
    bf16* WguT = (bf16*)(p.ws + WS_WGUT); bf16* WdT = (bf16*)(p.ws + WS_WDT);
    constexpr int N_G = 16 * 88, N_D = 44 * 32;
    for (int it = gw; it < 2 * N_G + N_D; it += NGW) {
        int r = it;
        if (r < N_G) { const int n0 = 32 * (r % 88); transpose_item(p.in[I_WG], DFF, WguT, 1024, 64 * (r / 88), n0, 256 * (n0 >> 7) + (n0 & 127), scr, lane); continue; } r -= N_G;
        if (r < N_G) { const int n0 = 32 * (r % 88); transpose_item(p.in[I_WU], DFF, WguT, 1024, 64 * (r / 88), n0, 256 * (n0 >> 7) + 128 + (n0 & 127), scr, lane); continue; } r -= N_G;
        transpose_item(p.in[I_WD], 1024, WdT, DFF, 64 * (r / 32), 32 * (r % 32), 32 * (r % 32), scr, lane);
    }
}

struct EpiZ {
    static constexpr bool PERM = true, AFTER_DRAIN = false;
    bf16* Z1; bf16* Zg;
    __device__ __forceinline__ void operator()(const pg8::f32x4 (&acc)[2][2][4][2], const pg8::Unit& u, int wr, int wc, int fr, int fq) const {
        bf16* base; int ldc, colt;
        if (u.pn < 21) { base = Z1; ldc = NZ1; colt = u.pn * 256; } else { if (u.pm >= 66) return; base = Zg; ldc = 2048; colt = (u.pn - 21) * 256; }
        const int row0 = u.pm * 256 + wr * 64 + fr, col0 = colt + wc * 32 + 8 * fq;
#pragma unroll
        for (int ai = 0; ai < 2; ++ai)
#pragma unroll
            for (int m = 0; m < 4; ++m) { bf16* rowp = base + (size_t)(row0 + ai * 128 + m * 16) * ldc + col0;
#pragma unroll
                for (int bj = 0; bj < 2; ++bj) { const pg8::f32x4 v0 = acc[ai][bj][m][0], v1 = acc[ai][bj][m][1];
                    v4u w; w.x = pg8::cvt_pk_bf16(v0[0], v0[1]); w.y = pg8::cvt_pk_bf16(v0[2], v0[3]); w.z = pg8::cvt_pk_bf16(v1[0], v1[1]); w.w = pg8::cvt_pk_bf16(v1[2], v1[3]);
                    *(v4u*)(rowp + bj * 128) = w; } }
    }
};
struct EpiRes {
    static constexpr bool PERM = false, AFTER_DRAIN = false;
    const float* resA; const float* resB; float* out;
    __device__ __forceinline__ void operator()(const pg8::f32x4 (&acc)[2][2][4][2], const pg8::Unit& u, int wr, int wc, int fr, int fq) const {
        const int row0 = u.pm * 256 + wr * 64 + fr, col0 = u.pn * 256 + wc * 32 + 4 * fq;
#pragma unroll
        for (int ai = 0; ai < 2; ++ai)
#pragma unroll
            for (int m = 0; m < 4; ++m) { const int row = row0 + ai * 128 + m * 16;
                const float* rp = (row < MP ? resA + (size_t)row * DM : resB + (size_t)(row - MP) * DM) + col0; float* op = out + (size_t)row * DM + col0;
#pragma unroll
                for (int bj = 0; bj < 2; ++bj)
#pragma unroll
                    for (int n = 0; n < 2; ++n) { const pg8::f32x4 x = *(const pg8::f32x4*)(rp + bj * 128 + n * 16); *(pg8::f32x4*)(op + bj * 128 + n * 16) = acc[ai][bj][m][n] + x * ALPHA; } }
    }
};

template <bool RES_BF16> struct EpiResB {
    static constexpr bool PERM = true, AFTER_DRAIN = false;
    const float* resA; const float* resB; const bf16* resH; bf16* out;
    __device__ __forceinline__ void operator()(const pg8::f32x4 (&acc)[2][2][4][2], const pg8::Unit& u, int wr, int wc, int fr, int fq) const {
        const int row0 = u.pm * 256 + wr * 64 + fr, col0 = u.pn * 256 + wc * 32 + 8 * fq;
#pragma unroll
        for (int ai = 0; ai < 2; ++ai)
#pragma unroll
            for (int m = 0; m < 4; ++m) { const int row = row0 + ai * 128 + m * 16; bf16* op = out + (size_t)row * DM + col0;
#pragma unroll
                for (int bj = 0; bj < 2; ++bj) { float x[8];
                    if (RES_BF16) { const v4u h = *(const v4u*)(resH + (size_t)row * DM + col0 + bj * 128); UNPACK8(h, x); }
                    else { const float* rp = (row < MP ? resA + (size_t)row * DM : resB + (size_t)(row - MP) * DM) + col0 + bj * 128;
                           const pg8::f32x4 x0 = *(const pg8::f32x4*)rp, x1 = *(const pg8::f32x4*)(rp + 4);
                           x[0] = x0[0]; x[1] = x0[1]; x[2] = x0[2]; x[3] = x0[3]; x[4] = x1[0]; x[5] = x1[1]; x[6] = x1[2]; x[7] = x1[3]; }
                    const pg8::f32x4 v0 = acc[ai][bj][m][0], v1 = acc[ai][bj][m][1];
                    v4u w; w.x = pk2(v0[0] + ALPHA * x[0], v0[1] + ALPHA * x[1]); w.y = pk2(v0[2] + ALPHA * x[2], v0[3] + ALPHA * x[3]);
                    w.z = pk2(v1[0] + ALPHA * x[4], v1[1] + ALPHA * x[5]); w.w = pk2(v1[2] + ALPHA * x[6], v1[3] + ALPHA * x[7]);
                    *(v4u*)(op + bj * 128) = w; } }
    }
};
struct EpiSwi {
    static constexpr bool PERM = true, AFTER_DRAIN = false;
    bf16* O;
    __device__ __forceinline__ void operator()(const pg8::f32x4 (&acc)[2][2][4][2], const pg8::Unit& u, int wr, int wc, int fr, int fq) const {
        const int row0 = u.pm * 256 + wr * 64 + fr, col0 = u.pn * 128 + wc * 32 + 8 * fq;
#pragma unroll
        for (int ai = 0; ai < 2; ++ai)
#pragma unroll
            for (int m = 0; m < 4; ++m) { bf16* rowp = O + (size_t)(row0 + ai * 128 + m * 16) * DFF + col0;
                float o[8];
#pragma unroll
                for (int n = 0; n < 2; ++n)
#pragma unroll
                    for (int j = 0; j < 4; ++j) { const float g = acc[ai][0][m][n][j], uu = acc[ai][1][m][n][j]; o[4 * n + j] = g * sigm(g) * uu; }
                v4u w; w.x = pg8::cvt_pk_bf16(o[0], o[1]); w.y = pg8::cvt_pk_bf16(o[2], o[3]); w.z = pg8::cvt_pk_bf16(o[4], o[5]); w.w = pg8::cvt_pk_bf16(o[6], o[7]);
                *(v4u*)rowp = w; }
    }
};

typedef _Float16 h8 __attribute__((ext_vector_type(8)));
typedef _Float16 h4 __attribute__((ext_vector_type(4)));
constexpr int L_NKK = 0, L_WR = 17408, L_W = 34816, L_B = 52224, L_KP = 69632, L_VL = 87040, L_SC = 95232, L_RAW = 95744, L_YB = L_RAW  , L_RAWL = 120704,
              L_CST = 138384, L_MUL = 140432, L_WB = 140944, L_PW = L_W, L_PA = L_B;
constexpr int OPS = 68, RLS = 136, WBS = 72;

__device__ __forceinline__ float mixmul_lo(unsigned h, float x) { float d; asm("v_fma_mix_f32 %0, %1, %2, 0 op_sel_hi:[1,0,0]" : "=v"(d) : "v"(h), "v"(x)); return d; }
__device__ __forceinline__ float mix_lo(unsigned h, float x, float acc) { float d; asm("v_fma_mix_f32 %0, %1, %2, %3 op_sel_hi:[1,0,0]" : "=v"(d) : "v"(h), "v"(x), "v"(acc)); return d; }
__device__ __forceinline__ float mix_hi(unsigned h, float x, float acc) { float d; asm("v_fma_mix_f32 %0, %1, %2, %3 op_sel:[1,0,0] op_sel_hi:[1,0,0]" : "=v"(d) : "v"(h), "v"(x), "v"(acc)); return d; }
__device__ __forceinline__ float nmix_lo(unsigned h, float x, float acc) { float d; asm("v_fma_mix_f32 %0, -%1, %2, %3 op_sel_hi:[1,0,0]" : "=v"(d) : "v"(h), "v"(x), "v"(acc)); return d; }
__device__ __forceinline__ float nmix_hi(unsigned h, float x, float acc) { float d; asm("v_fma_mix_f32 %0, -%1, %2, %3 op_sel:[1,0,0] op_sel_hi:[1,0,0]" : "=v"(d) : "v"(h), "v"(x), "v"(acc)); return d; }
__device__ __forceinline__ void allred16x2(float& a, float& b) {
    asm("s_nop 0\n\t"
        "v_add_f32_dpp %0, %0, %0 quad_perm:[1,0,3,2] row_mask:0xf bank_mask:0xf bound_ctrl:1\n\t"
        "v_add_f32_dpp %1, %1, %1 quad_perm:[1,0,3,2] row_mask:0xf bank_mask:0xf bound_ctrl:1\n\t"
        "s_nop 0\n\t"
        "v_add_f32_dpp %0, %0, %0 quad_perm:[2,3,0,1] row_mask:0xf bank_mask:0xf bound_ctrl:1\n\t"
        "v_add_f32_dpp %1, %1, %1 quad_perm:[2,3,0,1] row_mask:0xf bank_mask:0xf bound_ctrl:1\n\t"
        "s_nop 0\n\t"
        "v_add_f32_dpp %0, %0, %0 row_half_mirror row_mask:0xf bank_mask:0xf bound_ctrl:1\n\t"
        "v_add_f32_dpp %1, %1, %1 row_half_mirror row_mask:0xf bank_mask:0xf bound_ctrl:1\n\t"
        "s_nop 0\n\t"
        "v_add_f32_dpp %0, %0, %0 row_mirror row_mask:0xf bank_mask:0xf bound_ctrl:1\n\t"
        "v_add_f32_dpp %1, %1, %1 row_mirror row_mask:0xf bank_mask:0xf bound_ctrl:1"
        : "+v"(a), "+v"(b));
}

__device__ __forceinline__ f32x2 pk_mul(f32x2 a, f32x2 b) { f32x2 d; asm("v_pk_mul_f32 %0, %1, %2" : "=v"(d) : "v"(a), "v"(b)); return d; }
__device__ __forceinline__ f32x2 pk_fma(f32x2 a, f32x2 b, f32x2 c) { f32x2 d; asm("v_pk_fma_f32 %0, %1, %2, %3" : "=v"(d) : "v"(a), "v"(b), "v"(c)); return d; }
__device__ __forceinline__ f32x2 pk_fma_b(f32x2 a, f32x2 blo, f32x2 c) { f32x2 d; asm("v_pk_fma_f32 %0, %1, %2, %3 op_sel_hi:[1,0,1]" : "=v"(d) : "v"(a), "v"(blo), "v"(c)); return d; }
__device__ __forceinline__ float add_asm(float a, float b) { float d; asm("v_add_f32 %0, %1, %2" : "=v"(d) : "v"(a), "v"(b)); return d; }
struct StepOps { f32x4 nk, wr, w, b, k; f32x2 vi; };
__device__ __forceinline__ void allred8x2_decay(float& a, float& b, float a0, float a1, float b0, float b1, f32x2& s01, f32x2& s23, f32x2& s45, f32x2& s67, f32x2 w01, f32x2 w23, f32x2 w45, f32x2 w67) {
    asm volatile("v_add_f32 %0, %10, %11\n\t"
        "v_add_f32 %1, %12, %13\n\t"
        "v_pk_mul_f32 %2, %2, %6\n\t"
        "v_add_f32_dpp %0, %0, %0 quad_perm:[1,0,3,2] row_mask:0xf bank_mask:0xf bound_ctrl:1\n\t"
        "v_add_f32_dpp %1, %1, %1 quad_perm:[1,0,3,2] row_mask:0xf bank_mask:0xf bound_ctrl:1\n\t"
        "v_pk_mul_f32 %3, %3, %7\n\t"
        "v_add_f32_dpp %0, %0, %0 quad_perm:[2,3,0,1] row_mask:0xf bank_mask:0xf bound_ctrl:1\n\t"
        "v_add_f32_dpp %1, %1, %1 quad_perm:[2,3,0,1] row_mask:0xf bank_mask:0xf bound_ctrl:1\n\t"
        "v_pk_mul_f32 %4, %4, %8\n\t"
        "v_add_f32_dpp %0, %0, %0 row_half_mirror row_mask:0xf bank_mask:0xf bound_ctrl:1\n\t"
        "v_add_f32_dpp %1, %1, %1 row_half_mirror row_mask:0xf bank_mask:0xf bound_ctrl:1\n\t"
        "v_pk_mul_f32 %5, %5, %9"
        : "=&v"(a), "=&v"(b), "+v"(s01), "+v"(s23), "+v"(s45), "+v"(s67) : "v"(w01), "v"(w23), "v"(w45), "v"(w67), "v"(a0), "v"(a1), "v"(b0), "v"(b1));
}
struct StepOps8 { f32x4 nk0, nk1, wr0, wr1, w0, w1, b0, b1, k0, k1; f32x2 vi; };

__device__ __forceinline__ void wkv_prompt(CP& p, LAS unsigned char* lds, int unit, bool dry) {
    int tid_l = threadIdx.x; asm volatile("" : "+v"(tid_l)); const int tid = tid_l, wave = tid >> 6, lane = tid & 63;
    const int bh = unit >> 1, half = unit & 1, b = bh >> 4, h = bh & 15;
    const int rl = (wave & 3) * 8 + (lane >> 3), s = lane & 7;
    const int ptok = tid >> 3, pcg = tid & 7;
    bf16* Z1 = (bf16*)(p.ws + WS_Z1); bf16* BON = (bf16*)(p.ws + WS_BONUS);
    const size_t rowbase = (size_t)b * SEQ;
    LAS bf16* RAW = (LAS bf16*)(lds + L_RAW); LAS bf16* RAWL = (LAS bf16*)(lds + L_RAWL);
    LAS float* ONKK = (LAS float*)(lds + L_NKK); LAS float* OWR = (LAS float*)(lds + L_WR); LAS float* OW = (LAS float*)(lds + L_W); LAS float* OB = (LAS float*)(lds + L_B); LAS float* OKP = (LAS float*)(lds + L_KP);
    LAS float* VL = (LAS float*)(lds + L_VL); LAS float* SC = (LAS float*)(lds + L_SC); LAS float* YB = (LAS float*)(lds + L_YB);
    LAS float* PW = (LAS float*)(lds + L_PW); LAS float* PA = (LAS float*)(lds + L_PA);
    LAS float* CST = (LAS float*)(lds + L_CST); LAS float* MUL = (LAS float*)(lds + L_MUL); LAS bf16* WB = (LAS bf16*)(lds + L_WB);
    if (tid < 96) ((LAS unsigned*)RAW)[tid] = 0u;
    if (tid < 68) ((LAS unsigned*)RAWL)[tid] = 0u;
    {
      const int a = tid >> 6, cc = tid & 63, C = h * 64 + cc;
      const float* src = a == 0 ? p.in[I_MU] + ZR : a == 1 ? p.in[I_MU] + ZK : a == 2 ? p.in[I_MU] + ZV : a == 3 ? p.in[I_W0] : a == 4 ? p.in[I_A0] : a == 5 ? p.in[I_KK] : a == 6 ? p.in[I_KA] : p.in[I_RK];
      CST[a * 64 + cc] = src[C];
      if (tid < 128) MUL[tid] = p.in[I_MU][ZWL + tid];
      const bf16* w2T = (const bf16*)(p.ws + WS_SMALL); const bf16* a2T = w2T + 65536;
      const int n = tid >> 3, k8 = tid & 7;
      *(LAS v4u*)(WB + n * WBS + 8 * k8) = *(const v4u*)(w2T + (size_t)(h * 64 + n) * 64 + 8 * k8);
      *(LAS v4u*)(WB + 64 * WBS + n * WBS + 8 * k8) = *(const v4u*)(a2T + (size_t)(h * 64 + n) * 64 + 8 * k8); }
    f32x2 S01 = {0.f, 0.f}, S23 = {0.f, 0.f}, S45 = {0.f, 0.f}, S67 = {0.f, 0.f};
    const int C0 = h * 64 + 8 * pcg;
    const bool vmine = (pcg >> 2) == half;
    v4u pr, pk, pv, pl0, pl1;
    { const bf16* z = Z1 + (rowbase + ptok) * NZ1;
      pr = *(const v4u*)(z + ZR + C0); pk = *(const v4u*)(z + ZK + C0); pv = vmine ? *(const v4u*)(z + ZV + C0) : (v4u){0u, 0u, 0u, 0u};
      pl0 = *(const v4u*)(z + ZWL + 16 * pcg); pl1 = *(const v4u*)(z + ZWL + 16 * pcg + 8); }
    for (int c = 0; c < SEQ / 64; ++c) {
        if (ptok == 63 && c > 0) {
            *(LAS v4u*)(RAW + 0 + 8 * pcg) = *(LAS v4u*)(RAW + 64 * 192 + 8 * pcg); *(LAS v4u*)(RAW + 64 + 8 * pcg) = *(LAS v4u*)(RAW + 64 * 192 + 64 + 8 * pcg);
            *(LAS v4u*)(RAW + 128 + 8 * pcg) = *(LAS v4u*)(RAW + 64 * 192 + 128 + 8 * pcg);
            *(LAS v4u*)(RAWL + 16 * pcg) = *(LAS v4u*)(RAWL + 64 * RLS + 16 * pcg); *(LAS v4u*)(RAWL + 16 * pcg + 8) = *(LAS v4u*)(RAWL + 64 * RLS + 16 * pcg + 8); }
        { LAS bf16* rr = RAW + (ptok + 1) * 192; *(LAS v4u*)(rr + 8 * pcg) = pr; *(LAS v4u*)(rr + 64 + 8 * pcg) = pk; *(LAS v4u*)(rr + 128 + 8 * pcg) = pv;
          LAS bf16* rl2 = RAWL + (ptok + 1) * RLS; *(LAS v4u*)(rl2 + 16 * pcg) = pl0; *(LAS v4u*)(rl2 + 16 * pcg + 8) = pl1; }
        __syncthreads();
        if (c + 1 < SEQ / 64) { const bf16* z = Z1 + (rowbase + (size_t)(c + 1) * 64 + ptok) * NZ1;
            pr = *(const v4u*)(z + ZR + C0); pk = *(const v4u*)(z + ZK + C0); if (vmine) pv = *(const v4u*)(z + ZV + C0);
            pl0 = *(const v4u*)(z + ZWL + 16 * pcg); pl1 = *(const v4u*)(z + ZWL + 16 * pcg + 8); }
#ifdef PROBE_PREP2
        for (int rep = 0; rep < (p.never == 0 ? 2 : 1); ++rep) {
#else
        {
#endif
        { const int tb = wave & 3, nh = wave >> 2, fr = lane & 15, q = lane >> 4, ti = 16 * tb + fr;
          bf16x8 aw[2], aa[2];
#pragma unroll
          for (int ks = 0; ks < 2; ++ks) {
              const int ko = 32 * ks + 8 * q;
              { const v4u cu = *(LAS v4u*)(RAWL + (ti + 1) * RLS + ko), pu = *(LAS v4u*)(RAWL + ti * RLS + ko); float cf[8], pf[8]; UNPACK8(cu, cf); UNPACK8(pu, pf);
                const f32x4 m0 = *(LAS f32x4*)(MUL + ko), m1 = *(LAS f32x4*)(MUL + ko + 4); float o[8];
#pragma unroll
                for (int e = 0; e < 8; ++e) { const float mu = e < 4 ? m0[e & 3] : m1[e & 3]; o[e] = tanh_(cf[e] + mu * (pf[e] - cf[e])); }
                v4u w; w.x = pk2(o[0], o[1]); w.y = pk2(o[2], o[3]); w.z = pk2(o[4], o[5]); w.w = pk2(o[6], o[7]); aw[ks] = __builtin_bit_cast(bf16x8, w); }
              { const v4u cu = *(LAS v4u*)(RAWL + (ti + 1) * RLS + 64 + ko), pu = *(LAS v4u*)(RAWL + ti * RLS + 64 + ko); float cf[8], pf[8]; UNPACK8(cu, cf); UNPACK8(pu, pf);
                const f32x4 m0 = *(LAS f32x4*)(MUL + 64 + ko), m1 = *(LAS f32x4*)(MUL + 64 + ko + 4); float o[8];
#pragma unroll
                for (int e = 0; e < 8; ++e) { const float mu = e < 4 ? m0[e & 3] : m1[e & 3]; o[e] = cf[e] + mu * (pf[e] - cf[e]); }
                v4u w; w.x = pk2(o[0], o[1]); w.y = pk2(o[2], o[3]); w.z = pk2(o[4], o[5]); w.w = pk2(o[6], o[7]); aa[ks] = __builtin_bit_cast(bf16x8, w); }
          }
#pragma unroll
          for (int nbi = 0; nbi < 2; ++nbi) {
              const int nb = 2 * nh + nbi, n = 16 * nb + fr;
              f32x4 cw = {0.f, 0.f, 0.f, 0.f}, ca = {0.f, 0.f, 0.f, 0.f};
#pragma unroll
              for (int ks = 0; ks < 2; ++ks) {
                  const bf16x8 bw = *(LAS bf16x8*)(WB + n * WBS + 32 * ks + 8 * q), ba = *(LAS bf16x8*)(WB + 64 * WBS + n * WBS + 32 * ks + 8 * q);
                  cw = __builtin_amdgcn_mfma_f32_16x16x32_bf16(aw[ks], bw, cw, 0, 0, 0); ca = __builtin_amdgcn_mfma_f32_16x16x32_bf16(aa[ks], ba, ca, 0, 0, 0); }
#pragma unroll
              for (int r = 0; r < 4; ++r) { const int tok = 16 * tb + 4 * q + r; PW[tok * OPS + 16 * nb + fr] = cw[r]; PA[tok * OPS + 16 * nb + fr] = ca[r]; }
          }
        }
        __syncthreads();
        { float rc[8], kc[8], vc[8], t8[8];
          const int cc0 = 8 * pcg;
          { const v4u cu = *(LAS v4u*)(RAW + (ptok + 1) * 192 + cc0), pu = *(LAS v4u*)(RAW + ptok * 192 + cc0); UNPACK8(cu, rc); UNPACK8(pu, t8);
            const f32x4 m0 = *(LAS f32x4*)(CST + cc0), m1 = *(LAS f32x4*)(CST + cc0 + 4);
#pragma unroll
            for (int e = 0; e < 8; ++e) rc[e] += (e < 4 ? m0[e & 3] : m1[e & 3]) * (t8[e] - rc[e]); }
          { const v4u cu = *(LAS v4u*)(RAW + (ptok + 1) * 192 + 64 + cc0), pu = *(LAS v4u*)(RAW + ptok * 192 + 64 + cc0); UNPACK8(cu, kc); UNPACK8(pu, t8);
            const f32x4 m0 = *(LAS f32x4*)(CST + 64 + cc0), m1 = *(LAS f32x4*)(CST + 64 + cc0 + 4);
#pragma unroll
            for (int e = 0; e < 8; ++e) kc[e] += (e < 4 ? m0[e & 3] : m1[e & 3]) * (t8[e] - kc[e]); }
          { const v4u cu = *(LAS v4u*)(RAW + (ptok + 1) * 192 + 128 + cc0), pu = *(LAS v4u*)(RAW + ptok * 192 + 128 + cc0); UNPACK8(cu, vc); UNPACK8(pu, t8);
            const f32x4 m0 = *(LAS f32x4*)(CST + 128 + cc0), m1 = *(LAS f32x4*)(CST + 128 + cc0 + 4);
#pragma unroll
            for (int e = 0; e < 8; ++e) vc[e] += (e < 4 ? m0[e & 3] : m1[e & 3]) * (t8[e] - vc[e]); }
          float dec[8], av[8], kku[8], kp[8];
          { const f32x4 wa0 = *(LAS f32x4*)(PW + ptok * OPS + cc0), wa1 = *(LAS f32x4*)(PW + ptok * OPS + cc0 + 4);
            const f32x4 aa0 = *(LAS f32x4*)(PA + ptok * OPS + cc0), aa1 = *(LAS f32x4*)(PA + ptok * OPS + cc0 + 4);
            const f32x4 w00 = *(LAS f32x4*)(CST + 192 + cc0), w01 = *(LAS f32x4*)(CST + 192 + cc0 + 4);
            const f32x4 a00 = *(LAS f32x4*)(CST + 256 + cc0), a01 = *(LAS f32x4*)(CST + 256 + cc0 + 4);
            const f32x4 kk0 = *(LAS f32x4*)(CST + 320 + cc0), kk1 = *(LAS f32x4*)(CST + 320 + cc0 + 4);
            const f32x4 ka0 = *(LAS f32x4*)(CST + 384 + cc0), ka1 = *(LAS f32x4*)(CST + 384 + cc0 + 4);
#pragma unroll
            for (int e = 0; e < 8; ++e) {
                const float wl = (e < 4 ? w00[e & 3] : w01[e & 3]) + (e < 4 ? wa0[e & 3] : wa1[e & 3]);
                dec[e] = __expf(-0.6065306597126334f * sigm(wl));
                av[e] = sigm((e < 4 ? a00[e & 3] : a01[e & 3]) + (e < 4 ? aa0[e & 3] : aa1[e & 3]));
                kku[e] = kc[e] * (e < 4 ? kk0[e & 3] : kk1[e & 3]);
                kp[e] = kc[e] * (1.f + (av[e] - 1.f) * (e < 4 ? ka0[e & 3] : ka1[e & 3])); } }
          float ss = 0.f;
#pragma unroll
          for (int e = 0; e < 8; ++e) ss += kku[e] * kku[e];
          ss = allred8(ss);
          const float inv = __builtin_amdgcn_rsqf(fmaxf(ss, 1e-24f));
          const f32x4 rk0 = *(LAS f32x4*)(CST + 448 + cc0), rk1 = *(LAS f32x4*)(CST + 448 + cc0 + 4);
          float nk[8], bb[8], wr8[8], br = 0.f, kr = 0.f, bon = 0.f;
#pragma unroll
          for (int e = 0; e < 8; ++e) { const float kk = kku[e] * inv; nk[e] = -kk; bb[e] = kk * av[e]; wr8[e] = dec[e] * rc[e];
              br += bb[e] * rc[e]; kr += kp[e] * rc[e]; bon += rc[e] * kp[e] * (e < 4 ? rk0[e & 3] : rk1[e & 3]); }
          br = allred8(br); kr = allred8(kr); bon = allred8(bon);
          const int o = ptok * OPS + 8 * pcg;
          *(LAS f32x4*)(ONKK + o) = (f32x4){nk[0], nk[1], nk[2], nk[3]}; *(LAS f32x4*)(ONKK + o + 4) = (f32x4){nk[4], nk[5], nk[6], nk[7]};
          *(LAS f32x4*)(OWR + o) = (f32x4){wr8[0], wr8[1], wr8[2], wr8[3]}; *(LAS f32x4*)(OWR + o + 4) = (f32x4){wr8[4], wr8[5], wr8[6], wr8[7]};
          *(LAS f32x4*)(OW + o) = (f32x4){dec[0], dec[1], dec[2], dec[3]}; *(LAS f32x4*)(OW + o + 4) = (f32x4){dec[4], dec[5], dec[6], dec[7]};
          *(LAS f32x4*)(OB + o) = (f32x4){bb[0], bb[1], bb[2], bb[3]}; *(LAS f32x4*)(OB + o + 4) = (f32x4){bb[4], bb[5], bb[6], bb[7]};
          *(LAS f32x4*)(OKP + o) = (f32x4){kp[0], kp[1], kp[2], kp[3]}; *(LAS f32x4*)(OKP + o + 4) = (f32x4){kp[4], kp[5], kp[6], kp[7]};
          if (pcg == 0) *(LAS f32x2*)(SC + 2 * ptok) = (f32x2){br, kr};
          if (vmine) { const int vo = ptok * 32 + 8 * (pcg & 3);
              *(LAS f32x4*)(VL + vo) = (f32x4){vc[0], vc[1], vc[2], vc[3]}; *(LAS f32x4*)(VL + vo + 4) = (f32x4){vc[4], vc[5], vc[6], vc[7]};
              v4u w; w.x = pk2(bon * vc[0], bon * vc[1]); w.y = pk2(bon * vc[2], bon * vc[3]); w.z = pk2(bon * vc[4], bon * vc[5]); w.w = pk2(bon * vc[6], bon * vc[7]);
              if (!dry) *(v4u*)(BON + (rowbase + (size_t)c * 64 + ptok) * DM + C0) = w; }
        }
        __syncthreads();
        }
        if (wave < 4) { float sak = 0.f, y0k = 0.f;
#define WK_LOAD(o, t) do { const int ofs = (t) * OPS + 8 * s; \
              o.nk0 = *(const LAS f32x4*)(ONKK + ofs); o.nk1 = *(const LAS f32x4*)(ONKK + ofs + 4); o.wr0 = *(const LAS f32x4*)(OWR + ofs); o.wr1 = *(const LAS f32x4*)(OWR + ofs + 4); \
              o.w0 = *(const LAS f32x4*)(OW + ofs); o.w1 = *(const LAS f32x4*)(OW + ofs + 4); o.b0 = *(const LAS f32x4*)(OB + ofs); o.b1 = *(const LAS f32x4*)(OB + ofs + 4); \
              o.k0 = *(const LAS f32x4*)(OKP + ofs); o.k1 = *(const LAS f32x4*)(OKP + ofs + 4); o.vi[0] = VL[(t) * 32 + rl]; } while (0)
#define P2(v, i) ((f32x2){v[i], v[(i) + 1]})
#define WK_STEP(o, tl) do { \
              f32x2 ac = pk_mul(S01, P2(o.nk0, 0)); ac = pk_fma(S23, P2(o.nk0, 2), ac); ac = pk_fma(S45, P2(o.nk1, 0), ac); ac = pk_fma(S67, P2(o.nk1, 2), ac); \
              f32x2 ay = pk_mul(S01, P2(o.wr0, 0)); ay = pk_fma(S23, P2(o.wr0, 2), ay); ay = pk_fma(S45, P2(o.wr1, 0), ay); ay = pk_fma(S67, P2(o.wr1, 2), ay); \
              float psa, py; \
              allred8x2_decay(psa, py, ac[0], ac[1], ay[0], ay[1], S01, S23, S45, S67, P2(o.w0, 0), P2(o.w0, 2), P2(o.w1, 0), P2(o.w1, 2)); \
              f32x2 sap; sap[0] = psa; \
              S01 = pk_fma_b(P2(o.b0, 0), sap, S01); S23 = pk_fma_b(P2(o.b0, 2), sap, S23); S45 = pk_fma_b(P2(o.b1, 0), sap, S45); S67 = pk_fma_b(P2(o.b1, 2), sap, S67); \
              S01 = pk_fma_b(P2(o.k0, 0), o.vi, S01); S23 = pk_fma_b(P2(o.k0, 2), o.vi, S23); S45 = pk_fma_b(P2(o.k1, 0), o.vi, S45); S67 = pk_fma_b(P2(o.k1, 2), o.vi, S67); \
              const bool mine = (s == (tl)); sak = mine ? psa : sak; y0k = mine ? py : y0k; } while (0)
          StepOps8 A0, B0; A0.vi[1] = B0.vi[1] = 0.f;
          WK_LOAD(A0, 0);
#pragma unroll 1
          for (int tb = 0; tb < 64; tb += 8) {
              WK_LOAD(B0, tb + 1); WK_STEP(A0, 0);
              WK_LOAD(A0, tb + 2); WK_STEP(B0, 1);
              WK_LOAD(B0, tb + 3); WK_STEP(A0, 2);
              WK_LOAD(A0, tb + 4); WK_STEP(B0, 3);
              WK_LOAD(B0, tb + 5); WK_STEP(A0, 4);
              WK_LOAD(A0, tb + 6); WK_STEP(B0, 5);
              WK_LOAD(B0, tb + 7); WK_STEP(A0, 6);
              const int tn = (tb + 8) & 63;
              WK_LOAD(A0, tn);     WK_STEP(B0, 7);
              { const int t = tb + s; const f32x2 sc = *(const LAS f32x2*)(SC + 2 * t); YB[t * 32 + rl] = y0k + sak * sc[0] + VL[t * 32 + rl] * sc[1]; }
          }
#undef WK_LOAD
#undef WK_STEP
#undef P2
        }
        __syncthreads();
        { const f32x4 yv = *(LAS f32x4*)(YB + ptok * 32 + 4 * pcg); v2u w; w.x = pk2(yv[0], yv[1]); w.y = pk2(yv[2], yv[3]);
          if (!dry) *(v2u*)(Z1 + (rowbase + (size_t)c * 64 + ptok) * NZ1 + ZV + h * 64 + 32 * half + 4 * pcg) = w; }
    }
    if (!dry && wave < 4) { float* so = p.out + O_WKVP + ((size_t)(b * 16 + h) * 64 + 32 * half + rl) * 64 + 8 * s; *(f32x4*)so = (f32x4){S01[0], S01[1], S23[0], S23[1]}; *(f32x4*)(so + 4) = (f32x4){S45[0], S45[1], S67[0], S67[1]}; }
    __syncthreads();
}

constexpr int CH2 = 32, NCH2 = SEQ / CH2;
constexpr int L2_OP = 0, L2_OPSZ = 43520, L2_A = 8704  , L2_VL = 87040, L2_SC = 95232, L2_YB = 95744, L2_CST = 103936, L2_MUL = 105984, L2_WB = 106496;
struct RawRegs { v4u lw[2], la[2], lwp[2], lap[2], r, k, v, rp, kp, vp; };
__device__ __forceinline__ void wkv_prompt2(CP& p, LAS unsigned char* lds, int unit, bool dry) {
    int tid_l = threadIdx.x; asm volatile("" : "+v"(tid_l)); const int tid = tid_l, wave = tid >> 6, lane = tid & 63;
    const int bh = unit >> 1, half = unit & 1, b = bh >> 4, h = bh & 15;
    bf16* Z1 = (bf16*)(p.ws + WS_Z1); bf16* BON = (bf16*)(p.ws + WS_BONUS);
    const size_t rowbase = (size_t)b * SEQ;
    LAS float* CST = (LAS float*)(lds + L2_CST); LAS float* MUL = (LAS float*)(lds + L2_MUL); LAS bf16* WB = (LAS bf16*)(lds + L2_WB);
    { const int a = tid >> 6, cc = tid & 63, C = h * 64 + cc;
      const float* src = a == 0 ? p.in[I_MU] + ZR : a == 1 ? p.in[I_MU] + ZK : a == 2 ? p.in[I_MU] + ZV : a == 3 ? p.in[I_W0] : a == 4 ? p.in[I_A0] : a == 5 ? p.in[I_KK] : a == 6 ? p.in[I_KA] : p.in[I_RK];
      CST[a * 64 + cc] = src[C];
      if (tid < 128) MUL[tid] = p.in[I_MU][ZWL + tid];
      const bf16* w2T = (const bf16*)(p.ws + WS_SMALL); const bf16* a2T = w2T + 65536;
      const int n = tid >> 3, k8 = tid & 7;
      *(LAS v4u*)(WB + n * WBS + 8 * k8) = *(const v4u*)(w2T + (size_t)(h * 64 + n) * 64 + 8 * k8);
      *(LAS v4u*)(WB + 64 * WBS + n * WBS + 8 * k8) = *(const v4u*)(a2T + (size_t)(h * 64 + n) * 64 + 8 * k8); }
    __syncthreads();
    if (wave >= 4) {
        const int w4 = wave - 4, fr = lane & 15, q = lane >> 4, tb = w4 >> 1;
        const int ptok = 8 * w4 + (lane >> 3), pcg = lane & 7, C0 = h * 64 + 8 * pcg;
        const bool vmine = (pcg >> 2) == half;
        const int ftok = (tid - 256) >> 3;
        RawRegs R;
#define WK_LOADRAW(cc) do { const size_t rowL = rowbase + (size_t)(cc) * CH2 + 16 * tb + fr; const bf16* zl = Z1 + rowL * NZ1; const bool z0 = ((cc) == 0 && 16 * tb + fr == 0); const bf16* zlp = z0 ? zl : zl - NZ1; \
            _Pragma("unroll") for (int ks = 0; ks < 2; ++ks) { R.lw[ks] = *(const v4u*)(zl + ZWL + 32 * ks + 8 * q); R.la[ks] = *(const v4u*)(zl + ZAL + 32 * ks + 8 * q); \
                R.lwp[ks] = *(const v4u*)(zlp + ZWL + 32 * ks + 8 * q); R.lap[ks] = *(const v4u*)(zlp + ZAL + 32 * ks + 8 * q); \
                if (z0) { R.lwp[ks] = (v4u){0u, 0u, 0u, 0u}; R.lap[ks] = (v4u){0u, 0u, 0u, 0u}; } } \
            const size_t rowE = rowbase + (size_t)(cc) * CH2 + ptok; const bf16* ze = Z1 + rowE * NZ1; const bool e0 = ((cc) == 0 && ptok == 0); const bf16* zep = e0 ? ze : ze - NZ1; \
            R.r = *(const v4u*)(ze + ZR + C0); R.k = *(const v4u*)(ze + ZK + C0); R.rp = *(const v4u*)(zep + ZR + C0); R.kp = *(const v4u*)(zep + ZK + C0); \
            if (vmine) { R.v = *(const v4u*)(ze + ZV + C0); R.vp = *(const v4u*)(zep + ZV + C0); } else { R.v = (v4u){0u, 0u, 0u, 0u}; R.vp = R.v; } \
            if (e0) { R.rp = (v4u){0u, 0u, 0u, 0u}; R.kp = R.rp; R.vp = R.rp; } } while (0)
        WK_LOADRAW(0);
        for (int c = -1; c < NCH2; ++c) {
            if (c >= 1) {
                const LAS float* YBp = (const LAS float*)(lds + L2_YB + ((c - 1) & 1) * 4096);
                const f32x4 yv = *(const LAS f32x4*)(YBp + ftok * 32 + 4 * pcg); v2u w; w.x = pk2(yv[0], yv[1]); w.y = pk2(yv[2], yv[3]);
                if (!dry) *(v2u*)(Z1 + (rowbase + (size_t)(c - 1) * CH2 + ftok) * NZ1 + ZV + h * 64 + 32 * half + 4 * pcg) = w; }
            if (c + 1 < NCH2) {
                const int cc = c + 1;
                const RawRegs T = R;
                if (cc + 1 < NCH2) WK_LOADRAW(cc + 1);
                LAS unsigned char* ob = lds + L2_OP + (cc & 1) * L2_OPSZ;
                LAS float* ONKK = (LAS float*)ob; LAS float* OWR = (LAS float*)(ob + L2_A); LAS float* OW = (LAS float*)(ob + 2 * L2_A); LAS float* OB = (LAS float*)(ob + 3 * L2_A); LAS float* OKP = (LAS float*)(ob + 4 * L2_A);
                LAS float* VL = (LAS float*)(lds + L2_VL + (cc & 1) * 4096); LAS float* SC = (LAS float*)(lds + L2_SC + (cc & 1) * 256);
                { bf16x8 aw[2], aa[2];
#pragma unroll
                  for (int ks = 0; ks < 2; ++ks) { const int ko = 32 * ks + 8 * q;
                      { float cf[8], pf[8]; UNPACK8(T.lw[ks], cf); UNPACK8(T.lwp[ks], pf); const f32x4 m0 = *(LAS f32x4*)(MUL + ko), m1 = *(LAS f32x4*)(MUL + ko + 4); float o[8];
#pragma unroll
                        for (int e = 0; e < 8; ++e) { const float mu = e < 4 ? m0[e & 3] : m1[e & 3]; o[e] = tanh_(cf[e] + mu * (pf[e] - cf[e])); }
                        v4u w; w.x = pk2(o[0], o[1]); w.y = pk2(o[2], o[3]); w.z = pk2(o[4], o[5]); w.w = pk2(o[6], o[7]); aw[ks] = __builtin_bit_cast(bf16x8, w); }
                      { float cf[8], pf[8]; UNPACK8(T.la[ks], cf); UNPACK8(T.lap[ks], pf); const f32x4 m0 = *(LAS f32x4*)(MUL + 64 + ko), m1 = *(LAS f32x4*)(MUL + 64 + ko + 4); float o[8];
#pragma unroll
                        for (int e = 0; e < 8; ++e) { const float mu = e < 4 ? m0[e & 3] : m1[e & 3]; o[e] = cf[e] + mu * (pf[e] - cf[e]); }
                        v4u w; w.x = pk2(o[0], o[1]); w.y = pk2(o[2], o[3]); w.z = pk2(o[4], o[5]); w.w = pk2(o[6], o[7]); aa[ks] = __builtin_bit_cast(bf16x8, w); } }
#pragma unroll
                  for (int nb = 0; nb < 4; ++nb) { const int n = 16 * nb + fr; f32x4 cw = {0.f, 0.f, 0.f, 0.f}, ca = {0.f, 0.f, 0.f, 0.f};
#pragma unroll
                      for (int ks = 0; ks < 2; ++ks) { const bf16x8 bw = *(LAS bf16x8*)(WB + n * WBS + 32 * ks + 8 * q), ba = *(LAS bf16x8*)(WB + 64 * WBS + n * WBS + 32 * ks + 8 * q);
                          cw = __builtin_amdgcn_mfma_f32_16x16x32_bf16(aw[ks], bw, cw, 0, 0, 0); ca = __builtin_amdgcn_mfma_f32_16x16x32_bf16(aa[ks], ba, ca, 0, 0, 0); }
                      if ((q >> 1) == (w4 & 1)) {
#pragma unroll
                          for (int r = 0; r < 4; ++r) { const int tok = 16 * tb + 4 * q + r; OW[tok * OPS + 16 * nb + fr] = cw[r]; OB[tok * OPS + 16 * nb + fr] = ca[r]; } } } }
                LDS_WAIT(); asm volatile("" ::: "memory");
                { float rc[8], kc[8], vc[8], t8[8]; const int cc0 = 8 * pcg;
                  { UNPACK8(T.r, rc); UNPACK8(T.rp, t8); const f32x4 m0 = *(LAS f32x4*)(CST + cc0), m1 = *(LAS f32x4*)(CST + cc0 + 4);
#pragma unroll
                    for (int e = 0; e < 8; ++e) rc[e] += (e < 4 ? m0[e & 3] : m1[e & 3]) * (t8[e] - rc[e]); }
                  { UNPACK8(T.k, kc); UNPACK8(T.kp, t8); const f32x4 m0 = *(LAS f32x4*)(CST + 64 + cc0), m1 = *(LAS f32x4*)(CST + 64 + cc0 + 4);
#pragma unroll
                    for (int e = 0; e < 8; ++e) kc[e] += (e < 4 ? m0[e & 3] : m1[e & 3]) * (t8[e] - kc[e]); }
                  { UNPACK8(T.v, vc); UNPACK8(T.vp, t8); const f32x4 m0 = *(LAS f32x4*)(CST + 128 + cc0), m1 = *(LAS f32x4*)(CST + 128 + cc0 + 4);
#pragma unroll
                    for (int e = 0; e < 8; ++e) vc[e] += (e < 4 ? m0[e & 3] : m1[e & 3]) * (t8[e] - vc[e]); }
                  float dec[8], av[8], kku[8], kp[8];
                  { const f32x4 wa0 = *(LAS f32x4*)(OW + ptok * OPS + cc0), wa1 = *(LAS f32x4*)(OW + ptok * OPS + cc0 + 4);
                    const f32x4 aa0 = *(LAS f32x4*)(OB + ptok * OPS + cc0), aa1 = *(LAS f32x4*)(OB + ptok * OPS + cc0 + 4);
                    const f32x4 w00 = *(LAS f32x4*)(CST + 192 + cc0), w01 = *(LAS f32x4*)(CST + 192 + cc0 + 4);
                    const f32x4 a00 = *(LAS f32x4*)(CST + 256 + cc0), a01 = *(LAS f32x4*)(CST + 256 + cc0 + 4);
                    const f32x4 kk0 = *(LAS f32x4*)(CST + 320 + cc0), kk1 = *(LAS f32x4*)(CST + 320 + cc0 + 4);
                    const f32x4 ka0 = *(LAS f32x4*)(CST + 384 + cc0), ka1 = *(LAS f32x4*)(CST + 384 + cc0 + 4);
#pragma unroll
                    for (int e = 0; e < 8; ++e) {
                        const float wl = (e < 4 ? w00[e & 3] : w01[e & 3]) + (e < 4 ? wa0[e & 3] : wa1[e & 3]);
                        dec[e] = __expf(-0.6065306597126334f * sigm(wl));
                        av[e] = sigm((e < 4 ? a00[e & 3] : a01[e & 3]) + (e < 4 ? aa0[e & 3] : aa1[e & 3]));
                        kku[e] = kc[e] * (e < 4 ? kk0[e & 3] : kk1[e & 3]);
                        kp[e] = kc[e] * (1.f + (av[e] - 1.f) * (e < 4 ? ka0[e & 3] : ka1[e & 3])); } }
                  float ss = 0.f;
#pragma unroll
                  for (int e = 0; e < 8; ++e) ss += kku[e] * kku[e];
                  ss = allred8(ss);
                  const float inv = __builtin_amdgcn_rsqf(fmaxf(ss, 1e-24f));
                  const f32x4 rk0 = *(LAS f32x4*)(CST + 448 + cc0), rk1 = *(LAS f32x4*)(CST + 448 + cc0 + 4);
                  float nk[8], bb[8], wr8[8], br = 0.f, kr = 0.f, bon = 0.f;
#pragma unroll
                  for (int e = 0; e < 8; ++e) { const float kk = kku[e] * inv; nk[e] = -kk; bb[e] = kk * av[e]; wr8[e] = dec[e] * rc[e];
                      br += bb[e] * rc[e]; kr += kp[e] * rc[e]; bon += rc[e] * kp[e] * (e < 4 ? rk0[e & 3] : rk1[e & 3]); }
                  br = allred8(br); kr = allred8(kr); bon = allred8(bon);
                  const int o = ptok * OPS + 8 * pcg;
                  *(LAS f32x4*)(ONKK + o) = (f32x4){nk[0], nk[1], nk[2], nk[3]}; *(LAS f32x4*)(ONKK + o + 4) = (f32x4){nk[4], nk[5], nk[6], nk[7]};
                  *(LAS f32x4*)(OWR + o) = (f32x4){wr8[0], wr8[1], wr8[2], wr8[3]}; *(LAS f32x4*)(OWR + o + 4) = (f32x4){wr8[4], wr8[5], wr8[6], wr8[7]};
                  *(LAS f32x4*)(OW + o) = (f32x4){dec[0], dec[1], dec[2], dec[3]}; *(LAS f32x4*)(OW + o + 4) = (f32x4){dec[4], dec[5], dec[6], dec[7]};
                  *(LAS f32x4*)(OB + o) = (f32x4){bb[0], bb[1], bb[2], bb[3]}; *(LAS f32x4*)(OB + o + 4) = (f32x4){bb[4], bb[5], bb[6], bb[7]};
                  *(LAS f32x4*)(OKP + o) = (f32x4){kp[0], kp[1], kp[2], kp[3]}; *(LAS f32x4*)(OKP + o + 4) = (f32x4){kp[4], kp[5], kp[6], kp[7]};
                  if (pcg == 0) *(LAS f32x2*)(SC + 2 * ptok) = (f32x2){br, kr};
                  if (vmine) { const int vo = ptok * 32 + 8 * (pcg & 3);
                      *(LAS f32x4*)(VL + vo) = (f32x4){vc[0], vc[1], vc[2], vc[3]}; *(LAS f32x4*)(VL + vo + 4) = (f32x4){vc[4], vc[5], vc[6], vc[7]};
                      v4u w; w.x = pk2(bon * vc[0], bon * vc[1]); w.y = pk2(bon * vc[2], bon * vc[3]); w.z = pk2(bon * vc[4], bon * vc[5]); w.w = pk2(bon * vc[6], bon * vc[7]);
                      if (!dry) *(v4u*)(BON + (rowbase + (size_t)cc * CH2 + ptok) * DM + C0) = w; }
                }
            }
            __syncthreads();
        }
        { const int c = NCH2;
          const LAS float* YBp = (const LAS float*)(lds + L2_YB + ((c - 1) & 1) * 4096);
          const f32x4 yv = *(const LAS f32x4*)(YBp + ftok * 32 + 4 * pcg); v2u w; w.x = pk2(yv[0], yv[1]); w.y = pk2(yv[2], yv[3]);
          if (!dry) *(v2u*)(Z1 + (rowbase + (size_t)(c - 1) * CH2 + ftok) * NZ1 + ZV + h * 64 + 32 * half + 4 * pcg) = w; }
#undef WK_LOADRAW
    } else {
        const int rl = wave * 8 + (lane >> 3), s = lane & 7;
        f32x2 S01 = {0.f, 0.f}, S23 = {0.f, 0.f}, S45 = {0.f, 0.f}, S67 = {0.f, 0.f};
        __syncthreads();
        for (int c = 0; c < NCH2; ++c) {
            const LAS unsigned char* ob = lds + L2_OP + (c & 1) * L2_OPSZ;
            const LAS float* ONKK = (const LAS float*)ob; const LAS float* OWR = (const LAS float*)(ob + L2_A); const LAS float* OW = (const LAS float*)(ob + 2 * L2_A);
            const LAS float* OB = (const LAS float*)(ob + 3 * L2_A); const LAS float* OKP = (const LAS float*)(ob + 4 * L2_A);
            const LAS float* VL = (const LAS float*)(lds + L2_VL + (c & 1) * 4096); const LAS float* SC = (const LAS float*)(lds + L2_SC + (c & 1) * 256);
            LAS float* YB = (LAS float*)(lds + L2_YB + (c & 1) * 4096);
            float sak = 0.f, y0k = 0.f;
#define WK_LOAD(o, t) do { const int ofs = (t) * OPS + 8 * s; \
              o.nk0 = *(const LAS f32x4*)(ONKK + ofs); o.nk1 = *(const LAS f32x4*)(ONKK + ofs + 4); o.wr0 = *(const LAS f32x4*)(OWR + ofs); o.wr1 = *(const LAS f32x4*)(OWR + ofs + 4); \
              o.w0 = *(const LAS f32x4*)(OW + ofs); o.w1 = *(const LAS f32x4*)(OW + ofs + 4); o.b0 = *(const LAS f32x4*)(OB + ofs); o.b1 = *(const LAS f32x4*)(OB + ofs + 4); \
              o.k0 = *(const LAS f32x4*)(OKP + ofs); o.k1 = *(const LAS f32x4*)(OKP + ofs + 4); o.vi[0] = VL[(t) * 32 + rl]; } while (0)
#define P2(v, i) ((f32x2){v[i], v[(i) + 1]})
#define WK_STEP(o, tl) do { \
              f32x2 ac = pk_mul(S01, P2(o.nk0, 0)); ac = pk_fma(S23, P2(o.nk0, 2), ac); ac = pk_fma(S45, P2(o.nk1, 0), ac); ac = pk_fma(S67, P2(o.nk1, 2), ac); \
              f32x2 ay = pk_mul(S01, P2(o.wr0, 0)); ay = pk_fma(S23, P2(o.wr0, 2), ay); ay = pk_fma(S45, P2(o.wr1, 0), ay); ay = pk_fma(S67, P2(o.wr1, 2), ay); \
              float psa, py; \
              allred8x2_decay(psa, py, ac[0], ac[1], ay[0], ay[1], S01, S23, S45, S67, P2(o.w0, 0), P2(o.w0, 2), P2(o.w1, 0), P2(o.w1, 2)); \
              f32x2 sap; sap[0] = psa; \
              S01 = pk_fma_b(P2(o.b0, 0), sap, S01); S23 = pk_fma_b(P2(o.b0, 2), sap, S23); S45 = pk_fma_b(P2(o.b1, 0), sap, S45); S67 = pk_fma_b(P2(o.b1, 2), sap, S67); \
              S01 = pk_fma_b(P2(o.k0, 0), o.vi, S01); S23 = pk_fma_b(P2(o.k0, 2), o.vi, S23); S45 = pk_fma_b(P2(o.k1, 0), o.vi, S45); S67 = pk_fma_b(P2(o.k1, 2), o.vi, S67); \
              const bool mine = (s == (tl)); sak = mine ? psa : sak; y0k = mine ? py : y0k; } while (0)
            StepOps8 A0, B0; A0.vi[1] = B0.vi[1] = 0.f;
            WK_LOAD(A0, 0);
#pragma unroll 1
            for (int tb = 0; tb < CH2; tb += 8) {
                WK_LOAD(B0, tb + 1); WK_STEP(A0, 0);
                WK_LOAD(A0, tb + 2); WK_STEP(B0, 1);
                WK_LOAD(B0, tb + 3); WK_STEP(A0, 2);
                WK_LOAD(A0, tb + 4); WK_STEP(B0, 3);
                WK_LOAD(B0, tb + 5); WK_STEP(A0, 4);
                WK_LOAD(A0, tb + 6); WK_STEP(B0, 5);
                WK_LOAD(B0, tb + 7); WK_STEP(A0, 6);
                const int tn = (tb + 8) & (CH2 - 1);
                WK_LOAD(A0, tn);     WK_STEP(B0, 7);
                { const int t = tb + s; const f32x2 sc = *(const LAS f32x2*)(SC + 2 * t); YB[t * 32 + rl] = y0k + sak * sc[0] + VL[t * 32 + rl] * sc[1]; }
            }
#undef WK_LOAD
#undef WK_STEP
#undef P2
            __syncthreads();
        }
        if (!dry) { float* so = p.out + O_WKVP + ((size_t)(b * 16 + h) * 64 + 32 * half + rl) * 64 + 8 * s; *(f32x4*)so = (f32x4){S01[0], S01[1], S23[0], S23[1]}; *(f32x4*)(so + 4) = (f32x4){S45[0], S45[1], S67[0], S67[1]}; }
    }
    __syncthreads();
}

__device__ __forceinline__ void wkv_sample(CP& p, LAS unsigned char* lds, bool dry) {
    int tid_l = threadIdx.x; asm volatile("" : "+v"(tid_l)); const int tid = tid_l, lane = tid & 63;
    const int i = tid >> 3, s8 = tid & 7;
    bf16* Z1 = (bf16*)(p.ws + WS_Z1); bf16* BON = (bf16*)(p.ws + WS_BONUS);
    LAS float* TW = (LAS float*)lds; LAS float* TA = TW + 256; LAS float* ONKK = TW + 512; LAS float* OWR = TW + 768; LAS float* OW = TW + 1024;
    LAS float* OB = TW + 1280; LAS float* OKP = TW + 1536; LAS float* VV = TW + 1792; LAS float* SC = TW + 2048; LAS float* YS = TW + 2064;
    const float* Sin = p.in[I_WKV];
    int u = blockIdx.x;
    f32x4 sa0, sa1;
    if (u < DECB * 16) { const float* sp = Sin + ((size_t)u * 64 + i) * 64 + 8 * s8; sa0 = *(const f32x4*)sp; sa1 = *(const f32x4*)(sp + 4); }
    for (; u < DECB * 16; u += gridDim.x) {
        const int b = u >> 4, h = u & 15;
        float S[8] = {sa0[0], sa0[1], sa0[2], sa0[3], sa1[0], sa1[1], sa1[2], sa1[3]};
        { const int un = u + gridDim.x; if (un < DECB * 16) { const float* sp = Sin + ((size_t)un * 64 + i) * 64 + 8 * s8; sa0 = *(const f32x4*)sp; sa1 = *(const f32x4*)(sp + 4); } }
        const int tok = tid >> 6, c = lane, C = h * 64 + c;
        const size_t rowc = (size_t)MP + 4 * b + (tok & 3), rowp = (tok & 3) == 0 ? (size_t)MT + b : rowc - 1;
        float r = 0.f, k = 0.f, v = 0.f;
        if (tid < 256) {
            const bf16* zc = Z1 + rowc * NZ1; const bf16* zp = Z1 + rowp * NZ1; const float* mu = p.in[I_MU];
            r = bf2f(zc[ZR + C]); r += mu[ZR + C] * (bf2f(zp[ZR + C]) - r);
            k = bf2f(zc[ZK + C]); k += mu[ZK + C] * (bf2f(zp[ZK + C]) - k);
            v = bf2f(zc[ZV + C]); v += mu[ZV + C] * (bf2f(zp[ZV + C]) - v);
            float wl = bf2f(zc[ZWL + c]); wl += mu[ZWL + c] * (bf2f(zp[ZWL + c]) - wl);
            float al = bf2f(zc[ZAL + c]); al += mu[ZAL + c] * (bf2f(zp[ZAL + c]) - al);
            TW[tok * 64 + c] = tanh_(wl); TA[tok * 64 + c] = al;
        }
        __syncthreads();
        if (tid < 256) {
            float wp = 0.f, ap = 0.f; const float* w2 = p.in[I_W2] + C; const float* a2 = p.in[I_A2] + C;
#pragma unroll 8
            for (int kk = 0; kk < 64; ++kk) { wp += TW[tok * 64 + kk] * w2[(size_t)kk * DM]; ap += TA[tok * 64 + kk] * a2[(size_t)kk * DM]; }
            const float dec = __expf(-0.6065306597126334f * sigm(p.in[I_W0][C] + wp));
            const float a = sigm(p.in[I_A0][C] + ap);
            const float kku = k * p.in[I_KK][C];
            const float kp = k * (1.f + (a - 1.f) * p.in[I_KA][C]);
            const float ss = wave_sum(kku * kku);
            const float kk = kku / fmaxf(sqrtf(ss), 1e-12f);
            const float bb = kk * a;
            const float br = wave_sum(bb * r), kr = wave_sum(kp * r), bon = wave_sum(r * kp * p.in[I_RK][C]);
            ONKK[tok * 64 + c] = -kk; OWR[tok * 64 + c] = dec * r; OW[tok * 64 + c] = dec; OB[tok * 64 + c] = bb; OKP[tok * 64 + c] = kp; VV[tok * 64 + c] = v;
            if (c == 0) { SC[2 * tok] = br; SC[2 * tok + 1] = kr; }
            if (!dry) BON[rowc * DM + C] = (bf16)f2bf(bon * v);
        }
        __syncthreads();
#pragma unroll
        for (int t = 0; t < 4; ++t) {
            const f32x4 n0 = *(LAS f32x4*)(ONKK + t * 64 + 8 * s8), n1 = *(LAS f32x4*)(ONKK + t * 64 + 8 * s8 + 4);
            const f32x4 q0 = *(LAS f32x4*)(OWR + t * 64 + 8 * s8), q1 = *(LAS f32x4*)(OWR + t * 64 + 8 * s8 + 4);
            const f32x4 w0 = *(LAS f32x4*)(OW + t * 64 + 8 * s8), w1 = *(LAS f32x4*)(OW + t * 64 + 8 * s8 + 4);
            const f32x4 b0 = *(LAS f32x4*)(OB + t * 64 + 8 * s8), b1 = *(LAS f32x4*)(OB + t * 64 + 8 * s8 + 4);
            const f32x4 k0 = *(LAS f32x4*)(OKP + t * 64 + 8 * s8), k1 = *(LAS f32x4*)(OKP + t * 64 + 8 * s8 + 4);
            const float vi = VV[t * 64 + i], br = SC[2 * t], kr = SC[2 * t + 1];
            float psa = 0.f, py = 0.f;
#pragma unroll
            for (int e = 0; e < 8; ++e) { psa += S[e] * (e < 4 ? n0[e & 3] : n1[e & 3]); py += S[e] * (e < 4 ? q0[e & 3] : q1[e & 3]); }
            const float sa = allred8(psa), y0 = allred8(py);
#pragma unroll
            for (int e = 0; e < 8; ++e) S[e] = S[e] * (e < 4 ? w0[e & 3] : w1[e & 3]) + sa * (e < 4 ? b0[e & 3] : b1[e & 3]) + vi * (e < 4 ? k0[e & 3] : k1[e & 3]);
            if (s8 == 0) YS[t * 64 + i] = y0 + sa * br + vi * kr;
        }
        if (!dry) { float* so = p.out + O_WKVS + ((size_t)u * 64 + i) * 64 + 8 * s8; *(f32x4*)so = (f32x4){S[0], S[1], S[2], S[3]}; *(f32x4*)(so + 4) = (f32x4){S[4], S[5], S[6], S[7]}; }
        __syncthreads();
        if (tid < 256 && !dry) Z1[rowc * NZ1 + ZV + C] = (bf16)f2bf(YS[tok * 64 + c]);
        __syncthreads();
    }
}

__device__ __forceinline__ void wkv_sample2(CP& p, LAS unsigned char* lds, bool dry) {
    int tid_l = threadIdx.x; asm volatile("" : "+v"(tid_l)); const int tid = tid_l, wave = tid >> 6, lane = tid & 63, fr = lane & 15, q = lane >> 4;
    bf16* Z1 = (bf16*)(p.ws + WS_Z1); bf16* BON = (bf16*)(p.ws + WS_BONUS);
    const bf16* w2T = (const bf16*)(p.ws + WS_SMALL); const bf16* a2T = w2T + 65536;
    LAS float* OPN = (LAS float*)lds; LAS float* OPWR = OPN + 2048; LAS float* OPW = OPN + 4096; LAS float* OPB = OPN + 6144; LAS float* OPK = OPN + 8192;
    LAS float* VV = OPN + 10240; LAS float* YS = OPN + 12288; LAS float* SC = OPN + 14336;
    const float* Sin = p.in[I_WKV]; const float* mu = p.in[I_MU];
    const int i = tid >> 3, s8 = tid & 7;
    for (int unit = blockIdx.x; unit < DECB * 2; unit += gridDim.x) {
        const int b = unit >> 1, hh = unit & 1;
        f32x4 sa0, sa1;
        { const float* sp = Sin + ((size_t)(b * 16 + 8 * hh) * 64 + i) * 64 + 8 * s8; sa0 = *(const f32x4*)sp; sa1 = *(const f32x4*)(sp + 4); }
        { bf16x8 Tw[2], Ta[2];
          const size_t rowc = (size_t)MP + 4 * b + (fr & 3), rowp = (fr & 3) == 0 ? (size_t)MT + b : rowc - 1;
#pragma unroll
          for (int ks = 0; ks < 2; ++ks) { const int ko = 32 * ks + 8 * q;
              v4u cw = *(const v4u*)(Z1 + rowc * NZ1 + ZWL + ko), pw = *(const v4u*)(Z1 + rowp * NZ1 + ZWL + ko), ca = *(const v4u*)(Z1 + rowc * NZ1 + ZAL + ko), pa = *(const v4u*)(Z1 + rowp * NZ1 + ZAL + ko);
              const f32x4 m0 = *(const f32x4*)(mu + ZWL + ko), m1 = *(const f32x4*)(mu + ZWL + ko + 4), n0 = *(const f32x4*)(mu + ZAL + ko), n1 = *(const f32x4*)(mu + ZAL + ko + 4);
              float cf[8], pf[8], o[8]; UNPACK8(cw, cf); UNPACK8(pw, pf);
#pragma unroll
              for (int e = 0; e < 8; ++e) o[e] = fr < 4 ? tanh_(cf[e] + (e < 4 ? m0[e & 3] : m1[e & 3]) * (pf[e] - cf[e])) : 0.f;
              { v4u w; w.x = pk2(o[0], o[1]); w.y = pk2(o[2], o[3]); w.z = pk2(o[4], o[5]); w.w = pk2(o[6], o[7]); Tw[ks] = __builtin_bit_cast(bf16x8, w); }
              UNPACK8(ca, cf); UNPACK8(pa, pf);
#pragma unroll
              for (int e = 0; e < 8; ++e) o[e] = fr < 4 ? cf[e] + (e < 4 ? n0[e & 3] : n1[e & 3]) * (pf[e] - cf[e]) : 0.f;
              { v4u w; w.x = pk2(o[0], o[1]); w.y = pk2(o[2], o[3]); w.z = pk2(o[4], o[5]); w.w = pk2(o[6], o[7]); Ta[ks] = __builtin_bit_cast(bf16x8, w); } }
#pragma unroll
          for (int nbi = 0; nbi < 4; ++nbi) { const int nb = 4 * wave + nbi; const size_t n = (size_t)512 * hh + 16 * nb + fr;
              f32x4 aw = {0.f, 0.f, 0.f, 0.f}, aa = {0.f, 0.f, 0.f, 0.f};
#pragma unroll
              for (int ks = 0; ks < 2; ++ks) { const bf16x8 bw = *(const bf16x8*)(w2T + n * 64 + 32 * ks + 8 * q), ba = *(const bf16x8*)(a2T + n * 64 + 32 * ks + 8 * q);
                  aw = __builtin_amdgcn_mfma_f32_16x16x32_bf16(bw, Tw[ks], aw, 0, 0, 0); aa = __builtin_amdgcn_mfma_f32_16x16x32_bf16(ba, Ta[ks], aa, 0, 0, 0); }
              if (fr < 4) { *(LAS f32x4*)(OPW + fr * 512 + 16 * nb + 4 * q) = aw; *(LAS f32x4*)(OPB + fr * 512 + 16 * nb + 4 * q) = aa; } } }
        __syncthreads();
        { const int tok = tid >> 7, cg = tid & 127, Cl = 4 * cg, C = 512 * hh + Cl;
          const size_t rowc = (size_t)MP + 4 * b + tok, rowp = tok == 0 ? (size_t)MT + b : rowc - 1;
          const bf16* zc = Z1 + rowc * NZ1; const bf16* zp = Z1 + rowp * NZ1;
          const v2u ru = *(const v2u*)(zc + ZR + C), rpu = *(const v2u*)(zp + ZR + C), ku = *(const v2u*)(zc + ZK + C), kpu = *(const v2u*)(zp + ZK + C), vu = *(const v2u*)(zc + ZV + C), vpu = *(const v2u*)(zp + ZV + C);
          const f32x4 mr = *(const f32x4*)(mu + ZR + C), mk = *(const f32x4*)(mu + ZK + C), mv = *(const f32x4*)(mu + ZV + C);
          const f32x4 w0 = *(const f32x4*)(p.in[I_W0] + C), a0 = *(const f32x4*)(p.in[I_A0] + C), kkc = *(const f32x4*)(p.in[I_KK] + C), kac = *(const f32x4*)(p.in[I_KA] + C), rkc = *(const f32x4*)(p.in[I_RK] + C);
          const f32x4 wp = *(LAS f32x4*)(OPW + tok * 512 + Cl), ap = *(LAS f32x4*)(OPB + tok * 512 + Cl);
          const float rc_[4] = {lo16(ru.x), hi16(ru.x), lo16(ru.y), hi16(ru.y)}, rp_[4] = {lo16(rpu.x), hi16(rpu.x), lo16(rpu.y), hi16(rpu.y)};
          const float kc_[4] = {lo16(ku.x), hi16(ku.x), lo16(ku.y), hi16(ku.y)}, kp_[4] = {lo16(kpu.x), hi16(kpu.x), lo16(kpu.y), hi16(kpu.y)};
          const float vc_[4] = {lo16(vu.x), hi16(vu.x), lo16(vu.y), hi16(vu.y)}, vp_[4] = {lo16(vpu.x), hi16(vpu.x), lo16(vpu.y), hi16(vpu.y)};
          float r[4], k[4], v[4], dec[4], av[4], kku[4], kp[4], ss = 0.f;
#pragma unroll
          for (int e = 0; e < 4; ++e) { r[e] = rc_[e] + mr[e] * (rp_[e] - rc_[e]); k[e] = kc_[e] + mk[e] * (kp_[e] - kc_[e]); v[e] = vc_[e] + mv[e] * (vp_[e] - vc_[e]);
              dec[e] = __expf(-0.6065306597126334f * sigm(w0[e] + wp[e])); av[e] = sigm(a0[e] + ap[e]); kku[e] = k[e] * kkc[e]; kp[e] = k[e] * (1.f + (av[e] - 1.f) * kac[e]); ss += kku[e] * kku[e]; }
          ss = allred16(ss);
          const float inv = __builtin_amdgcn_rsqf(fmaxf(ss, 1e-24f));
          float nk[4], bb[4], wr[4], br = 0.f, kr = 0.f, bon = 0.f;
#pragma unroll
          for (int e = 0; e < 4; ++e) { const float kk = kku[e] * inv; nk[e] = -kk; bb[e] = kk * av[e]; wr[e] = dec[e] * r[e]; br += bb[e] * r[e]; kr += kp[e] * r[e]; bon += r[e] * kp[e] * rkc[e]; }
          br = allred16(br); kr = allred16(kr); bon = allred16(bon);
          const int o = tok * 512 + Cl;
          *(LAS f32x4*)(OPN + o) = (f32x4){nk[0], nk[1], nk[2], nk[3]}; *(LAS f32x4*)(OPWR + o) = (f32x4){wr[0], wr[1], wr[2], wr[3]}; *(LAS f32x4*)(OPW + o) = (f32x4){dec[0], dec[1], dec[2], dec[3]};
          *(LAS f32x4*)(OPB + o) = (f32x4){bb[0], bb[1], bb[2], bb[3]}; *(LAS f32x4*)(OPK + o) = (f32x4){kp[0], kp[1], kp[2], kp[3]}; *(LAS f32x4*)(VV + o) = (f32x4){v[0], v[1], v[2], v[3]};
          if ((cg & 15) == 0) *(LAS f32x2*)(SC + (tok * 8 + (cg >> 4)) * 2) = (f32x2){br, kr};
          if (!dry) *(v2u*)(BON + rowc * DM + C) = (v2u){pk2(bon * v[0], bon * v[1]), pk2(bon * v[2], bon * v[3])};
        }
        __syncthreads();
        for (int hl = 0; hl < 8; ++hl) {
            float S[8] = {sa0[0], sa0[1], sa0[2], sa0[3], sa1[0], sa1[1], sa1[2], sa1[3]};
            const size_t sidx = ((size_t)(b * 16 + 8 * hh + hl) * 64 + i) * 64 + 8 * s8;
            if (hl < 7) { const float* sp = Sin + sidx + 4096; sa0 = *(const f32x4*)sp; sa1 = *(const f32x4*)(sp + 4); }
#pragma unroll
            for (int t = 0; t < 4; ++t) { const int o = t * 512 + 64 * hl + 8 * s8;
                const f32x4 n0 = *(LAS f32x4*)(OPN + o), n1 = *(LAS f32x4*)(OPN + o + 4), q0 = *(LAS f32x4*)(OPWR + o), q1 = *(LAS f32x4*)(OPWR + o + 4);
                const f32x4 w0 = *(LAS f32x4*)(OPW + o), w1 = *(LAS f32x4*)(OPW + o + 4), b0 = *(LAS f32x4*)(OPB + o), b1 = *(LAS f32x4*)(OPB + o + 4);
                const f32x4 k0 = *(LAS f32x4*)(OPK + o), k1 = *(LAS f32x4*)(OPK + o + 4);
                const float vi = VV[t * 512 + 64 * hl + i]; const f32x2 sc = *(LAS f32x2*)(SC + (t * 8 + hl) * 2);
                float psa = 0.f, py = 0.f;
#pragma unroll
                for (int e = 0; e < 8; ++e) { psa += S[e] * (e < 4 ? n0[e & 3] : n1[e & 3]); py += S[e] * (e < 4 ? q0[e & 3] : q1[e & 3]); }
                const float sa = allred8(psa), y0 = allred8(py);
#pragma unroll
                for (int e = 0; e < 8; ++e) S[e] = S[e] * (e < 4 ? w0[e & 3] : w1[e & 3]) + sa * (e < 4 ? b0[e & 3] : b1[e & 3]) + vi * (e < 4 ? k0[e & 3] : k1[e & 3]);
                if (s8 == 0) YS[t * 512 + 64 * hl + i] = y0 + sa * sc[0] + vi * sc[1]; }
            if (!dry) { float* so = p.out + O_WKVS + sidx; *(f32x4*)so = (f32x4){S[0], S[1], S[2], S[3]}; *(f32x4*)(so + 4) = (f32x4){S[4], S[5], S[6], S[7]}; }
        }
        __syncthreads();
        { const int tok = tid >> 7, Cl = 4 * (tid & 127); const f32x4 yv = *(LAS f32x4*)(YS + tok * 512 + Cl);
          if (!dry) *(v2u*)(Z1 + ((size_t)MP + 4 * b + tok) * NZ1 + ZV + 512 * hh + Cl) = (v2u){pk2(yv[0], yv[1]), pk2(yv[2], yv[3])}; }
        __syncthreads();
    }
}

constexpr int LL_XR = 0, LL_UB = 8704, LL_UF = 17920, LL_PR = 26112, LL_PI = 34560, LL_CA = 43008, LL_CB = 45056, LL_HC = 47104;
__device__ __forceinline__ void lru_prompt(CP& p, LAS unsigned char* lds, int unit, bool dry) {
    int tid_l = threadIdx.x; asm volatile("" : "+v"(tid_l)); const int tid = tid_l, wave = tid >> 6, lane = tid & 63;
    const int b = unit >> 5, n = (unit >> 1) & 15, hf = unit & 1;
    const int ptok = tid >> 3, pcg = tid & 7;
    bf16* Z1 = (bf16*)(p.ws + WS_Z1);
    const bf16* waT = (const bf16*)(p.ws + WS_SMALL) + 262144; const bf16* wiT = waT + 65536;
    const size_t rowbase = (size_t)b * SEQ;
    LAS bf16* XR = (LAS bf16*)(lds + LL_XR); LAS bf16* UB = (LAS bf16*)(lds + LL_UB); LAS float* UF = (LAS float*)(lds + LL_UF);
    LAS float* PR = (LAS float*)(lds + LL_PR); LAS float* PI = (LAS float*)(lds + LL_PI); LAS float* CA = (LAS float*)(lds + LL_CA);
    LAS float* CB = (LAS float*)(lds + LL_CB); LAS float* HC = (LAS float*)(lds + LL_HC);
    if (tid < 96) ((LAS unsigned*)XR)[tid] = 0u;
    if (tid < 32) HC[tid] = 0.f;
    const int mb = wave & 3, gate = wave >> 2, fr = lane & 15, q = lane >> 4;
    bf16x8 Bf[2][2];
#pragma unroll
    for (int nb = 0; nb < 2; ++nb)
#pragma unroll
        for (int ks = 0; ks < 2; ++ks) Bf[nb][ks] = *(const bf16x8*)((gate ? wiT : waT) + (size_t)n * 4096 + (32 * hf + 16 * nb + fr) * 64 + 32 * ks + 8 * q);
    const int dl = tid & 31, sub = tid >> 5, Cs = 64 * n + 32 * hf + dl;
    const int etok = tid >> 3, dg = tid & 7, Ce = 64 * n + 32 * hf + 4 * dg;
    const f32x4 ba4 = *(const f32x4*)(p.in[I_BA] + Ce), bi4 = *(const f32x4*)(p.in[I_BI] + Ce), lam4 = *(const f32x4*)(p.in[I_LAM] + Ce);
    f32x4 sp4;
#pragma unroll
    for (int e = 0; e < 4; ++e) sp4[e] = -8.f * __logf(1.f + __expf(-lam4[e]));
    const int Cc = 64 * n + 8 * pcg;
    v4u px = *(const v4u*)(Z1 + (rowbase + ptok) * NZ1 + ZXB + Cc);
    float hlast = 0.f;
    const f32x4 cb0 = *(const f32x4*)(p.in[I_CB] + Cc), cb1 = *(const f32x4*)(p.in[I_CB] + Cc + 4);
    f32x4 cw0[4], cw1[4];
#pragma unroll
    for (int j = 0; j < 4; ++j) { cw0[j] = *(const f32x4*)(p.in[I_CW] + j * DM + Cc); cw1[j] = *(const f32x4*)(p.in[I_CW] + j * DM + Cc + 4); }
    unsigned short gbn[4];
#pragma unroll
    for (int i2 = 0; i2 < 4; ++i2) gbn[i2] = Z1[(rowbase + 4 * sub + i2) * NZ1 + ZGB + Cs];
    for (int c = 0; c < SEQ / 64; ++c) {
        if (ptok >= 61 && c > 0) *(LAS v4u*)(XR + (ptok - 61) * 64 + 8 * pcg) = *(LAS v4u*)(XR + (3 + ptok) * 64 + 8 * pcg);
        *(LAS v4u*)(XR + (3 + ptok) * 64 + 8 * pcg) = px;
        __syncthreads();
        if (c + 1 < SEQ / 64) px = *(const v4u*)(Z1 + (rowbase + (size_t)(c + 1) * 64 + ptok) * NZ1 + ZXB + Cc);
        unsigned short gbr[4];
#pragma unroll
        for (int i2 = 0; i2 < 4; ++i2) gbr[i2] = gbn[i2];
        if (c + 1 < SEQ / 64) {
#pragma unroll
            for (int i2 = 0; i2 < 4; ++i2) gbn[i2] = Z1[(rowbase + (size_t)(c + 1) * 64 + 4 * sub + i2) * NZ1 + ZGB + Cs]; }
        { float u8[8];
#pragma unroll
          for (int e = 0; e < 8; ++e) u8[e] = e < 4 ? cb0[e & 3] : cb1[e & 3];
#pragma unroll
          for (int j = 0; j < 4; ++j) { const v4u xu = *(LAS v4u*)(XR + (ptok + j) * 64 + 8 * pcg); float xf[8]; UNPACK8(xu, xf);
#pragma unroll
              for (int e = 0; e < 8; ++e) u8[e] += (e < 4 ? cw0[j][e & 3] : cw1[j][e & 3]) * xf[e]; }
          v4u w; w.x = pk2(u8[0], u8[1]); w.y = pk2(u8[2], u8[3]); w.z = pk2(u8[4], u8[5]); w.w = pk2(u8[6], u8[7]);
          *(LAS v4u*)(UB + ptok * 72 + 8 * pcg) = w;
          if ((pcg >> 2) == hf) { *(LAS f32x4*)(UF + ptok * 32 + 8 * (pcg & 3)) = (f32x4){u8[0], u8[1], u8[2], u8[3]}; *(LAS f32x4*)(UF + ptok * 32 + 8 * (pcg & 3) + 4) = (f32x4){u8[4], u8[5], u8[6], u8[7]}; }
        }
        __syncthreads();
        { const bf16x8 A0 = *(LAS bf16x8*)(UB + (16 * mb + fr) * 72 + 8 * q), A1 = *(LAS bf16x8*)(UB + (16 * mb + fr) * 72 + 32 + 8 * q);
          LAS float* P = gate ? PI : PR;
#pragma unroll
          for (int nb = 0; nb < 2; ++nb) { f32x4 acc = {0.f, 0.f, 0.f, 0.f};
              acc = __builtin_amdgcn_mfma_f32_16x16x32_bf16(A0, Bf[nb][0], acc, 0, 0, 0); acc = __builtin_amdgcn_mfma_f32_16x16x32_bf16(A1, Bf[nb][1], acc, 0, 0, 0);
#pragma unroll
              for (int r = 0; r < 4; ++r) P[(16 * mb + 4 * q + r) * 33 + 16 * nb + fr] = acc[r]; } }
        __syncthreads();
        {
#pragma unroll
          for (int e = 0; e < 4; ++e) { const int o = etok * 33 + 4 * dg + e;
              const float rg = sigm(PR[o] + ba4[e]), ig = sigm(PI[o] + bi4[e]);
              const float a = __expf(sp4[e] * rg);
              float mult = sqrtf(fmaxf(1.f - a * a, 0.f)); if (c == 0 && etok == 0) mult = 1.f;
              PR[o] = a; PI[o] = mult * ig * UF[etok * 32 + 4 * dg + e]; } }
        __syncthreads();
        { float av[4], bx[4];
#pragma unroll
          for (int i2 = 0; i2 < 4; ++i2) { av[i2] = PR[(4 * sub + i2) * 33 + dl]; bx[i2] = PI[(4 * sub + i2) * 33 + dl]; }
          float hl = 0.f, ap = 1.f;
#pragma unroll
          for (int i2 = 0; i2 < 4; ++i2) { hl = av[i2] * hl + bx[i2]; ap *= av[i2]; }
          CA[sub * 32 + dl] = ap; CB[sub * 32 + dl] = hl;
          float h = HC[dl];
          __syncthreads();
          for (int s2 = 0; s2 < sub; ++s2) h = CA[s2 * 32 + dl] * h + CB[s2 * 32 + dl];
#pragma unroll
          for (int i2 = 0; i2 < 4; ++i2) { h = av[i2] * h + bx[i2];
              if (!dry) Z1[(rowbase + (size_t)c * 64 + 4 * sub + i2) * NZ1 + ZGB + Cs] = (bf16)f2bf(h * gelu_tanh(bf2f(gbr[i2]))); }
          if (sub == 15) { HC[dl] = h; hlast = h; }
        }
        __syncthreads();
    }
    if (sub == 15 && !dry) p.out[O_LRUP + (size_t)b * DM + Cs] = hlast;
    if (hf == 0 && tid < 192 && !dry) { const int j = tid >> 6, cc = tid & 63; p.out[O_CONVP + ((size_t)b * 3 + j) * DM + 64 * n + cc] = bf2f(XR[(64 + j) * 64 + cc]); }
    __syncthreads();
}

constexpr int L3_XR = 0, L3_UB = 17152, L3_UF = 26368, L3_GB = 34560, L3_CA = 42752, L3_CB = 44800, L3_HC = 46848, L3_YL = 47104;
__device__ __forceinline__ void lru_prompt2(CP& p, LAS unsigned char* lds, int unit, bool dry) {
    int tid_l = threadIdx.x; asm volatile("" : "+v"(tid_l)); const int tid = tid_l, wave = tid >> 6, lane = tid & 63, fr = lane & 15, q = lane >> 4;
    const int b = unit >> 5, n = (unit >> 1) & 15, hf = unit & 1;
    const int ptok = tid >> 3, pcg = tid & 7;
    bf16* Z1 = (bf16*)(p.ws + WS_Z1);
    const bf16* waT = (const bf16*)(p.ws + WS_SMALL) + 262144; const bf16* wiT = waT + 65536;
    const size_t rowbase = (size_t)b * SEQ;
    LAS bf16* XR = (LAS bf16*)(lds + L3_XR); LAS bf16* UB = (LAS bf16*)(lds + L3_UB); LAS float* UF = (LAS float*)(lds + L3_UF); LAS bf16* GBS = (LAS bf16*)(lds + L3_GB);
    LAS float* CA = (LAS float*)(lds + L3_CA); LAS float* CB = (LAS float*)(lds + L3_CB); LAS float* HC = (LAS float*)(lds + L3_HC); LAS bf16* YL = (LAS bf16*)(lds + L3_YL);
    const int mb = wave & 3, nbh = wave >> 2, dl = 16 * nbh + fr, Cs = 64 * n + 32 * hf + dl, tg = 4 * mb + q;
    bf16x8 Bf[2][2];
#pragma unroll
    for (int g = 0; g < 2; ++g)
#pragma unroll
        for (int ks = 0; ks < 2; ++ks) Bf[g][ks] = *(const bf16x8*)((g ? wiT : waT) + (size_t)n * 4096 + (32 * hf + dl) * 64 + 32 * ks + 8 * q);
    const float bac = p.in[I_BA][Cs], bic = p.in[I_BI][Cs], spc = -8.f * __logf(1.f + __expf(-p.in[I_LAM][Cs]));
    const int Cc = 64 * n + 8 * pcg; const bool gmine = (pcg >> 2) == hf;
    const f32x4 cb0 = *(const f32x4*)(p.in[I_CB] + Cc), cb1 = *(const f32x4*)(p.in[I_CB] + Cc + 4);
    f32x4 cw0[4], cw1[4];
#pragma unroll
    for (int j = 0; j < 4; ++j) { cw0[j] = *(const f32x4*)(p.in[I_CW] + j * DM + Cc); cw1[j] = *(const f32x4*)(p.in[I_CW] + j * DM + Cc + 4); }
    if (tid < 96) ((LAS unsigned*)XR)[tid] = 0u;
    if (tid < 32) HC[tid] = 0.f;
    { const bf16* z = Z1 + (rowbase + ptok) * NZ1;
      *(LAS v4u*)(XR + (3 + ptok) * 64 + 8 * pcg) = *(const v4u*)(z + ZXB + Cc);
      if (gmine) *(LAS v4u*)(GBS + ptok * 32 + 8 * (pcg & 3)) = *(const v4u*)(z + ZGB + Cc); }
    __syncthreads();
    float hlast = 0.f;
    for (int c = 0; c < SEQ / 64; ++c) {
        const int cb = c & 1;
        LAS bf16* XRc = XR + cb * (67 * 64); LAS bf16* XRn = XR + (cb ^ 1) * (67 * 64); LAS bf16* GBc = GBS + cb * 2048; LAS bf16* GBn = GBS + (cb ^ 1) * 2048;
        v4u px = {0u, 0u, 0u, 0u}, pg = px;
        if (c + 1 < SEQ / 64) { const bf16* z = Z1 + (rowbase + (size_t)(c + 1) * 64 + ptok) * NZ1; px = *(const v4u*)(z + ZXB + Cc); if (gmine) pg = *(const v4u*)(z + ZGB + Cc); }
        { float u8[8];
#pragma unroll
          for (int e = 0; e < 8; ++e) u8[e] = e < 4 ? cb0[e & 3] : cb1[e & 3];
#pragma unroll
          for (int j = 0; j < 4; ++j) { const v4u xu = *(LAS v4u*)(XRc + (ptok + j) * 64 + 8 * pcg); float xf[8]; UNPACK8(xu, xf);
#pragma unroll
              for (int e = 0; e < 8; ++e) u8[e] += (e < 4 ? cw0[j][e & 3] : cw1[j][e & 3]) * xf[e]; }
          *(LAS v4u*)(UB + ptok * 72 + 8 * pcg) = (v4u){pk2(u8[0], u8[1]), pk2(u8[2], u8[3]), pk2(u8[4], u8[5]), pk2(u8[6], u8[7])};
          if (gmine) { *(LAS f32x4*)(UF + ptok * 32 + 8 * (pcg & 3)) = (f32x4){u8[0], u8[1], u8[2], u8[3]}; *(LAS f32x4*)(UF + ptok * 32 + 8 * (pcg & 3) + 4) = (f32x4){u8[4], u8[5], u8[6], u8[7]}; } }
        __syncthreads();
        float av[4], bx[4];
        { const bf16x8 A0 = *(LAS bf16x8*)(UB + (16 * mb + fr) * 72 + 8 * q), A1 = *(LAS bf16x8*)(UB + (16 * mb + fr) * 72 + 32 + 8 * q);
          f32x4 ar = {0.f, 0.f, 0.f, 0.f}, ai = {0.f, 0.f, 0.f, 0.f};
          ar = __builtin_amdgcn_mfma_f32_16x16x32_bf16(A0, Bf[0][0], ar, 0, 0, 0); ar = __builtin_amdgcn_mfma_f32_16x16x32_bf16(A1, Bf[0][1], ar, 0, 0, 0);
          ai = __builtin_amdgcn_mfma_f32_16x16x32_bf16(A0, Bf[1][0], ai, 0, 0, 0); ai = __builtin_amdgcn_mfma_f32_16x16x32_bf16(A1, Bf[1][1], ai, 0, 0, 0);
          float hl = 0.f, ap = 1.f;
#pragma unroll
          for (int r = 0; r < 4; ++r) { const int tok = 16 * mb + 4 * q + r;
              const float rg = sigm(ar[r] + bac), ig = sigm(ai[r] + bic); const float a = __expf(spc * rg);
              float mult = sqrtf(fmaxf(1.f - a * a, 0.f)); if (c == 0 && tok == 0) mult = 1.f;
              av[r] = a; bx[r] = mult * ig * UF[tok * 32 + dl]; hl = a * hl + bx[r]; ap *= a; }
          CA[tg * 32 + dl] = ap; CB[tg * 32 + dl] = hl; }
        __syncthreads();
        { float h = HC[cb * 32 + dl];
          for (int s2 = 0; s2 < tg; ++s2) h = CA[s2 * 32 + dl] * h + CB[s2 * 32 + dl];
#pragma unroll
          for (int r = 0; r < 4; ++r) { const int tok = 16 * mb + 4 * q + r; h = av[r] * h + bx[r];
              YL[tok * 32 + dl] = (bf16)f2bf(h * gelu_tanh(bf2f(GBc[tok * 32 + dl]))); }
          if (tg == 15) { HC[(cb ^ 1) * 32 + dl] = h; hlast = h; }
          if (c + 1 < SEQ / 64) {
              if (ptok >= 61) *(LAS v4u*)(XRn + (ptok - 61) * 64 + 8 * pcg) = *(LAS v4u*)(XRc + (3 + ptok) * 64 + 8 * pcg);
              *(LAS v4u*)(XRn + (3 + ptok) * 64 + 8 * pcg) = px;
              if (gmine) *(LAS v4u*)(GBn + ptok * 32 + 8 * (pcg & 3)) = pg; } }
        __syncthreads();
        if (tid < 256 && !dry) { const int tok = tid >> 2, part = tid & 3;
            *(v4u*)(Z1 + (rowbase + (size_t)c * 64 + tok) * NZ1 + ZGB + 64 * n + 32 * hf + 8 * part) = *(LAS v4u*)(YL + tok * 32 + 8 * part); }
    }
    if (tg == 15 && !dry) p.out[O_LRUP + (size_t)b * DM + Cs] = hlast;
    if (hf == 0 && tid < 192 && !dry) { const int j = tid >> 6, cc = tid & 63; p.out[O_CONVP + ((size_t)b * 3 + j) * DM + 64 * n + cc] = bf2f(XR[((SEQ / 64 - 1) & 1) * (67 * 64) + (64 + j) * 64 + cc]); }
    __syncthreads();
}

__device__ __forceinline__ void lru_sample(CP& p, LAS unsigned char* lds, bool dry) {
    int tid_l = threadIdx.x; asm volatile("" : "+v"(tid_l)); const int tid = tid_l;
    bf16* Z1 = (bf16*)(p.ws + WS_Z1);
    LAS float* U = (LAS float*)lds;
    for (int b = blockIdx.x; b < DECB; b += gridDim.x) {
        const int C = 2 * tid, n = C >> 6, d = C & 63;
        float xp0[7], xp1[7];
#pragma unroll
        for (int j = 0; j < 3; ++j) { const f32x2 v = *(const f32x2*)(p.in[I_CONV] + ((size_t)b * 3 + j) * DM + C); xp0[j] = v[0]; xp1[j] = v[1]; }
#pragma unroll
        for (int j = 0; j < 4; ++j) { const unsigned v = *(const unsigned*)(Z1 + ((size_t)MP + 4 * b + j) * NZ1 + ZXB + C); xp0[3 + j] = lo16(v); xp1[3 + j] = hi16(v); }
        { const f32x2 cb = *(const f32x2*)(p.in[I_CB] + C); f32x2 cw[4];
#pragma unroll
          for (int j = 0; j < 4; ++j) cw[j] = *(const f32x2*)(p.in[I_CW] + j * DM + C);
#pragma unroll
          for (int t = 0; t < 4; ++t) { float u0 = cb[0], u1 = cb[1];
#pragma unroll
              for (int j = 0; j < 4; ++j) { u0 += cw[j][0] * xp0[t + j]; u1 += cw[j][1] * xp1[t + j]; }
              *(LAS f32x2*)(U + t * DM + C) = (f32x2){u0, u1}; } }
        __syncthreads();
        float pr[4][2], pi[4][2];
#pragma unroll
        for (int t = 0; t < 4; ++t) { pr[t][0] = pr[t][1] = pi[t][0] = pi[t][1] = 0.f; }
        const float* wa = p.in[I_WA] + (size_t)n * 4096 + d; const float* wi = p.in[I_WI] + (size_t)n * 4096 + d;
#pragma unroll 4
        for (int cc = 0; cc < 64; ++cc) { const f32x2 a = *(const f32x2*)(wa + cc * 64), i2 = *(const f32x2*)(wi + cc * 64);
#pragma unroll
            for (int t = 0; t < 4; ++t) { const float uu = U[t * DM + 64 * n + cc]; pr[t][0] += uu * a[0]; pr[t][1] += uu * a[1]; pi[t][0] += uu * i2[0]; pi[t][1] += uu * i2[1]; } }
        const f32x2 ba = *(const f32x2*)(p.in[I_BA] + C), bi = *(const f32x2*)(p.in[I_BI] + C), lam = *(const f32x2*)(p.in[I_LAM] + C), h0 = *(const f32x2*)(p.in[I_LRU] + (size_t)b * DM + C);
        float h[2] = {h0[0], h0[1]};
        const float sp[2] = {-8.f * __logf(1.f + __expf(-lam[0])), -8.f * __logf(1.f + __expf(-lam[1]))};
#pragma unroll
        for (int t = 0; t < 4; ++t) { const f32x2 uu = *(LAS f32x2*)(U + t * DM + C);
            bf16* zp = Z1 + ((size_t)MP + 4 * b + t) * NZ1 + ZGB + C; const unsigned g = *(const unsigned*)zp; float yb[2];
#pragma unroll
            for (int e = 0; e < 2; ++e) { const float rg = sigm(pr[t][e] + ba[e]), ig = sigm(pi[t][e] + bi[e]); const float a = __expf(sp[e] * rg);
                const float mult = sqrtf(fmaxf(1.f - a * a, 0.f)); h[e] = a * h[e] + mult * ig * uu[e]; yb[e] = h[e] * gelu_tanh(e ? hi16(g) : lo16(g)); }
            if (!dry) *(unsigned*)zp = pk2(yb[0], yb[1]); }
        if (!dry) *(f32x2*)(p.out + O_LRUS + (size_t)b * DM + C) = (f32x2){h[0], h[1]};
#pragma unroll
        for (int j = 0; j < 3; ++j) if (!dry) *(f32x2*)(p.out + O_CONVS + ((size_t)b * 3 + j) * DM + C) = (f32x2){xp0[4 + j], xp1[4 + j]};
        __syncthreads();
    }
}

__device__ __forceinline__ void phase_merge(CP& p, LAS unsigned char* lds) {
    int tid_l = threadIdx.x; asm volatile("" : "+v"(tid_l)); const int tid = tid_l, wave = tid >> 6, lane = tid & 63, fr = lane & 15, q = lane >> 4;
    const bf16* Z1 = (const bf16*)(p.ws + WS_Z1); const bf16* BON = (const bf16*)(p.ws + WS_BONUS); const bf16* Zg = (const bf16*)p.out;
    const bf16* g2T = (const bf16*)(p.ws + WS_SMALL) + 131072; bf16* MG = (bf16*)(p.ws + WS_XB);
    LAS float* GL = (LAS float*)lds;
    const int tk = tid >> 7, cg8 = tid & 127, Cm = 8 * cg8;
    const f32x4 lg0 = *(const f32x4*)(p.in[I_LNXG] + Cm), lg1 = *(const f32x4*)(p.in[I_LNXG] + Cm + 4), lb0 = *(const f32x4*)(p.in[I_LNXB] + Cm), lb1 = *(const f32x4*)(p.in[I_LNXB] + Cm + 4);
    for (int unit = blockIdx.x; unit < MT / 16; unit += gridDim.x) {
        const int m0 = unit * 16;
        {
          const int m = m0 + fr; size_t prow; bool pz = false;
          if (m < MP) { if ((m & (SEQ - 1)) == 0) { pz = true; prow = m; } else prow = m - 1; } else { const int ms = m - MP; prow = (ms & 3) == 0 ? (size_t)MT + (ms >> 2) : (size_t)m - 1; }
          bf16x8 Tf[4];
#pragma unroll
          for (int ks = 0; ks < 4; ++ks) { const int ko = 32 * ks + 8 * q;
              const v4u cu = *(const v4u*)(Z1 + (size_t)m * NZ1 + ZGL + ko); v4u pu = *(const v4u*)(Z1 + prow * NZ1 + ZGL + ko); if (pz) pu = (v4u){0u, 0u, 0u, 0u};
              float cf[8], pf[8]; UNPACK8(cu, cf); UNPACK8(pu, pf);
              const f32x4 mu0 = *(const f32x4*)(p.in[I_MU] + ZGL + ko), mu1 = *(const f32x4*)(p.in[I_MU] + ZGL + ko + 4); float o[8];
#pragma unroll
              for (int e = 0; e < 8; ++e) o[e] = sigm(cf[e] + (e < 4 ? mu0[e & 3] : mu1[e & 3]) * (pf[e] - cf[e]));
              v4u w; w.x = pk2(o[0], o[1]); w.y = pk2(o[2], o[3]); w.z = pk2(o[4], o[5]); w.w = pk2(o[6], o[7]); Tf[ks] = __builtin_bit_cast(bf16x8, w); }
#pragma unroll 2
          for (int nbi = 0; nbi < 8; ++nbi) { const int nb = wave * 8 + nbi; f32x4 acc = {0.f, 0.f, 0.f, 0.f};
#pragma unroll
              for (int ks = 0; ks < 4; ++ks) { const bf16x8 gf = *(const bf16x8*)(g2T + (size_t)(16 * nb + fr) * 128 + 32 * ks + 8 * q); acc = __builtin_amdgcn_mfma_f32_16x16x32_bf16(gf, Tf[ks], acc, 0, 0, 0); }
              *(LAS f32x4*)(GL + fr * 1028 + 16 * nb + 4 * q) = acc; }
        }
        __syncthreads();
#pragma unroll 1
        for (int ps = 0; ps < 4; ++ps) {
            const int tok = 4 * ps + tk; const size_t m = (size_t)m0 + tok;
            const v4u yu = *(const v4u*)(Z1 + m * NZ1 + ZV + Cm), bu = *(const v4u*)(BON + m * DM + Cm), ybu = *(const v4u*)(Z1 + m * NZ1 + ZGB + Cm);
            const v4u gau = *(const v4u*)(Zg + m * 2048 + Cm), gbu = *(const v4u*)(Zg + m * 2048 + 1024 + Cm);
            const f32x4 g0 = *(LAS f32x4*)(GL + tok * 1028 + Cm), g1 = *(LAS f32x4*)(GL + tok * 1028 + Cm + 4);
            float y[8], bo[8], yb[8], ga[8], gb[8]; UNPACK8(yu, y); UNPACK8(bu, bo); UNPACK8(ybu, yb); UNPACK8(gau, ga); UNPACK8(gbu, gb);
            float sm = 0.f;
#pragma unroll
            for (int e = 0; e < 8; ++e) sm += y[e];
            const float mean = allred8(sm) * (1.f / 64.f); float sq = 0.f;
#pragma unroll
            for (int e = 0; e < 8; ++e) { y[e] -= mean; sq += y[e] * y[e]; }
            const float rstd = __builtin_amdgcn_rsqf(allred8(sq) * (1.f / 64.f) + GN_EPS);
            float o[8];
#pragma unroll
            for (int e = 0; e < 8; ++e) { const float yn = y[e] * rstd * (e < 4 ? lg0[e & 3] : lg1[e & 3]) + (e < 4 ? lb0[e & 3] : lb1[e & 3]);
                const float yA = (yn + bo[e]) * (e < 4 ? g0[e & 3] : g1[e & 3]); o[e] = sigm(ga[e]) * yA + sigm(gb[e]) * yb[e]; }
            v4u w; w.x = pk2(o[0], o[1]); w.y = pk2(o[2], o[3]); w.z = pk2(o[4], o[5]); w.w = pk2(o[6], o[7]);
            *(v4u*)(MG + m * DM + Cm) = w;
        }
        __syncthreads();
    }
}


template <bool RES_BF16> __device__ __forceinline__ void mini_gemm_tail(LAS unsigned char* lds, const bf16* A, int lda, const bf16* Bt, int K, const float* resF, const bf16* resH, bf16* out) {
    int tid_l = threadIdx.x; asm volatile("" : "+v"(tid_l)); const int tid = tid_l, wave = tid >> 6, lane = tid & 63, fr = lane & 15, q = lane >> 4;
    LAS float* RED = (LAS float*)lds;
    for (int task = blockIdx.x; task < 256; task += gridDim.x) {
        const int row0 = MP + 32 * (task >> 4), col0 = 64 * (task & 15);
        const int kw = K >> 3, kb = wave * kw;
        f32x4 acc[2][4];
#pragma unroll
        for (int mb = 0; mb < 2; ++mb)
#pragma unroll
            for (int nb = 0; nb < 4; ++nb) acc[mb][nb] = (f32x4){0.f, 0.f, 0.f, 0.f};
        const bf16* ap = A + (size_t)(row0 + fr) * lda + kb + 8 * q; const bf16* bp = Bt + (size_t)(col0 + fr) * K + kb + 8 * q;
#pragma unroll 2
        for (int k0 = 0; k0 < kw; k0 += 32) {
            bf16x8 af[2], bf[4];
#pragma unroll
            for (int mb = 0; mb < 2; ++mb) af[mb] = *(const bf16x8*)(ap + (size_t)(16 * mb) * lda + k0);
#pragma unroll
            for (int nb = 0; nb < 4; ++nb) bf[nb] = *(const bf16x8*)(bp + (size_t)(16 * nb) * K + k0);
#pragma unroll
            for (int mb = 0; mb < 2; ++mb)
#pragma unroll
                for (int nb = 0; nb < 4; ++nb) acc[mb][nb] = __builtin_amdgcn_mfma_f32_16x16x32_bf16(bf[nb], af[mb], acc[mb][nb], 0, 0, 0);
        }
#pragma unroll
        for (int mb = 0; mb < 2; ++mb)
#pragma unroll
            for (int nb = 0; nb < 4; ++nb) *(LAS f32x4*)(RED + wave * 2048 + (16 * mb + fr) * 64 + 16 * nb + 4 * q) = acc[mb][nb];
        __syncthreads();
        { const int r = tid >> 4, c4 = (tid & 15) * 4; f32x4 sum = *(LAS f32x4*)(RED + r * 64 + c4);
#pragma unroll
          for (int w = 1; w < 8; ++w) sum += *(LAS f32x4*)(RED + w * 2048 + r * 64 + c4);
          const size_t o = (size_t)(row0 + r) * DM + col0 + c4; f32x4 x;
          if (RES_BF16) { const v2u hx = *(const v2u*)(resH + o); x = (f32x4){lo16(hx.x), hi16(hx.x), lo16(hx.y), hi16(hx.y)}; } else x = *(const f32x4*)(resF + o);
          sum += x * ALPHA; *(v2u*)(out + o) = (v2u){pk2(sum[0], sum[1]), pk2(sum[2], sum[3])}; }
        __syncthreads();
    }
}

template <bool FINAL> __device__ __forceinline__ void phase_ln(CP& p, const float* g, const float* bb) {
    int tid_l = threadIdx.x; asm volatile("" : "+v"(tid_l)); const int tid = tid_l, wave = tid >> 6, lane = tid & 63;
    const bf16* PRE = (const bf16*)(p.ws + WS_H1); bf16* H1B = (bf16*)(p.ws + WS_H1B);
    f32x4 gv[4], bv[4];
#pragma unroll
    for (int j = 0; j < 4; ++j) { gv[j] = *(const f32x4*)(g + 16 * lane + 4 * j); bv[j] = *(const f32x4*)(bb + 16 * lane + 4 * j); }
    const int m0 = blockIdx.x * 8 + wave, mstep = gridDim.x * 8;
    v4u n0 = {0u, 0u, 0u, 0u}, n1 = n0;
    if (m0 < MT) { n0 = *(const v4u*)(PRE + (size_t)m0 * DM + 16 * lane); n1 = *(const v4u*)(PRE + (size_t)m0 * DM + 16 * lane + 8); }
    for (int m = m0; m < MT; m += mstep) {
        float x[16]; UNPACK8(n0, x); { float* x8 = x + 8; UNPACK8(n1, x8); }
        if (m + mstep < MT) { n0 = *(const v4u*)(PRE + (size_t)(m + mstep) * DM + 16 * lane); n1 = *(const v4u*)(PRE + (size_t)(m + mstep) * DM + 16 * lane + 8); }
        float sm = 0.f;
#pragma unroll
        for (int e = 0; e < 16; ++e) sm += x[e];
        const float mean = wave_sum(sm) * (1.f / DM); float s2 = 0.f;
#pragma unroll
        for (int e = 0; e < 16; ++e) { x[e] -= mean; s2 += x[e] * x[e]; }
        const float rstd = 1.f / sqrtf(wave_sum(s2) * (1.f / DM) + LN_EPS);
#pragma unroll
        for (int e = 0; e < 16; ++e) x[e] = x[e] * rstd * gv[e >> 2][e & 3] + bv[e >> 2][e & 3];
        if (FINAL) {
#pragma unroll
            for (int j = 0; j < 4; ++j) *(f32x4*)(p.out + O_Y + (size_t)m * DM + 16 * lane + 4 * j) = (f32x4){x[4 * j], x[4 * j + 1], x[4 * j + 2], x[4 * j + 3]};
        } else {
            *(v4u*)(H1B + (size_t)m * DM + 16 * lane) = (v4u){pk2(x[0], x[1]), pk2(x[2], x[3]), pk2(x[4], x[5]), pk2(x[6], x[7])};
            *(v4u*)(H1B + (size_t)m * DM + 16 * lane + 8) = (v4u){pk2(x[8], x[9]), pk2(x[10], x[11]), pk2(x[12], x[13]), pk2(x[14], x[15])}; }
    }
}

__global__ void __launch_bounds__(512, 2) hybrid_step_kernel(Params p_unused) {
    CP* pp = (CP*)__builtin_amdgcn_kernarg_segment_ptr();
#define p (*launder(pp))
    extern __shared__ __attribute__((aligned(16))) unsigned char lds_raw[];
    LAS unsigned char* lds = (LAS unsigned char*)lds_raw;
    volatile LAS unsigned* MISC = (volatile LAS unsigned*)(lds + MISC_OFF);
    if (threadIdx.x < 16) MISC[threadIdx.x] = 0u;
    __syncthreads();
    XcdBarrier bar = xcd_barrier_post((unsigned*)(p.ws + WS_CTL) + CW_BAR, MISC + 8);
    if (p.never) cg::this_grid().sync();
    const int G = gridDim.x, bx = blockIdx.x;

    phase0(p, lds);
#ifdef PROBE_P0M
    if (p.never == 0) { __syncthreads(); phase0(p, lds); }
#endif

#ifdef PROBE_INSTR
    { float x0 = threadIdx.x, x1 = x0 + 1.f, x2 = x0 + 2.f, x3 = x0 + 3.f, x4 = x0 + 4.f, x5 = x0 + 5.f, x6 = x0 + 6.f, x7 = x0 + 7.f; const float kf = 0.999f; const unsigned hh = 0x3c003c00u; f32x2 kp = {0.999f, 0.998f}; f32x2 x0p = {x0, x1}, x1p = {x1, x2}, x2p = {x2, x3}, x3p = {x3, x4}, x4p = {x4, x5}, x5p = {x5, x6}, x6p = {x6, x7}, x7p = {x7, x0};
      const int nit = (p.never == 0 ? 20000 : 1);
      for (int it = 0; it < nit; ++it) {
#if PROBE_INSTR == 1
#define PI(x) asm volatile("v_fma_f32 %0, %0, %1, %0" : "+v"(x) : "v"(kf))
#elif PROBE_INSTR == 2
#define PI(x) asm volatile("v_fma_mix_f32 %0, %1, %0, %0 op_sel_hi:[1,0,0]" : "+v"(x) : "v"(hh))
#elif PROBE_INSTR == 3
#define PI(x) asm volatile("v_add_f32_dpp %0, %0, %0 quad_perm:[1,0,3,2] row_mask:0xf bank_mask:0xf bound_ctrl:1" : "+v"(x))
#elif PROBE_INSTR == 4
#define PI(x) asm volatile("v_pk_fma_f32 %0, %0, %1, %0" : "+v"(x##p) : "v"(kp))

#endif
#if PROBE_INSTR == 4
          static_assert(true, "");
#endif
          PI(x0); PI(x1); PI(x2); PI(x3); PI(x4); PI(x5); PI(x6); PI(x7);
      }
      x0 += x0p[0] + x1p[1] + x2p[0] + x3p[1] + x4p[0] + x5p[1] + x6p[0] + x7p[1];
      if (x0 + x1 + x2 + x3 + x4 + x5 + x6 + x7 == 123.456f) ((float*)(p.ws + WS_CTL))[20000] = x0; }
#endif
    xcd_barrier(bar);
    { pg8::Gemm g{(const pg8::bf16_t*)(p.ws + WS_XB), (const pg8::bf16_t*)(p.ws + WS_WINT), MPAD, NIN, 1024}; pg8::StaticOrder S; S.init(MPAD, NIN, G, bx);
      EpiZ E{(bf16*)(p.ws + WS_Z1), (bf16*)p.out};
      pg8::gemm_phase<EpiZ, pg8::StaticOrder, true, true>(lds, g, S, E); }
    xcd_barrier(bar);
#ifdef PROBE_WKVP
    for (int u = bx; u < 256; u += G) wkv_prompt2(p, lds, u, p.never == 0);
#endif
    for (int u = bx; u < 256; u += G) wkv_prompt2(p, lds, u, p.never != 0);
#ifdef PROBE_WKVS
    wkv_sample2(p, lds, p.never == 0);
#endif
    wkv_sample2(p, lds, p.never != 0);
#ifdef PROBE_LRUP
    for (int u = bx; u < 256; u += G) lru_prompt2(p, lds, u, p.never == 0);
#endif
    for (int u = bx; u < 256; u += G) lru_prompt2(p, lds, u, p.never != 0);
#ifdef PROBE_LRUS
    lru_sample(p, lds, p.never == 0);
#endif
    lru_sample(p, lds, p.never != 0);
    xcd_barrier(bar);
    phase_merge(p, lds);
#ifdef PROBE_P0M
    if (p.never == 0) { __syncthreads(); phase_merge(p, lds); }
#endif
    xcd_barrier(bar);
    phase_convert_ffn(p, lds);
    __syncthreads();
    { pg8::Gemm g{(const pg8::bf16_t*)(p.ws + WS_XB), (const pg8::bf16_t*)(p.ws + WS_WOT), MP, 1024, 1024}; pg8::StaticOrder S; S.init(MP, 1024, G, bx);
      EpiResB<false> E{p.in[I_XP], p.in[I_XS], nullptr, (bf16*)(p.ws + WS_H1)};
      pg8::gemm_phase<EpiResB<false>, pg8::StaticOrder, true, true>(lds, g, S, E); }
    __syncthreads();
    mini_gemm_tail<false>(lds, (const bf16*)(p.ws + WS_XB), 1024, (const bf16*)(p.ws + WS_WOT), 1024, p.in[I_XS] - (size_t)MP * DM, nullptr, (bf16*)(p.ws + WS_H1));
    xcd_barrier(bar);
    phase_ln<false>(p, p.in[I_LN1G], p.in[I_LN1B]);
    xcd_barrier(bar);
    { pg8::Gemm g{(const pg8::bf16_t*)(p.ws + WS_H1B), (const pg8::bf16_t*)(p.ws + WS_WGUT), MT, 2 * DFF, 1024}; pg8::StaticOrder S; S.init(MT, 2 * DFF, G, bx);
      EpiSwi E{(bf16*)(p.ws + WS_ACT)};
      pg8::gemm_phase<EpiSwi, pg8::StaticOrder, true, true>(lds, g, S, E); }
    xcd_barrier(bar);
    { pg8::Gemm g{(const pg8::bf16_t*)(p.ws + WS_ACT), (const pg8::bf16_t*)(p.ws + WS_WDT), MP, 1024, DFF}; pg8::StaticOrder S; S.init(MP, 1024, G, bx);
      EpiResB<true> E{nullptr, nullptr, (const bf16*)(p.ws + WS_H1B), (bf16*)(p.ws + WS_H1)};
      pg8::gemm_phase<EpiResB<true>, pg8::StaticOrder, true, true>(lds, g, S, E); }
    __syncthreads();
    mini_gemm_tail<true>(lds, (const bf16*)(p.ws + WS_ACT), DFF, (const bf16*)(p.ws + WS_WDT), DFF, nullptr, (const bf16*)(p.ws + WS_H1B), (bf16*)(p.ws + WS_H1));
    xcd_barrier(bar);
    phase_ln<true>(p, p.in[I_LN2G], p.in[I_LN2B]);
#undef p
}

extern "C" void kernel_launch(void* const* d_in, const int* in_sizes, int n_in, void* d_out, int out_size, void* d_ws, size_t ws_size, hipStream_t stream) {
    static int grid = 0;
    if (grid == 0) {
        int dev = 0, cus = 0, per_cu = 0;
        if (n_in != 33 || ws_size < 256 * MiB) { fprintf(stderr, "kernel_launch: unexpected n_in %d / ws %zu\n", n_in, ws_size); grid = -1; return; }
        hipGetDevice(&dev); hipDeviceGetAttribute(&cus, hipDeviceAttributeMultiprocessorCount, dev);
        if (hipFuncSetAttribute((const void*)hybrid_step_kernel, hipFuncAttributeMaxDynamicSharedMemorySize, LDS_BYTES) != hipSuccess) { fprintf(stderr, "kernel_launch: hipFuncSetAttribute failed\n"); grid = -1; return; }
        if (hipOccupancyMaxActiveBlocksPerMultiprocessor(&per_cu, (const void*)hybrid_step_kernel, 512, LDS_BYTES) != hipSuccess || per_cu < 1) { fprintf(stderr, "kernel_launch: occupancy query says %d blocks per CU\n", per_cu); }
        (void)hipGetLastError();
        grid = cus;
    }
    if (grid < 0) return;
    (void)hipMemsetAsync((char*)d_ws + WS_CTL, 0, CTL_ZERO_BYTES, stream);
    Params p{};
    for (int i = 0; i < 33; ++i) p.in[i] = (const float*)d_in[i];
    p.out = (float*)d_out; p.ws = (unsigned char*)d_ws; p.never = 0; p.pad = 0;
    void* args[] = {&p};
    hipError_t e = hipLaunchCooperativeKernel((const void*)hybrid_step_kernel, dim3(grid), dim3(512), args, LDS_BYTES, stream);
    if (e != hipSuccess) fprintf(stderr, "kernel_launch: cooperative launch failed: %s (grid %d)\n", hipGetErrorString(e), grid);
}
```
